# Optimizing an MI355X kernel written in HIP

```python
import math
import jax, jax.numpy as jnp
from jax import lax
import numpy as np

D_MODEL = 1024
BATCH = 4
SEQ = 4096
DEPTH = 4

N_MEM = 256
MIX_HALF = D_MODEL // 2
A_HEADS = 4
A_HEAD_DIM = MIX_HALF // A_HEADS
DILATED_GROUPS = ((128, 1), (512, 4), (2048, 16))
PAD_MULTIPLE = 2048
RG_WIDTH = MIX_HALF
RG_BLOCKS = 4
RG_BLOCK_DIM = RG_WIDTH // RG_BLOCKS
RG_C = 8.0
CONV_WIDTH = 4
POOL_WINDOWS = (2, 4, 8, 16)
POOL_GROUP_DIM = D_MODEL // len(POOL_WINDOWS)
XA_HEADS = 4
XA_HEAD_DIM = D_MODEL // XA_HEADS
D_FF = 4 * D_MODEL
IN_COLS = 3 * MIX_HALF + 2 * RG_WIDTH
N_EVEN = (DEPTH + 1) // 2
N_ODD = DEPTH // 2
EPS = 1e-6

kernel_name = 'hybrid_dilated_rglru_pool_trunk'


def rms_norm(x, g):
    xf = x.astype(jnp.float32)
    y = xf * lax.rsqrt(jnp.mean(xf * xf, axis=-1, keepdims=True) + EPS)
    return (y * g.astype(jnp.float32)).astype(x.dtype)


def dilated_window_attn(q, k, v, window, dilation):
    B, S, H, C = q.shape
    L = window // dilation
    nb = S // window

    def split(t):
        return t.reshape(B, nb, L, dilation, H, C)

    def with_prev(t):
        prev = jnp.pad(t, ((0, 0), (1, 0), (0, 0), (0, 0), (0, 0), (0, 0)))[:, :-1]
        return jnp.concatenate([prev, t], axis=2)

    qb = split(q)
    kc = with_prev(split(k))
    vc = with_prev(split(v))
    s = jnp.einsum('bnqrhc,bnkrhc->bnrhqk', qb, kc).astype(jnp.float32) * (C ** -0.5)
    qi = jnp.arange(L)[:, None]
    kj = jnp.arange(2 * L)[None, :]
    dist = qi + L - kj
    band = (dist >= 0) & (dist <= L)
    first = (jnp.arange(nb) == 0)[:, None, None]
    mask = band[None] & (jnp.logical_not(first) | (kj >= L)[None])
    s = jnp.where(mask[None, :, None, None], s, -jnp.inf)
    m = jnp.max(s, axis=-1, keepdims=True)
    p = jnp.exp(s - m)
    den = jnp.sum(p, axis=-1)
    o = jnp.einsum('bnrhqk,bnkrhc->bnqrhc', p, vc.astype(jnp.float32))
    den_t = den.transpose(0, 1, 4, 2, 3)
    o = o / den_t[..., None]
    lse = m[..., 0].transpose(0, 1, 4, 2, 3) + jnp.log(den_t)
    return o.reshape(B, S, H, C), lse.reshape(B, S, H)


def mixer_attn_rglru(h, w_in, q_g, k_g, conv_w, conv_b, ga_w, ga_b, gx_w, gx_b, lam, w_out):
    B, S, _ = h.shape
    proj = h @ w_in
    q, k, v, xr, gate = jnp.split(
        proj, [MIX_HALF, 2 * MIX_HALF, 3 * MIX_HALF, 3 * MIX_HALF + RG_WIDTH], axis=-1)

    q = rms_norm(q.reshape(B, S, A_HEADS, A_HEAD_DIM), q_g)
    k = rms_norm(k.reshape(B, S, A_HEADS, A_HEAD_DIM), k_g)
    v = v.reshape(B, S, A_HEADS, A_HEAD_DIM)
    Sp = -(-S // PAD_MULTIPLE) * PAD_MULTIPLE
    pad = ((0, 0), (0, Sp - S), (0, 0), (0, 0))
    qp, kp, vp = jnp.pad(q, pad), jnp.pad(k, pad), jnp.pad(v, pad)
    outs, lses = [], []
    for window, dilation in DILATED_GROUPS:
        o_g, lse_g = dilated_window_attn(qp, kp, vp, window, dilation)
        outs.append(o_g)
        lses.append(lse_g)
    wts = jax.nn.softmax(jnp.stack(lses), axis=0)
    o_a = jnp.sum(wts[..., None] * jnp.stack(outs), axis=0)[:, :S]
    o_a = o_a.reshape(B, S, MIX_HALF).astype(h.dtype)

    xpad = jnp.pad(xr, ((0, 0), (CONV_WIDTH - 1, 0), (0, 0)))
    xc = conv_b + sum(xpad[:, j:j + S] * conv_w[j] for j in range(CONV_WIDTH))
    xb = xc.reshape(B, S, RG_BLOCKS, RG_BLOCK_DIM)
    r = jax.nn.sigmoid(jnp.einsum('bsgc,gcd->bsgd', xb, ga_w).reshape(B, S, RG_WIDTH) + ga_b)
    i = jax.nn.sigmoid(jnp.einsum('bsgc,gcd->bsgd', xb, gx_w).reshape(B, S, RG_WIDTH) + gx_b)
    log_a = -RG_C * r.astype(jnp.float32) * jax.nn.softplus(-lam.astype(jnp.float32))
    a = jnp.exp(log_a)
    u = jnp.sqrt(-jnp.expm1(2.0 * log_a)) * (i * xc).astype(jnp.float32)

    def combine(e1, e2):
        a1, b1 = e1
        a2, b2 = e2
        return a1 * a2, a2 * b1 + b2

    _, hs = lax.associative_scan(combine, (a, u), axis=1)
    y_b = hs.astype(h.dtype) * jax.nn.gelu(gate)

    return jnp.concatenate([o_a, y_b], axis=-1) @ w_out


def pool_mixer(h, pool_w, scale):
    B, S, D = h.shape
    hf = h.astype(jnp.float32)
    cs = jnp.pad(jnp.cumsum(hf, axis=1), ((0, 0), (1, 0), (0, 0)))
    t = jnp.arange(S)
    diffs = []
    for g, w in enumerate(POOL_WINDOWS):
        sl = slice(g * POOL_GROUP_DIM, (g + 1) * POOL_GROUP_DIM)
        lo = jnp.maximum(t + 1 - w, 0)
        window_sum = cs[:, 1:, sl] - cs[:, lo, sl]
        count = jnp.minimum(t + 1, w).astype(jnp.float32)[None, :, None]
        diffs.append(window_sum / count - hf[..., sl])
    d = jnp.stack(diffs, axis=2)
    out = jnp.einsum('bsgc,gcd->bsgd', d, pool_w.astype(jnp.float32)).reshape(B, S, D)
    return (out * scale.astype(jnp.float32)).astype(h.dtype)


def memory_xattn(h, mem_n, w_q, w_kv, q_g, k_g, w_o):
    B, S, D = h.shape
    M = mem_n.shape[1]
    q = rms_norm((h @ w_q).reshape(B, S, XA_HEADS, XA_HEAD_DIM), q_g)
    k, v = jnp.split(mem_n @ w_kv, 2, axis=-1)
    k = rms_norm(k.reshape(B, M, XA_HEADS, XA_HEAD_DIM), k_g)
    v = v.reshape(B, M, XA_HEADS, XA_HEAD_DIM)
    s = jnp.einsum('bshc,bmhc->bhsm', q, k).astype(jnp.float32) * (XA_HEAD_DIM ** -0.5)
    p = jax.nn.softmax(s, axis=-1)
    o = jnp.einsum('bhsm,bmhc->bshc', p, v.astype(jnp.float32)).astype(h.dtype)
    return o.reshape(B, S, D) @ w_o


def sq_relu_mlp(h, w1, w2):
    return jnp.square(jax.nn.relu(h @ w1)) @ w2


def setup_inputs(seed: int = 0) -> dict:
    key = jax.random.key(seed)
    ks = jax.random.split(key, 26)
    f32 = jnp.float32

    def nrm(k, shape, fan_in):
        return jax.random.normal(k, shape, f32) * fan_in ** -0.5

    def gain(k, shape):
        return 1.0 + 0.02 * jax.random.normal(k, shape, f32)

    def bias(k, shape):
        return 0.02 * jax.random.normal(k, shape, f32)

    u = jax.random.uniform(ks[15], (N_EVEN, RG_WIDTH), f32, minval=0.9, maxval=0.999)
    s = u ** (1.0 / RG_C)
    lam = jnp.log(s) - jnp.log1p(-s)
    return {
        'x': jax.random.normal(ks[0], (BATCH, SEQ, D_MODEL), f32),
        'mem': jax.random.normal(ks[1], (BATCH, N_MEM, D_MODEL), f32),
        'mem_norm_g': gain(ks[2], (D_MODEL,)),
        'mix_norm_g': gain(ks[3], (DEPTH, D_MODEL)),
        'xattn_norm_g': gain(ks[4], (DEPTH, D_MODEL)),
        'mlp_norm_g': gain(ks[5], (DEPTH, D_MODEL)),
        'ev_w_in': nrm(ks[6], (N_EVEN, D_MODEL, IN_COLS), D_MODEL),
        'ev_q_norm_g': gain(ks[7], (N_EVEN, A_HEAD_DIM)),
        'ev_k_norm_g': gain(ks[8], (N_EVEN, A_HEAD_DIM)),
        'ev_conv_w': nrm(ks[9], (N_EVEN, CONV_WIDTH, RG_WIDTH), CONV_WIDTH),
        'ev_conv_b': bias(ks[10], (N_EVEN, RG_WIDTH)),
        'ev_gate_a_w': nrm(ks[11], (N_EVEN, RG_BLOCKS, RG_BLOCK_DIM, RG_BLOCK_DIM), RG_BLOCK_DIM),
        'ev_gate_a_b': bias(ks[12], (N_EVEN, RG_WIDTH)),
        'ev_gate_x_w': nrm(ks[13], (N_EVEN, RG_BLOCKS, RG_BLOCK_DIM, RG_BLOCK_DIM), RG_BLOCK_DIM),
        'ev_gate_x_b': bias(ks[14], (N_EVEN, RG_WIDTH)),
        'ev_lambda': lam,
        'ev_w_out': nrm(ks[16], (N_EVEN, 2 * MIX_HALF, D_MODEL), 2 * MIX_HALF),
        'od_pool_w': nrm(ks[17], (N_ODD, len(POOL_WINDOWS), POOL_GROUP_DIM, POOL_GROUP_DIM), POOL_GROUP_DIM),
        'od_scale': 0.5 + 0.05 * jax.random.normal(ks[18], (N_ODD, D_MODEL), f32),
        'xa_w_q': nrm(ks[19], (DEPTH, D_MODEL, D_MODEL), D_MODEL),
        'xa_w_kv': nrm(ks[20], (DEPTH, D_MODEL, 2 * D_MODEL), D_MODEL),
        'xa_q_norm_g': gain(ks[21], (DEPTH, XA_HEAD_DIM)),
        'xa_k_norm_g': gain(ks[22], (DEPTH, XA_HEAD_DIM)),
        'xa_w_o': nrm(ks[23], (DEPTH, D_MODEL, D_MODEL), D_MODEL),
        'mlp_w1': nrm(ks[24], (DEPTH, D_MODEL, D_FF), D_MODEL),
        'mlp_w2': nrm(ks[25], (DEPTH, D_FF, D_MODEL), D_FF),
    }


def reference(x, mem, mem_norm_g, mix_norm_g, xattn_norm_g, mlp_norm_g,
              ev_w_in, ev_q_norm_g, ev_k_norm_g, ev_conv_w, ev_conv_b,
              ev_gate_a_w, ev_gate_a_b, ev_gate_x_w, ev_gate_x_b, ev_lambda, ev_w_out,
              od_pool_w, od_scale,
              xa_w_q, xa_w_kv, xa_q_norm_g, xa_k_norm_g, xa_w_o,
              mlp_w1, mlp_w2):
    mem_n = rms_norm(mem, mem_norm_g)
    for l in range(DEPTH):
        h = rms_norm(x, mix_norm_g[l])
        if l % 2 == 0:
            e = l // 2
            x = x + mixer_attn_rglru(h, ev_w_in[e], ev_q_norm_g[e], ev_k_norm_g[e],
                                     ev_conv_w[e], ev_conv_b[e], ev_gate_a_w[e], ev_gate_a_b[e],
                                     ev_gate_x_w[e], ev_gate_x_b[e], ev_lambda[e], ev_w_out[e])
        else:
            o = l // 2
            x = x + pool_mixer(h, od_pool_w[o], od_scale[o])
        x = x + memory_xattn(rms_norm(x, xattn_norm_g[l]), mem_n, xa_w_q[l], xa_w_kv[l],
                             xa_q_norm_g[l], xa_k_norm_g[l], xa_w_o[l])
        x = x + sq_relu_mlp(rms_norm(x, mlp_norm_g[l]), mlp_w1[l], mlp_w2[l])
    return x
```

```cpp
#include <hip/hip_runtime.h>
#include <cstdio>
#include <cstdint>
#include <cmath>

namespace nv {
constexpr int D = 1024, BATCH = 4, SEQ = 4096, T = BATCH * SEQ, NMEM = 256, TM = BATCH * NMEM;
constexpr int HALF = 512, AH = 4, AD = 128, RGW = 512, XH = 4, XD = 256, FF = 4096, INC = 2560;
constexpr float EPS = 1e-6f;

__global__ void __launch_bounds__(256) k_rmsnorm(const float* in, int in_pitch, int rows_per_tok, int L, const float* __restrict__ g, float* out, int out_pitch, long nrows) {
    const long row = (long)blockIdx.x * 4 + (threadIdx.x >> 6); const int lane = threadIdx.x & 63;
    if (row >= nrows) return;
    const long tok = row / rows_per_tok; const int sub = (int)(row % rows_per_tok);
    const float* p = in + tok * in_pitch + (long)sub * L; float* o = out + tok * out_pitch + (long)sub * L;
    float s = 0.f;
    for (int i = lane; i < L; i += 64) { const float v = p[i]; s += v * v; }
    for (int off = 32; off; off >>= 1) s += __shfl_xor(s, off);
    const float r = 1.0f / sqrtf(s / (float)L + EPS);
    for (int i = lane; i < L; i += 64) o[i] = p[i] * r * g[i];
}

enum { EPI_STORE = 0, EPI_ADD = 1, EPI_SQRELU = 2, EPI_ADD_SCALE = 3, EPI_SIGMOID_BIAS = 4 };
struct GemmP { const float* A; const float* B; float* C; int lda, ldb, ldc, M, N, K; long sA, sB, sC; const float* aux; int sAux; int epi; };
__global__ void __launch_bounds__(256) k_gemm(GemmP p) {
    __shared__ float As[16][132];
    __shared__ float Bs[16][132];
    const int z = blockIdx.z;
    const float* A = p.A + z * p.sA; const float* B = p.B + z * p.sB; float* C = p.C + z * p.sC; const float* aux = p.aux ? p.aux + (long)z * p.sAux : nullptr;
    const int m0 = blockIdx.y * 128, n0 = blockIdx.x * 128, tid = threadIdx.x, tx = tid & 15, ty = tid >> 4;
    float acc[8][8];
#pragma unroll
    for (int i = 0; i < 8; ++i)
#pragma unroll
        for (int j = 0; j < 8; ++j) acc[i][j] = 0.f;
    for (int k0 = 0; k0 < p.K; k0 += 16) {
#pragma unroll
        for (int i = 0; i < 2; ++i) { const int r = (tid >> 2) + 64 * i, kq = tid & 3; const float4 v = *(const float4*)(A + (long)(m0 + r) * p.lda + k0 + kq * 4);
            As[kq * 4 + 0][r] = v.x; As[kq * 4 + 1][r] = v.y; As[kq * 4 + 2][r] = v.z; As[kq * 4 + 3][r] = v.w; }
#pragma unroll
        for (int i = 0; i < 2; ++i) { const int kk = (tid >> 5) + 8 * i, nq = tid & 31; const float4 v = *(const float4*)(B + (long)(k0 + kk) * p.ldb + n0 + nq * 4);
            *(float4*)&Bs[kk][nq * 4] = v; }
        __syncthreads();
#pragma unroll
        for (int kk = 0; kk < 16; ++kk) {
            float a[8], b[8];
            const float4 a0 = *(const float4*)&As[kk][ty * 4], a1 = *(const float4*)&As[kk][64 + ty * 4];
            const float4 b0 = *(const float4*)&Bs[kk][tx * 4], b1 = *(const float4*)&Bs[kk][64 + tx * 4];
            a[0] = a0.x; a[1] = a0.y; a[2] = a0.z; a[3] = a0.w; a[4] = a1.x; a[5] = a1.y; a[6] = a1.z; a[7] = a1.w;
            b[0] = b0.x; b[1] = b0.y; b[2] = b0.z; b[3] = b0.w; b[4] = b1.x; b[5] = b1.y; b[6] = b1.z; b[7] = b1.w;
#pragma unroll
            for (int i = 0; i < 8; ++i)
#pragma unroll
                for (int j = 0; j < 8; ++j) acc[i][j] = fmaf(a[i], b[j], acc[i][j]);
        }
        __syncthreads();
    }
#pragma unroll
    for (int i = 0; i < 8; ++i) {
        const int r = m0 + (i < 4 ? ty * 4 + i : 64 + ty * 4 + (i - 4));
#pragma unroll
        for (int jh = 0; jh < 2; ++jh) {
            const int c = n0 + jh * 64 + tx * 4; float* cp = C + (long)r * p.ldc + c;
            float4 v = make_float4(acc[i][jh * 4 + 0], acc[i][jh * 4 + 1], acc[i][jh * 4 + 2], acc[i][jh * 4 + 3]);
            if (p.epi == EPI_ADD) { const float4 o = *(const float4*)cp; v.x += o.x; v.y += o.y; v.z += o.z; v.w += o.w; }
            else if (p.epi == EPI_SQRELU) { v.x = v.x > 0.f ? v.x * v.x : 0.f; v.y = v.y > 0.f ? v.y * v.y : 0.f; v.z = v.z > 0.f ? v.z * v.z : 0.f; v.w = v.w > 0.f ? v.w * v.w : 0.f; }
            else if (p.epi == EPI_ADD_SCALE) { const float4 o = *(const float4*)cp; const float4 s = *(const float4*)(aux + c); v.x = o.x + v.x * s.x; v.y = o.y + v.y * s.y; v.z = o.z + v.z * s.z; v.w = o.w + v.w * s.w; }
            else if (p.epi == EPI_SIGMOID_BIAS) { const float4 s = *(const float4*)(aux + c); v.x = 1.f / (1.f + expf(-(v.x + s.x))); v.y = 1.f / (1.f + expf(-(v.y + s.y))); v.z = 1.f / (1.f + expf(-(v.z + s.z))); v.w = 1.f / (1.f + expf(-(v.w + s.w))); }
            *(float4*)cp = v;
        }
    }
}

__global__ void __launch_bounds__(256) k_dilattn(const float* __restrict__ qkv  , float* __restrict__ out, int out_pitch) {
    const long wv = (long)blockIdx.x * 4 + (threadIdx.x >> 6); const int lane = threadIdx.x & 63;
    if (wv >= (long)T * AH) return;
    const int h = (int)(wv % AH); const long tok = wv / AH; const int b = (int)(tok / SEQ), t = (int)(tok % SEQ);
    const float* qp = qkv + tok * 1536 + h * AD; const float q0 = qp[lane * 2], q1 = qp[lane * 2 + 1];
    float m = -INFINITY, den = 0.f, n0 = 0.f, n1 = 0.f;
    const float sc = 0.08838834764831845f;
    for (int g = 0; g < 3; ++g) { const int d = g == 0 ? 1 : (g == 1 ? 4 : 16);
        for (int i = 0; i <= 128; ++i) { const int tt = t - i * d; if (tt < 0) break;
            const float* kp = qkv + ((long)b * SEQ + tt) * 1536 + 512 + h * AD; const float* vp = kp + 512;
            float s = q0 * kp[lane * 2] + q1 * kp[lane * 2 + 1];
            for (int off = 32; off; off >>= 1) s += __shfl_xor(s, off);
            s *= sc;
            const float mn = fmaxf(m, s), al = expf(m - mn), e = expf(s - mn);
            den = den * al + e; n0 = n0 * al + e * vp[lane * 2]; n1 = n1 * al + e * vp[lane * 2 + 1]; m = mn; } }
    float* op = out + tok * out_pitch + h * AD; op[lane * 2] = n0 / den; op[lane * 2 + 1] = n1 / den;
}

__global__ void k_conv(const float* __restrict__ xg, const float* __restrict__ cw  , const float* __restrict__ cb, float* __restrict__ xc  ) {
    const long idx = (long)blockIdx.x * 256 + threadIdx.x; if (idx >= (long)T * RGW) return;
    const int c = (int)(idx % RGW); const long tok = idx / RGW; const int t = (int)(tok % SEQ);
    float s = cb[c];
#pragma unroll
    for (int j = 0; j < 4; ++j) { const int tt = t - 3 + j; if (tt >= 0) s += xg[(tok - 3 + j) * 1024 + c] * cw[j * RGW + c]; }
    xc[idx] = s;
}
__global__ void k_scan(const float* __restrict__ r, const float* __restrict__ ig, const float* __restrict__ xc, const float* __restrict__ xg  , const float* __restrict__ lam, float* __restrict__ out, int out_pitch) {
    const int idx = blockIdx.x * 64 + threadIdx.x; if (idx >= BATCH * RGW) return;
    const int c = idx % RGW, b = idx / RGW;
    const float l = lam[c]; const float sp = (-l > 20.f) ? -l : log1pf(expf(-l));
    float h = 0.f;
    for (int t = 0; t < SEQ; ++t) { const long tok = (long)b * SEQ + t;
        const float la = -8.0f * r[tok * RGW + c] * sp, a = expf(la), u = sqrtf(-expm1f(2.0f * la)) * (ig[tok * RGW + c] * xc[tok * RGW + c]);
        h = a * h + u;
        const float gt = xg[tok * 1024 + 512 + c]; const float ge = 0.5f * gt * (1.0f + tanhf(0.7978845608028654f * (gt + 0.044715f * gt * gt * gt)));
        out[tok * out_pitch + c] = h * ge; }
}
__global__ void k_pooldiff(const float* __restrict__ hn, float* __restrict__ dd) {
    const long idx = (long)blockIdx.x * 256 + threadIdx.x; if (idx >= (long)T * D) return;
    const int c = (int)(idx % D); const long tok = idx / D; const int t = (int)(tok % SEQ); const int w = 2 << (c >> 8);
    const int cnt = (t + 1 < w) ? t + 1 : w; float s = 0.f;
    for (int i = 0; i < cnt; ++i) s += hn[(tok - i) * D + c];
    dd[idx] = s / (float)cnt - hn[idx];
}
__global__ void __launch_bounds__(256) k_xattn(const float* __restrict__ qn, const float* __restrict__ kn, const float* __restrict__ kv, float* __restrict__ out) {
    const long wv = (long)blockIdx.x * 4 + (threadIdx.x >> 6); const int lane = threadIdx.x & 63;
    if (wv >= (long)T * XH) return;
    const int h = (int)(wv % XH); const long tok = wv / XH; const int b = (int)(tok / SEQ);
    const float4 q = *(const float4*)(qn + tok * D + h * XD + lane * 4);
    float m = -INFINITY, den = 0.f; float4 n = make_float4(0.f, 0.f, 0.f, 0.f);
    for (int j = 0; j < NMEM; ++j) { const long mr = (long)b * NMEM + j;
        const float4 k = *(const float4*)(kn + mr * D + h * XD + lane * 4); const float4 v = *(const float4*)(kv + mr * 2048 + 1024 + h * XD + lane * 4);
        float s = q.x * k.x + q.y * k.y + q.z * k.z + q.w * k.w;
        for (int off = 32; off; off >>= 1) s += __shfl_xor(s, off);
        s *= 0.0625f;
        const float mn = fmaxf(m, s), al = expf(m - mn), e = expf(s - mn);
        den = den * al + e; n.x = n.x * al + e * v.x; n.y = n.y * al + e * v.y; n.z = n.z * al + e * v.z; n.w = n.w * al + e * v.w; m = mn; }
    *(float4*)(out + tok * D + h * XD + lane * 4) = make_float4(n.x / den, n.y / den, n.z / den, n.w / den);
}

static void gemm(hipStream_t s, const float* A, int lda, const float* B, int ldb, float* C, int ldc, int M, int N, int K, int epi, const float* aux = nullptr, int nz = 1, long sA = 0, long sB = 0, long sC = 0, int sAux = 0) {
    GemmP p{A, B, C, lda, ldb, ldc, M, N, K, sA, sB, sC, aux, sAux, epi};
    hipLaunchKernelGGL(k_gemm, dim3(N / 128, M / 128, nz), dim3(256), 0, s, p);
}
static void rmsnorm(hipStream_t s, const float* in, int in_pitch, int rpt, int L, const float* g, float* out, int out_pitch, long nrows) {
    hipLaunchKernelGGL(k_rmsnorm, dim3((unsigned)((nrows + 3) / 4)), dim3(256), 0, s, in, in_pitch, rpt, L, g, out, out_pitch, nrows);
}

static void forward(void* const* d_in, float* x, unsigned char* ws, hipStream_t s) {
    const float* in[26]; for (int i = 0; i < 26; ++i) in[i] = (const float*)d_in[i];
    const size_t MiB = 1u << 20;
    float* B0 = (float*)(ws);
    float* B1 = (float*)(ws + 64 * MiB);
    float* B2 = (float*)(ws + 160 * MiB);
    float* memn = (float*)(ws + 224 * MiB);
    float* kv = (float*)(ws + 228 * MiB);
    float* kn = (float*)(ws + 236 * MiB);
    hipMemcpyAsync(x, in[0], (size_t)T * D * 4, hipMemcpyDeviceToDevice, s);
    rmsnorm(s, in[1], D, 1, D, in[2], memn, D, TM);
    for (int l = 0; l < 4; ++l) {
        rmsnorm(s, x, D, 1, D, in[3] + l * D, B0, D, T);
        if ((l & 1) == 0) { const int e = l / 2;
            const float* win = in[6] + (size_t)e * D * INC;
            gemm(s, B0, D, win, INC, B1, 1536, T, 1536, D, EPI_STORE);
            rmsnorm(s, B1, 1536, 4, AD, in[7] + e * AD, B1, 1536, (long)T * 4);
            rmsnorm(s, B1 + 512, 1536, 4, AD, in[8] + e * AD, B1 + 512, 1536, (long)T * 4);
            hipLaunchKernelGGL(k_dilattn, dim3(T * AH / 4), dim3(256), 0, s, (const float*)B1, B2, D);
            gemm(s, B0, D, win + 1536, INC, B1, 1024, T, 1024, D, EPI_STORE);
            float* xc = B1 + (size_t)T * 1024;
            hipLaunchKernelGGL(k_conv, dim3(T * RGW / 256), dim3(256), 0, s, (const float*)B1, in[9] + e * 4 * RGW, in[10] + e * RGW, xc);
            float* rr = B0; float* ii = B0 + (size_t)T * RGW;
            gemm(s, xc, RGW, in[11] + (size_t)e * 4 * 128 * 128, 128, rr, RGW, T, 128, 128, EPI_SIGMOID_BIAS, in[12] + e * RGW, 4, 128, 128 * 128, 128, 128);
            gemm(s, xc, RGW, in[13] + (size_t)e * 4 * 128 * 128, 128, ii, RGW, T, 128, 128, EPI_SIGMOID_BIAS, in[14] + e * RGW, 4, 128, 128 * 128, 128, 128);
            hipLaunchKernelGGL(k_scan, dim3(BATCH * RGW / 64), dim3(64), 0, s, (const float*)rr, (const float*)ii, (const float*)xc, (const float*)B1, in[15] + e * RGW, B2 + 512, D);
            gemm(s, B2, D, in[16] + (size_t)e * D * D, D, x, D, T, D, D, EPI_ADD);
        } else { const int o = l / 2;
            hipLaunchKernelGGL(k_pooldiff, dim3(T * D / 256), dim3(256), 0, s, (const float*)B0, B2);
            gemm(s, B2, D, in[17] + (size_t)o * 4 * 256 * 256, 256, x, D, T, 256, 256, EPI_ADD_SCALE, in[18] + o * D, 4, 256, 256 * 256, 256, 256);
        }
        rmsnorm(s, x, D, 1, D, in[4] + l * D, B0, D, T);
        gemm(s, B0, D, in[19] + (size_t)l * D * D, D, B1, D, T, D, D, EPI_STORE);
        rmsnorm(s, B1, D, 4, XD, in[21] + l * XD, B1, D, (long)T * 4);
        gemm(s, memn, D, in[20] + (size_t)l * D * 2048, 2048, kv, 2048, TM, 2048, D, EPI_STORE);
        rmsnorm(s, kv, 2048, 4, XD, in[22] + l * XD, kn, D, (long)TM * 4);
        hipLaunchKernelGGL(k_xattn, dim3(T * XH / 4), dim3(256), 0, s, (const float*)B1, (const float*)kn, (const float*)kv, B2);
        gemm(s, B2, D, in[23] + (size_t)l * D * D, D, x, D, T, D, D, EPI_ADD);
        rmsnorm(s, x, D, 1, D, in[5] + l * D, B0, D, T);
        for (int c = 0; c < 4; ++c) {
            gemm(s, B0, D, in[24] + (size_t)l * D * FF + c * 1024, FF, B1, 1024, T, 1024, D, EPI_SQRELU);
            gemm(s, B1, 1024, in[25] + (size_t)l * FF * D + (size_t)c * 1024 * D, D, x, D, T, D, 1024, EPI_ADD);
        }
    }
}
}

extern "C" void kernel_launch(void* const* d_in, const int* in_sizes, int n_in, void* d_out, int out_size, void* d_ws, size_t ws_size, hipStream_t stream) {
    if (n_in != 26 || out_size != nv::T * nv::D || ws_size < (size_t)240 * (1u << 20)) { fprintf(stderr, "kernel_launch: unexpected shapes n_in %d out %d ws %zu\n", n_in, out_size, ws_size); return; }
    nv::forward(d_in, (float*)d_out, (unsigned char*)d_ws, stream);
}
```

```cpp
#include <hip/hip_runtime.h>
#include <cstdio>
#include <cstdint>

#ifndef MK_N_LAUNCHES
#define MK_N_LAUNCHES 0
#endif

namespace pg8 {
#define PG8_LAS __attribute__((address_space(3)))
typedef unsigned short bf16_t;
typedef short bf16x8 __attribute__((ext_vector_type(8)));
typedef float f32x4 __attribute__((ext_vector_type(4)));
typedef float f32x2 __attribute__((ext_vector_type(2)));
typedef unsigned u32x4 __attribute__((ext_vector_type(4)));
typedef unsigned u32x2 __attribute__((ext_vector_type(2)));
constexpr int BM = 256, BK = 64, HALF = 128, HTB = HALF * BK * 2, STAGE_BYTES = 8 * HTB, NXCD = 8, WGM = 8;

__host__ __device__ __forceinline__ int lds_byte(int r, int c) { const int st = (r >> 4) * 2 + (c >> 5), rr = r & 15, cc = c & 31, ob = rr * 64 + cc * 2; return st * 1024 + (ob ^ (((ob >> 9) & 1) << 5)); }
__host__ __device__ __forceinline__ void stage_rc(int b, int& R, int& C) { const int st = b / 1024, sb = b % 1024, swz = sb ^ (((sb >> 9) & 1) << 5); R = (st >> 1) * 16 + swz / 64; C = (st & 1) * 32 + (swz % 64) / 2; }
__host__ __device__ __forceinline__ int perm32(int rho) { const int n = rho >> 4, i = rho & 15; return 8 * (i >> 2) + 4 * n + (i & 3); }

struct Unit { int pm, pn; };
struct Gemm { const bf16_t* A; const bf16_t* Bt; int lda, ldb, K; int a_pm_mask, a_pn_cols; long b_pn_elems; int b_pm_shift; long b_batch_elems; };

struct StaticOrder {
    int nM, nN, nwg, G, c;
    __host__ __device__ void init(int nM_, int nN_, int G_, int c_) { nM = nM_; nN = nN_; nwg = nM * nN; G = G_; c = c_; }
    __host__ __device__ bool next(int i, Unit& u) const {
        const long L = (long)i * G + c; if (L >= nwg) return false;
        int wgid = (int)L; { const int q = nwg / NXCD, r = nwg % NXCD, xcd = wgid % NXCD, off = wgid / NXCD; wgid = (xcd < r ? xcd * (q + 1) : r * (q + 1) + (xcd - r) * q) + off; }
        const int nig = WGM * nN, gid = wgid / nig, fm = gid * WGM, gsz = (nM - fm) < WGM ? (nM - fm) : WGM;
        u.pm = fm + ((wgid % nig) % gsz); u.pn = (wgid % nig) / gsz; return true;
    }
};

__device__ __forceinline__ unsigned cvt_pk_bf16(float lo, float hi) { unsigned r; asm volatile("v_cvt_pk_bf16_f32 %0, %1, %2" : "=v"(r) : "v"(lo), "v"(hi)); return r; }

constexpr float EPS = 1e-6f;
template <int MODE> struct EpiBf16 {
    static constexpr bool PERM = true;
    bf16_t* O; int ldc; const float* aux_in; float* aux_out;
    __device__ __forceinline__ void operator()(const f32x4 (&acc)[2][2][4][2], const Unit& u, int wr, int wc, int fr, int fq) const {
        const int row0 = u.pm * BM + wr * 64 + fr, col0 = u.pn * BM + wc * 32 + 8 * fq;
#pragma unroll
        for (int ai = 0; ai < 2; ++ai)
#pragma unroll
            for (int m = 0; m < 4; ++m) {
                const int row = row0 + ai * HALF + m * 16; float f = 1.f;
                if (MODE >= 1 && MODE <= 3) { const f32x4 v = *(const f32x4*)(aux_in + (size_t)row * 16 + fq * 4); float s = (v[0] + v[1]) + (v[2] + v[3]); s += __shfl_xor(s, 16); s += __shfl_xor(s, 32); f = __builtin_amdgcn_rsqf(s * (1.0f / 1024.0f) + EPS); }
                if (MODE == 4) { const f32x4 v = *(const f32x4*)(aux_in + (size_t)row * 16 + u.pn * 4); const float s = (v[0] + v[1]) + (v[2] + v[3]); f = __builtin_amdgcn_rsqf(s * (1.0f / 256.0f) + EPS); }
                if (MODE == 5) { const f32x4 v = *(const f32x4*)(aux_in + (size_t)row * 16 + u.pn * 4); const float s = (v[0] + v[1]) + (v[2] + v[3]); f = 1.0f / s; }
                bf16_t* rowp = O + (size_t)row * ldc + col0; float part = 0.f;
#pragma unroll
                for (int bj = 0; bj < 2; ++bj) { f32x4 v0 = acc[ai][bj][m][0] * f, v1 = acc[ai][bj][m][1] * f;
                    if (MODE == 2) {
#pragma unroll
                        for (int e = 0; e < 4; ++e) { const float a = v0[e] > 0.f ? v0[e] : 0.f, b = v1[e] > 0.f ? v1[e] : 0.f; v0[e] = a * a; v1[e] = b * b; } }
                    if (MODE == 4) {
#pragma unroll
                        for (int e = 0; e < 4; ++e) { v0[e] = __builtin_amdgcn_exp2f(v0[e]); v1[e] = __builtin_amdgcn_exp2f(v1[e]); } }
                    if (MODE == 3) part += (v0[0] * v0[0] + v0[1] * v0[1]) + (v0[2] * v0[2] + v0[3] * v0[3]) + (v1[0] * v1[0] + v1[1] * v1[1]) + (v1[2] * v1[2] + v1[3] * v1[3]);
                    if (MODE == 4) part += (v0[0] + v0[1]) + (v0[2] + v0[3]) + (v1[0] + v1[1]) + (v1[2] + v1[3]);
                    u32x4 w; w.x = cvt_pk_bf16(v0[0], v0[1]); w.y = cvt_pk_bf16(v0[2], v0[3]); w.z = cvt_pk_bf16(v1[0], v1[1]); w.w = cvt_pk_bf16(v1[2], v1[3]);
                    *(u32x4*)(rowp + bj * HALF) = w; }
                if (MODE == 3 || MODE == 4) { part += __shfl_xor(part, 16); part += __shfl_xor(part, 32); if (fq == 0) aux_out[(size_t)row * 16 + u.pn * 4 + wc] = part; }
            }
    }
};
struct EpiRes {
    static constexpr bool PERM = false;
    const float* xin; float* xout; bf16_t* xb; float* ss; const float* scale;
    __device__ __forceinline__ void operator()(const f32x4 (&acc)[2][2][4][2], const Unit& u, int wr, int wc, int fr, int fq) const {
        const int row0 = u.pm * BM + wr * 64 + fr, col0 = u.pn * BM + wc * 32 + 4 * fq;
#pragma unroll
        for (int ai = 0; ai < 2; ++ai)
#pragma unroll
            for (int m = 0; m < 4; ++m) {
                const int row = row0 + ai * HALF + m * 16; const size_t off = (size_t)row * 1024 + col0; float sq = 0.f;
#pragma unroll
                for (int bj = 0; bj < 2; ++bj)
#pragma unroll
                    for (int n = 0; n < 2; ++n) { const int co = bj * HALF + n * 16; f32x4 a = acc[ai][bj][m][n];
                        if (scale) a = a * *(const f32x4*)(scale + col0 + co);
                        const f32x4 x = *(const f32x4*)(xin + off + co) + a; *(f32x4*)(xout + off + co) = x;
                        sq += (x[0] * x[0] + x[1] * x[1]) + (x[2] * x[2] + x[3] * x[3]);
                        u32x2 w; w.x = cvt_pk_bf16(x[0], x[1]); w.y = cvt_pk_bf16(x[2], x[3]); *(u32x2*)(xb + off + co) = w; }
                sq += __shfl_xor(sq, 16); sq += __shfl_xor(sq, 32); if (fq == 0) ss[(size_t)row * 16 + u.pn * 4 + wc] = sq;
                asm volatile("" ::: "memory");
            }
    }
};

template <class Epi, class Sched>
__device__ __forceinline__ void gemm_phase(PG8_LAS unsigned char* lds, const Gemm g, const Sched& S, const Epi& E) {
    int tid_ = threadIdx.x; asm volatile("" : "+v"(tid_));
    const int tid = tid_, wid = __builtin_amdgcn_readfirstlane(tid >> 6), lane = tid & 63, wr = wid >> 2, wc = wid & 3, fr = lane & 15, fq = lane >> 4;
    int K_ = g.K; asm volatile("" : "+s"(K_));
    const int K = K_, nt = K / BK;
    unsigned voffA[2], voffB[2];
#pragma unroll
    for (int i = 0; i < 2; ++i) { int R, C; stage_rc(tid * 16 + i * 8192, R, C); const int Rb = Epi::PERM ? ((R & ~31) + perm32(R & 31)) : R;
        voffA[i] = (unsigned)(R * g.lda + C) * 2u; voffB[i] = (unsigned)(Rb * g.ldb + C) * 2u; }
    const size_t kstep = (size_t)(BK * 2);
    const size_t hstepA = (size_t)HALF * g.lda * 2, hstepB = (size_t)HALF * g.ldb * 2;
    const unsigned ldsw = (unsigned)wid * 1024u;
    const int aoff = lds_byte(wr * 64 + fr, fq * 8), boff = lds_byte(wc * 32 + fr, fq * 8);
#define PG8_SA(b, h) (((b) * 2 + (h)) * HTB)
#define PG8_SB(b, h) ((4 + (b) * 2 + (h)) * HTB)
#define PG8_STAGE(bufoff, gbase, voff) do { _Pragma("unroll") for (int _i = 0; _i < 2; ++_i) \
        __builtin_amdgcn_global_load_lds((const unsigned*)((const char*)(gbase) + (voff)[_i]), (PG8_LAS unsigned*)(lds + (bufoff) + ldsw + _i * 8192), 16, 0, 0); } while (0)
#define PG8_LDA(dst, b, h) do { _Pragma("unroll") for (int m = 0; m < 4; ++m) _Pragma("unroll") for (int k = 0; k < 2; ++k) dst[m][k] = *(const PG8_LAS bf16x8*)(lds + PG8_SA(b, h) + aoff + m * 2048 + k * 1024); } while (0)
#define PG8_LDB(dst, b, h) do { _Pragma("unroll") for (int n = 0; n < 2; ++n) _Pragma("unroll") for (int k = 0; k < 2; ++k) dst[n][k] = *(const PG8_LAS bf16x8*)(lds + PG8_SB(b, h) + boff + n * 2048 + k * 1024); } while (0)
#define PG8_MMA(ai, bj, At, Bt) do { __builtin_amdgcn_s_setprio(1); _Pragma("unroll") for (int m = 0; m < 4; ++m) _Pragma("unroll") for (int n = 0; n < 2; ++n) _Pragma("unroll") for (int k = 0; k < 2; ++k) \
        acc[ai][bj][m][n] = __builtin_amdgcn_mfma_f32_16x16x32_bf16(Bt[n][k], At[m][k], acc[ai][bj][m][n], 0, 0, 0); __builtin_amdgcn_s_setprio(0); } while (0)
#define PG8_WAIT_V(n) asm volatile("s_waitcnt vmcnt(" #n ")" ::: "memory")
#define PG8_WAIT_L(n) asm volatile("s_waitcnt lgkmcnt(" #n ")" ::: "memory")
#define PG8_BAR __builtin_amdgcn_s_barrier()
#define PG8_SCHED __builtin_amdgcn_sched_barrier(0)
#define PG8_APTR(u) ((const char*)g.A + ((size_t)((u).pm & g.a_pm_mask) * 256 * g.lda + (size_t)(u).pn * g.a_pn_cols) * 2)
#define PG8_BPTR(u) ((const char*)g.Bt + ((size_t)(u).pn * g.b_pn_elems + (size_t)((u).pm >> g.b_pm_shift) * g.b_batch_elems) * 2)
    Unit cur, nxt; int ui = 0;
    if (!S.next(0, cur)) return;
    f32x4 acc[2][2][4][2];
#pragma unroll
    for (int a = 0; a < 2; ++a)
#pragma unroll
        for (int b = 0; b < 2; ++b)
#pragma unroll
            for (int m = 0; m < 4; ++m)
#pragma unroll
                for (int n = 0; n < 2; ++n) acc[a][b][m][n] = (f32x4){0.f, 0.f, 0.f, 0.f};
    bf16x8 At[4][2], B0[2][2], B1[2][2];
    const char* cA = PG8_APTR(cur); const char* cB = PG8_BPTR(cur);
    PG8_STAGE(PG8_SB(0, 0), cB, voffB); PG8_STAGE(PG8_SB(0, 1), cB + hstepB, voffB); PG8_STAGE(PG8_SA(0, 0), cA, voffA); PG8_STAGE(PG8_SA(0, 1), cA + hstepA, voffA);
    if (wr == 1) PG8_BAR;
    PG8_WAIT_V(2); PG8_BAR;
    PG8_STAGE(PG8_SB(1, 0), cB + kstep, voffB); PG8_STAGE(PG8_SA(1, 0), cA + kstep, voffA); PG8_STAGE(PG8_SB(1, 1), cB + hstepB + kstep, voffB);
    PG8_WAIT_V(6); PG8_BAR;
    for (;;) {
        const bool has_next = S.next(ui + 1, nxt);
        const char* nA = has_next ? PG8_APTR(nxt) : cA; const char* nB = has_next ? PG8_BPTR(nxt) : cB;
        for (int t = 0; t < nt; t += 2) {
            const bool last = (t == nt - 2);
            const char* a1 = cA + (size_t)(t + 1) * kstep;
            const char* a2 = last ? nA : cA + (size_t)(t + 2) * kstep; const char* b2 = last ? nB : cB + (size_t)(t + 2) * kstep;
            const char* a3 = a2 + kstep; const char* b3 = b2 + kstep;
            PG8_LDB(B0, 0, 0); PG8_LDB(B1, 0, 1); PG8_SCHED; PG8_LDA(At, 0, 0); PG8_STAGE(PG8_SA(1, 1), a1 + hstepA, voffA);
            PG8_WAIT_V(8); PG8_WAIT_L(0); PG8_BAR; PG8_MMA(0, 0, At, B0); PG8_MMA(0, 1, At, B1); PG8_BAR; PG8_SCHED;
            PG8_LDA(At, 0, 1); PG8_STAGE(PG8_SB(0, 0), b2, voffB); PG8_STAGE(PG8_SB(0, 1), b2 + hstepB, voffB); PG8_STAGE(PG8_SA(0, 0), a2, voffA);
            PG8_WAIT_V(8); PG8_WAIT_L(0); PG8_BAR; PG8_MMA(1, 0, At, B0); PG8_MMA(1, 1, At, B1); PG8_BAR; PG8_SCHED;
            PG8_LDB(B0, 1, 0); PG8_LDB(B1, 1, 1); PG8_SCHED; PG8_LDA(At, 1, 0); PG8_STAGE(PG8_SA(0, 1), a2 + hstepA, voffA);
            PG8_WAIT_V(8); PG8_WAIT_L(0); PG8_BAR; PG8_MMA(0, 0, At, B0); PG8_MMA(0, 1, At, B1); PG8_BAR; PG8_SCHED;
            PG8_LDA(At, 1, 1); PG8_STAGE(PG8_SB(1, 0), b3, voffB); PG8_STAGE(PG8_SB(1, 1), b3 + hstepB, voffB); PG8_STAGE(PG8_SA(1, 0), a3, voffA);
            PG8_WAIT_V(8); PG8_WAIT_L(0); PG8_BAR; PG8_MMA(1, 0, At, B0); PG8_MMA(1, 1, At, B1); PG8_BAR; PG8_SCHED;
        }
        if (wr == 0) PG8_BAR;
        E(acc, cur, wr, wc, fr, fq);
        if (!has_next) break;
#pragma unroll
        for (int a = 0; a < 2; ++a)
#pragma unroll
            for (int b = 0; b < 2; ++b)
#pragma unroll
                for (int m = 0; m < 4; ++m)
#pragma unroll
                    for (int n = 0; n < 2; ++n) acc[a][b][m][n] = (f32x4){0.f, 0.f, 0.f, 0.f};
        cur = nxt; cA = nA; cB = nB; ++ui;
        if (wr == 1) PG8_BAR;
    }
    PG8_WAIT_V(0);
    PG8_BAR;
#undef PG8_SA
#undef PG8_SB
#undef PG8_STAGE
#undef PG8_LDA
#undef PG8_LDB
#undef PG8_MMA
#undef PG8_WAIT_V
#undef PG8_WAIT_L
#undef PG8_BAR
#undef PG8_SCHED
#undef PG8_APTR
#undef PG8_BPTR
}
}

constexpr int NWAVES = 8;
constexpr int D = 1024, BATCH = 4, SEQ = 4096, T = BATCH * SEQ, NMEM = 256, TM = BATCH * NMEM, FF = 4096, INC = 2560;
constexpr float EPS = 1e-6f;
constexpr float LOG2E = 1.4426950408889634f;

constexpr size_t MiB = 1u << 20;
constexpr size_t WS_CTL = 0, CTL_ZERO_BYTES = 64 * 1024;
constexpr size_t WS_SS = 1 * MiB, WS_QSS = 2 * MiB, WS_LSUM = 3 * MiB, WS_DEN = 4 * MiB, WS_AEND = 5 * MiB, WS_HEND = 5 * MiB + 256 * 1024;
constexpr size_t WS_GT = 6 * MiB, WS_POOLT = 7 * MiB;
constexpr size_t WS_WIN = 8 * MiB, WS_WOUT = 18 * MiB, WS_WQ = 22 * MiB, WS_WO = 30 * MiB, WS_W1 = 38 * MiB, WS_W2 = 70 * MiB, WS_WKV = 102 * MiB;
constexpr size_t WS_KN = 102 * MiB, WS_VT = 110 * MiB;
constexpr size_t WS_XB = 118 * MiB, WS_Y0 = 118 * MiB, WS_Y1 = 134 * MiB;
constexpr size_t WS_HID = 150 * MiB, WS_PROJ = 150 * MiB, WS_NUM = 230 * MiB, WS_AOUT = 150 * MiB, WS_Q = 182 * MiB, WS_P = 214 * MiB, WS_O = 246 * MiB;
constexpr size_t WS_END = 278 * MiB;
constexpr size_t DO_KVRAW = 0, DO_MEMN = 16 * MiB;

constexpr int RING_BYTES = 131072, LDSCTL_OFF = RING_BYTES, MISC_OFF = LDSCTL_OFF + 320, LDS_BYTES = 147456;

#define GAS __attribute__((address_space(1)))
#define LAS __attribute__((address_space(3)))
typedef unsigned short bf16;
typedef unsigned v4u __attribute__((ext_vector_type(4)));
typedef unsigned v2u __attribute__((ext_vector_type(2)));
typedef float f32x4 __attribute__((ext_vector_type(4)));
typedef short bf16x8 __attribute__((ext_vector_type(8)));
typedef short s16x4 __attribute__((ext_vector_type(4)));
#define LDS_WAIT() asm volatile("s_waitcnt lgkmcnt(0)" ::: "memory")
#define VM_WAIT() asm volatile("s_waitcnt vmcnt(0)" ::: "memory")
__device__ __forceinline__ unsigned pk2(float lo, float hi) { return pg8::cvt_pk_bf16(lo, hi); }
__device__ __forceinline__ float bflo(unsigned w) { return __uint_as_float(w << 16); }
__device__ __forceinline__ float bfhi(unsigned w) { return __uint_as_float(w & 0xffff0000u); }
__device__ __forceinline__ float bf1(bf16 h) { return __uint_as_float((unsigned)h << 16); }
__device__ __forceinline__ bf16 f2bf(float f) { return (bf16)(pg8::cvt_pk_bf16(f, 0.f) & 0xffffu); }

#define XB_TMO      128
#define XB_XCNT(j)  (256  + 64 * (j))
#define XB_XSUB(j)  (1280 + 64 * (j))
#define XB_XGEN(j)  (2304 + 64 * (j))
#define XB_TOP      3328
#define XB_TOPGEN   3392
#define XCD_BAR_WORDS 3456
#define XB_SPIN_CAP (1u << 22)
__device__ __forceinline__ unsigned xb_ld(unsigned* p)              { return __hip_atomic_load(p, __ATOMIC_RELAXED, __HIP_MEMORY_SCOPE_AGENT); }
__device__ __forceinline__ unsigned xb_add(unsigned* p, unsigned v) { return __hip_atomic_fetch_add(p, v, __ATOMIC_RELAXED, __HIP_MEMORY_SCOPE_AGENT); }
__device__ __forceinline__ unsigned xb_xcc_id() { return (unsigned)__builtin_amdgcn_s_getreg((3 << 11) | 20) & 0xFu; }
#define XB_SPIN(cond, bar) do { unsigned _sp = 0; while (cond) { __builtin_amdgcn_s_sleep(1); \
    if ((++_sp & 255u) == 0u) { if (xb_ld(&(bar)[XB_TMO])) break; if (_sp > XB_SPIN_CAP) { atomicAdd(&(bar)[XB_TMO], 1u); break; } } } } while (0)
struct XcdBarrier { unsigned* bar; unsigned x; volatile LAS unsigned* st; };
__device__ __forceinline__ XcdBarrier xcd_barrier_post(unsigned* bar, volatile LAS unsigned* st) {
    XcdBarrier b; b.bar = bar; b.x = xb_xcc_id(); b.st = st;
    if (threadIdx.x == 0) (void)xb_add(&bar[XB_XCNT(b.x)], 1u);
    return b;
}
__device__ __forceinline__ void xcd_barrier_complete(unsigned* bar, unsigned x, unsigned& nloc, unsigned& nx) {
    const unsigned G = gridDim.x * gridDim.y * gridDim.z;
    unsigned sum, cnt, mine, sp = 0u;
    for (;;) {
        sum = 0u; cnt = 0u; mine = 0u;
#pragma unroll
        for (unsigned j = 0; j < 16; ++j) { const unsigned c = xb_ld(&bar[XB_XCNT(j)]); sum += c; cnt += (c > 0u) ? 1u : 0u; mine = (j == x) ? c : mine; }
        if (sum == G) break;
        __builtin_amdgcn_s_sleep(1);
        if ((++sp & 255u) == 0u) { if (xb_ld(&bar[XB_TMO])) break; if (sp > XB_SPIN_CAP) { atomicAdd(&bar[XB_TMO], 1u); break; } }
    }
    nloc = mine > 0u ? mine : 1u; nx = cnt > 0u ? cnt : 1u;
}
__device__ __forceinline__ void xcd_barrier(const XcdBarrier& b) {
    asm volatile("s_waitcnt vmcnt(0)" ::: "memory");
    __syncthreads();
    if (threadIdx.x == 0) {
        unsigned* bar = b.bar;
        __builtin_amdgcn_s_waitcnt(0);
        unsigned nloc = b.st[0], nx = b.st[1];
        if (nloc == 0u) { xcd_barrier_complete(bar, b.x, nloc, nx); b.st[0] = nloc; b.st[1] = nx; }
        const unsigned old = xb_add(&bar[XB_XSUB(b.x)], 1u);
        const unsigned gen = old / nloc;
        if (old + 1u == (gen + 1u) * nloc) {
            __builtin_amdgcn_fence(__ATOMIC_RELEASE, "agent");
            asm volatile("s_waitcnt vmcnt(0)" ::: "memory");
            const unsigned og = xb_add(&bar[XB_TOP], 1u);
            const unsigned tg = og / nx;
            if (og + 1u == (tg + 1u) * nx) xb_add(&bar[XB_TOPGEN], 1u);
            else XB_SPIN(xb_ld(&bar[XB_TOPGEN]) == tg, bar);
            __builtin_amdgcn_fence(__ATOMIC_ACQUIRE, "agent");
            xb_add(&bar[XB_XGEN(b.x)], 1u);
            asm volatile("s_waitcnt vmcnt(0)" ::: "memory");
        } else {
            XB_SPIN(xb_ld(&bar[XB_XGEN(b.x)]) == gen, bar);
            __builtin_amdgcn_fence(__ATOMIC_ACQUIRE, "agent");
            asm volatile("s_waitcnt vmcnt(0)" ::: "memory");
        }
    }
    __syncthreads();
}

__device__ __forceinline__ float wave_sum(float v) {
#pragma unroll
    for (int o = 1; o < 64; o <<= 1) v += __shfl_xor(v, o);
    return v;
}

__device__ __forceinline__ void p0_transpose_item(const float* W, int K, int N, bf16* WT, const float* gain, LAS float* scr, int item, int lane) {
    const int nblk = N / 32, kb = item / nblk, nb = item % nblk, k0 = 64 * kb, n0 = 32 * nb;
#pragma unroll 8
    for (int i = 0; i < 32; ++i) { const int kk = 2 * i + (lane >> 5); float v = W[(size_t)(k0 + kk) * N + n0 + (lane & 31)]; if (gain) v *= gain[k0 + kk]; scr[kk * 33 + (lane & 31)] = v; }
    LDS_WAIT(); asm volatile("" ::: "memory");
    const int c = lane & 7;
#pragma unroll
    for (int j = 0; j < 4; ++j) { const int n = (lane >> 3) + 8 * j; const LAS float* s = scr + (8 * c) * 33 + n;
        v4u o; o.x = pk2(s[0 * 33], s[1 * 33]); o.y = pk2(s[2 * 33], s[3 * 33]); o.z = pk2(s[4 * 33], s[5 * 33]); o.w = pk2(s[6 * 33], s[7 * 33]);
        *(GAS v4u*)(WT + (size_t)(n0 + n) * K + k0 + 8 * c) = o; }
    LDS_WAIT(); asm volatile("" ::: "memory");
}

struct Ptrs {
    const float* in[26]; float* out; unsigned char* ws;
};

struct Args { Ptrs p; int ph_lo, ph_hi; };
__device__ __forceinline__ const float* ld_in(const Args& a, int i) { asm volatile("" : "+s"(i)); return a.p.in[i]; }
__device__ __forceinline__ float* ld_out(const Args& a) { int i = 0; asm volatile("" : "+s"(i)); return (&a.p.out)[i]; }
__device__ __forceinline__ unsigned char* ld_ws(const Args& a) { int i = 0; asm volatile("" : "+s"(i)); return (&a.p.ws)[i]; }
#define INP(i) ld_in(args, (i))
#define OUTP() ld_out(args)
__device__ __forceinline__ void p0_prologue(const Args& args, LAS unsigned char* lds, int gw, int NGW, int wave) {
    int tid_ = threadIdx.x; asm volatile("" : "+v"(tid_)); const int lane = tid_ & 63;
    LAS float* scr = (LAS float*)(lds + wave * 16384);
    unsigned char* ws = ld_ws(args);
    constexpr int I_WIN = 16 * 80, I_SQ = 16 * 32, I_G = 2 * 4, I_POOL = 4 * 8, I_KV = 16 * 64, I_W1 = 16 * 128, I_W2 = 64 * 32;
    constexpr int NITEMS = 2 * I_WIN + 2 * I_SQ + 16 * I_G + 8 * I_POOL + 4 * I_SQ + 4 * I_KV + 4 * I_SQ + 4 * I_W1 + 4 * I_W2;
    for (int it = gw; it < NITEMS; it += NGW) {
        int r = it;
        if (r < 4 * I_W1) { const int l = r / I_W1; p0_transpose_item(INP(24) + (size_t)l * D * FF, D, FF, (bf16*)(ws + WS_W1) + (size_t)l * FF * D, INP(5) + l * D, scr, r % I_W1, lane); continue; } r -= 4 * I_W1;
        if (r < 4 * I_W2) { const int l = r / I_W2; p0_transpose_item(INP(25) + (size_t)l * FF * D, FF, D, (bf16*)(ws + WS_W2) + (size_t)l * D * FF, nullptr, scr, r % I_W2, lane); continue; } r -= 4 * I_W2;
        if (r < 4 * I_KV) { const int l = r / I_KV; p0_transpose_item(INP(20) + (size_t)l * D * 2048, D, 2048, (bf16*)(ws + WS_WKV) + (size_t)l * 2048 * D, nullptr, scr, r % I_KV, lane); continue; } r -= 4 * I_KV;
        if (r < 2 * I_WIN) { const int e = r / I_WIN; p0_transpose_item(INP(6) + (size_t)e * D * INC, D, INC, (bf16*)(ws + WS_WIN) + (size_t)e * INC * D, INP(3) + (2 * e) * D, scr, r % I_WIN, lane); continue; } r -= 2 * I_WIN;
        if (r < 2 * I_SQ) { const int e = r / I_SQ; p0_transpose_item(INP(16) + (size_t)e * D * D, D, D, (bf16*)(ws + WS_WOUT) + (size_t)e * D * D, nullptr, scr, r % I_SQ, lane); continue; } r -= 2 * I_SQ;
        if (r < 4 * I_SQ) { const int l = r / I_SQ; p0_transpose_item(INP(19) + (size_t)l * D * D, D, D, (bf16*)(ws + WS_WQ) + (size_t)l * D * D, INP(4) + l * D, scr, r % I_SQ, lane); continue; } r -= 4 * I_SQ;
        if (r < 4 * I_SQ) { const int l = r / I_SQ; p0_transpose_item(INP(23) + (size_t)l * D * D, D, D, (bf16*)(ws + WS_WO) + (size_t)l * D * D, nullptr, scr, r % I_SQ, lane); continue; } r -= 4 * I_SQ;
        if (r < 8 * I_POOL) { const int mat = r / I_POOL, o = mat >> 2, g = mat & 3; p0_transpose_item(INP(17) + (size_t)mat * 65536, 256, 256, (bf16*)(ws + WS_POOLT) + (size_t)mat * 65536, INP(3) + (2 * o + 1) * D + g * 256, scr, r % I_POOL, lane); continue; } r -= 8 * I_POOL;
        { const int mat = r / I_G, kind = mat >> 3, eg = mat & 7, e = eg >> 2, g = eg & 3;
          p0_transpose_item((kind ? INP(13) : INP(11)) + (size_t)eg * 16384, 128, 128, (bf16*)(ws + WS_GT) + (size_t)((e * 2 + kind) * 4 + g) * 16384, nullptr, scr, r % I_G, lane); }
    }
    for (int m = gw; m < T; m += NGW) {
        const GAS f32x4* xr = (const GAS f32x4*)(INP(0) + (size_t)m * D) + lane; f32x4 v[4]; float s = 0.f;
#pragma unroll
        for (int j = 0; j < 4; ++j) { v[j] = xr[64 * j]; s += (v[j][0] * v[j][0] + v[j][1] * v[j][1]) + (v[j][2] * v[j][2] + v[j][3] * v[j][3]); }
        s = wave_sum(s);
        GAS v2u* o8 = (GAS v2u*)((bf16*)(ws + WS_XB) + (size_t)m * D) + lane;
#pragma unroll
        for (int j = 0; j < 4; ++j) { v2u w; w.x = pk2(v[j][0], v[j][1]); w.y = pk2(v[j][2], v[j][3]); o8[64 * j] = w; }
        if (lane < 16) ((float*)(ws + WS_SS))[(size_t)m * 16 + lane] = lane == 0 ? s : 0.f;
    }
    for (int m = gw; m < TM; m += NGW) {
        const GAS f32x4* xr = (const GAS f32x4*)(INP(1) + (size_t)m * D) + lane; const GAS f32x4* gr = (const GAS f32x4*)(INP(2)) + lane; f32x4 v[4]; float s = 0.f;
#pragma unroll
        for (int j = 0; j < 4; ++j) { v[j] = xr[64 * j]; s += (v[j][0] * v[j][0] + v[j][1] * v[j][1]) + (v[j][2] * v[j][2] + v[j][3] * v[j][3]); }
        const float rs = 1.0f / sqrtf(wave_sum(s) * (1.0f / D) + EPS);
        GAS v2u* o8 = (GAS v2u*)((bf16*)((unsigned char*)OUTP() + DO_MEMN) + (size_t)m * D) + lane;
#pragma unroll
        for (int j = 0; j < 4; ++j) { const f32x4 gg = gr[64 * j]; v2u w; w.x = pk2(v[j][0] * rs * gg[0], v[j][1] * rs * gg[1]); w.y = pk2(v[j][2] * rs * gg[2], v[j][3] * rs * gg[3]); o8[64 * j] = w; }
    }
}

__device__ __forceinline__ void kv_finalize(const Args& args, int gw, int NGW) {
    int tid_ = threadIdx.x; asm volatile("" : "+v"(tid_)); const int lane = tid_ & 63;
    const bf16* kvraw = (const bf16*)((unsigned char*)OUTP() + DO_KVRAW);
    bf16* Kn = (bf16*)(ld_ws(args) + WS_KN); bf16* Vt = (bf16*)(ld_ws(args) + WS_VT);
    for (int row = gw; row < 4 * TM * 4; row += NGW) {
        const int l = row >> 12, m = (row >> 2) & 1023, h = row & 3, b = m >> 8, key = m & 255;
        const v2u w = *(const GAS v2u*)(kvraw + ((size_t)(l * TM + m)) * 2048 + h * 256 + 4 * lane);
        const float k0 = bflo(w.x), k1 = bfhi(w.x), k2 = bflo(w.y), k3 = bfhi(w.y);
        const float ss = wave_sum((k0 * k0 + k1 * k1) + (k2 * k2 + k3 * k3));
        const float sc = (1.0f / sqrtf(ss * (1.0f / 256.0f) + EPS)) * (0.0625f * LOG2E);
        const f32x4 gk = *(const GAS f32x4*)(INP(22) + l * 256 + 4 * lane), gq = *(const GAS f32x4*)(INP(21) + l * 256 + 4 * lane);
        v2u o; o.x = pk2(k0 * sc * gk[0] * gq[0], k1 * sc * gk[1] * gq[1]); o.y = pk2(k2 * sc * gk[2] * gq[2], k3 * sc * gk[3] * gq[3]);
        *(GAS v2u*)(Kn + ((size_t)((l * 4 + b) * 4 + h) * 256 + key) * 256 + 4 * lane) = o;
    }
    for (int it = gw; it < 256; it += NGW) {
        const int l = it >> 6, b = (it >> 4) & 3, h = (it >> 2) & 3, kb = it & 3, key = 64 * kb + lane;
        const bf16* src = kvraw + ((size_t)(l * TM + b * 256 + key)) * 2048 + 1024 + h * 256;
        bf16* dst = Vt + ((size_t)((l * 4 + b) * 4 + h) * 256) * 256 + key;
        for (int dc = 0; dc < 32; ++dc) { const v4u w = *(const GAS v4u*)(src + 8 * dc);
            dst[(size_t)(8 * dc + 0) * 256] = (bf16)(w.x & 0xffffu); dst[(size_t)(8 * dc + 1) * 256] = (bf16)(w.x >> 16);
            dst[(size_t)(8 * dc + 2) * 256] = (bf16)(w.y & 0xffffu); dst[(size_t)(8 * dc + 3) * 256] = (bf16)(w.y >> 16);
            dst[(size_t)(8 * dc + 4) * 256] = (bf16)(w.z & 0xffffu); dst[(size_t)(8 * dc + 5) * 256] = (bf16)(w.z >> 16);
            dst[(size_t)(8 * dc + 6) * 256] = (bf16)(w.w & 0xffffu); dst[(size_t)(8 * dc + 7) * 256] = (bf16)(w.w >> 16); }
    }
}

__device__ __forceinline__ void attn_unit(LAS unsigned char* lds, const bf16* proj, const float* gq, const float* gk, bf16* num, float* den, int uid, int tid) {
    asm volatile("" : "+v"(tid));
    const int g = uid >> 9, rem = uid & 511, bh = rem >> 5, j = rem & 31;
    const int dsh = 2 * g, d = 1 << dsh, n = j >> dsh, r = j & (d - 1), b = bh >> 2, h = bh & 3;
    const int base = n * (128 << dsh) + r;
    const size_t rowb = (size_t)b * SEQ;
    {
        const int c = tid & 15;
        const f32x4 ga = *(const GAS f32x4*)(gk + 8 * c), gb = *(const GAS f32x4*)(gk + 8 * c + 4);
        v4u kk[8], vv[8];
#pragma unroll
        for (int i = 0; i < 8; ++i) { const int kj = (tid >> 4) + 32 * i, pos = base + (kj - 128) * d;
            if (pos >= 0) { const bf16* p = proj + (rowb + pos) * INC + 512 + h * 128 + 8 * c; kk[i] = *(const GAS v4u*)p; vv[i] = *(const GAS v4u*)(p + 512); }
            else { kk[i] = (v4u){0u, 0u, 0u, 0u}; vv[i] = (v4u){0u, 0u, 0u, 0u}; } }
#pragma unroll
        for (int i = 0; i < 8; ++i) { const int kj = (tid >> 4) + 32 * i;
            const float a0 = bflo(kk[i].x), a1 = bfhi(kk[i].x), a2 = bflo(kk[i].y), a3 = bfhi(kk[i].y), a4 = bflo(kk[i].z), a5 = bfhi(kk[i].z), a6 = bflo(kk[i].w), a7 = bfhi(kk[i].w);
            float ss = ((a0 * a0 + a1 * a1) + (a2 * a2 + a3 * a3)) + ((a4 * a4 + a5 * a5) + (a6 * a6 + a7 * a7));
            ss += __shfl_xor(ss, 1); ss += __shfl_xor(ss, 2); ss += __shfl_xor(ss, 4); ss += __shfl_xor(ss, 8);
            const float rk = __builtin_amdgcn_rsqf(ss * (1.0f / 128.0f) + EPS);
            v4u o; o.x = pk2(a0 * rk * ga[0], a1 * rk * ga[1]); o.y = pk2(a2 * rk * ga[2], a3 * rk * ga[3]); o.z = pk2(a4 * rk * gb[0], a5 * rk * gb[1]); o.w = pk2(a6 * rk * gb[2], a7 * rk * gb[3]);
            *(LAS v4u*)(lds + kj * 256 + ((c ^ (kj & 15)) << 4)) = o;
            *(LAS v4u*)(lds + 65536 + kj * 256 + ((c ^ ((kj & 7) << 1)) << 4)) = vv[i]; }
    }
    const int w = tid >> 6, lane = tid & 63, q = lane & 15, G = lane >> 4;
    const size_t qrow = rowb + base + (size_t)(16 * w + q) * d;
    bf16x8 Qf[4];
    {
        v4u qq[4]; float ss = 0.f;
#pragma unroll
        for (int ks = 0; ks < 4; ++ks) { qq[ks] = *(const GAS v4u*)(proj + qrow * INC + h * 128 + 32 * ks + 8 * G);
            const float a0 = bflo(qq[ks].x), a1 = bfhi(qq[ks].x), a2 = bflo(qq[ks].y), a3 = bfhi(qq[ks].y), a4 = bflo(qq[ks].z), a5 = bfhi(qq[ks].z), a6 = bflo(qq[ks].w), a7 = bfhi(qq[ks].w);
            ss += ((a0 * a0 + a1 * a1) + (a2 * a2 + a3 * a3)) + ((a4 * a4 + a5 * a5) + (a6 * a6 + a7 * a7)); }
        ss += __shfl_xor(ss, 16); ss += __shfl_xor(ss, 32);
        const float rq = __builtin_amdgcn_rsqf(ss * (1.0f / 128.0f) + EPS) * (0.08838834764831845f * LOG2E);
#pragma unroll
        for (int ks = 0; ks < 4; ++ks) { const f32x4 ga = *(const GAS f32x4*)(gq + 32 * ks + 8 * G), gb = *(const GAS f32x4*)(gq + 32 * ks + 8 * G + 4);
            v4u o; o.x = pk2(bflo(qq[ks].x) * rq * ga[0], bfhi(qq[ks].x) * rq * ga[1]); o.y = pk2(bflo(qq[ks].y) * rq * ga[2], bfhi(qq[ks].y) * rq * ga[3]);
            o.z = pk2(bflo(qq[ks].z) * rq * gb[0], bfhi(qq[ks].z) * rq * gb[1]); o.w = pk2(bflo(qq[ks].w) * rq * gb[2], bfhi(qq[ks].w) * rq * gb[3]);
            Qf[ks] = __builtin_bit_cast(bf16x8, o); }
    }
    __syncthreads();
    f32x4 s[9];
#pragma unroll
    for (int t = 0; t < 9; ++t) { s[t] = (f32x4){0.f, 0.f, 0.f, 0.f}; const int krow = 16 * (w + t) + q;
#pragma unroll
        for (int ks = 0; ks < 4; ++ks) { const bf16x8 Kf = *(const LAS bf16x8*)(lds + krow * 256 + (((4 * ks + G) ^ q) << 4));
            s[t] = __builtin_amdgcn_mfma_f32_16x16x32_bf16(Kf, Qf[ks], s[t], 0, 0, 0); } }
    float dsum = 0.f; const bool first = (n == 0);
#pragma unroll
    for (int t = 0; t < 9; ++t)
#pragma unroll
        for (int e = 0; e < 4; ++e) { const int kk = 4 * G + e; bool ok = true;
            if (t == 0) ok = kk >= q; if (t == 8) ok = kk <= q; if (first && (w + t) < 8) ok = false;
            const float p = ok ? __builtin_amdgcn_exp2f(s[t][e]) : 0.f; s[t][e] = p; dsum += p; }
    dsum += __shfl_xor(dsum, 16); dsum += __shfl_xor(dsum, 32);
    f32x4 o[8];
#pragma unroll
    for (int nt = 0; nt < 8; ++nt) o[nt] = (f32x4){0.f, 0.f, 0.f, 0.f};
    const int q4 = q >> 2, pp = q & 3;
#pragma unroll
    for (int si = 0; si < 5; ++si) {
        v4u pw; pw.x = pk2(s[2 * si][0], s[2 * si][1]); pw.y = pk2(s[2 * si][2], s[2 * si][3]);
        if (si < 4) { pw.z = pk2(s[2 * si + 1][0], s[2 * si + 1][1]); pw.w = pk2(s[2 * si + 1][2], s[2 * si + 1][3]); } else { pw.z = 0u; pw.w = 0u; }
        const bf16x8 Pf = __builtin_bit_cast(bf16x8, pw);
        const int key0 = 16 * (w + 2 * si) + 4 * G + q4, key1 = (si < 4) ? key0 + 16 : key0;
        const int sw0 = (key0 & 7) << 1, sw1 = (key1 & 7) << 1;
#pragma unroll
        for (int nt = 0; nt < 8; ++nt) { const int chunk = 2 * nt + (pp >> 1);
            const s16x4 v0 = __builtin_bit_cast(s16x4, __builtin_amdgcn_ds_read_tr16_b64_v4i16((LAS s16x4*)(lds + 65536 + key0 * 256 + ((chunk ^ sw0) << 4) + (pp & 1) * 8)));
            const s16x4 v1 = __builtin_bit_cast(s16x4, __builtin_amdgcn_ds_read_tr16_b64_v4i16((LAS s16x4*)(lds + 65536 + key1 * 256 + ((chunk ^ sw1) << 4) + (pp & 1) * 8)));
            const bf16x8 Vf = (bf16x8){v0[0], v0[1], v0[2], v0[3], v1[0], v1[1], v1[2], v1[3]};
            o[nt] = __builtin_amdgcn_mfma_f32_16x16x32_bf16(Vf, Pf, o[nt], 0, 0, 0); }
    }
    bf16* np = num + ((size_t)g * T + qrow) * 512 + h * 128 + 4 * G;
#pragma unroll
    for (int nt = 0; nt < 8; ++nt) { v2u wv; wv.x = pk2(o[nt][0], o[nt][1]); wv.y = pk2(o[nt][2], o[nt][3]); *(GAS v2u*)(np + 16 * nt) = wv; }
    if (G == 0) den[((size_t)g * T + qrow) * 4 + h] = dsum;
    __syncthreads();
}

__device__ __forceinline__ float sigmoidf_(float x) { return 1.0f / (1.0f + __expf(-x)); }
__device__ __forceinline__ float gelu_tanh(float x) { const float u = 0.7978845608028654f * (x + 0.044715f * x * x * x); const float e = __expf(2.0f * u); return x * (1.0f - 1.0f / (e + 1.0f)); }
__device__ __forceinline__ void r1_unit(LAS unsigned char* lds, const bf16* proj, const float* cw, const float* cb, const bf16* GaT, const bf16* GxT, const float* ba, const float* bx, const float* lam,
                                        bf16* Y0, bf16* Y1, float* Aend, float* Hend, int uid, int tid) {
    asm volatile("" : "+v"(tid));
    const int g = uid & 3, chunk = (uid >> 2) & 31, b = uid >> 7, t0 = chunk * 128;
    const size_t rowb = (size_t)b * SEQ;
    LAS unsigned char* lxc = lds; LAS unsigned char* lgt = lds + 32768; LAS float* sumA = (LAS float*)(lds + 65536); LAS float* sumH = (LAS float*)(lds + 65536 + 4096);
    {
        const int c8 = tid & 15, ch0 = 128 * g + 8 * c8;
        float wj[4][8], bb[8];
#pragma unroll
        for (int jj = 0; jj < 4; ++jj) { const f32x4 a = *(const GAS f32x4*)(cw + jj * 512 + ch0), c = *(const GAS f32x4*)(cw + jj * 512 + ch0 + 4);
            wj[jj][0] = a[0]; wj[jj][1] = a[1]; wj[jj][2] = a[2]; wj[jj][3] = a[3]; wj[jj][4] = c[0]; wj[jj][5] = c[1]; wj[jj][6] = c[2]; wj[jj][7] = c[3]; }
        { const f32x4 a = *(const GAS f32x4*)(cb + ch0), c = *(const GAS f32x4*)(cb + ch0 + 4); bb[0] = a[0]; bb[1] = a[1]; bb[2] = a[2]; bb[3] = a[3]; bb[4] = c[0]; bb[5] = c[1]; bb[6] = c[2]; bb[7] = c[3]; }
#pragma unroll
        for (int i = 0; i < 4; ++i) { const int tt = (tid >> 4) + 32 * i, t = t0 + tt;
            float a[8];
#pragma unroll
            for (int e = 0; e < 8; ++e) a[e] = bb[e];
#pragma unroll
            for (int jj = 0; jj < 4; ++jj) { const int ts = t - 3 + jj;
                if (ts >= 0) { const v4u x = *(const GAS v4u*)(proj + (rowb + ts) * INC + 1536 + ch0);
                    a[0] += wj[jj][0] * bflo(x.x); a[1] += wj[jj][1] * bfhi(x.x); a[2] += wj[jj][2] * bflo(x.y); a[3] += wj[jj][3] * bfhi(x.y);
                    a[4] += wj[jj][4] * bflo(x.z); a[5] += wj[jj][5] * bfhi(x.z); a[6] += wj[jj][6] * bflo(x.w); a[7] += wj[jj][7] * bfhi(x.w); } }
            v4u o; o.x = pk2(a[0], a[1]); o.y = pk2(a[2], a[3]); o.z = pk2(a[4], a[5]); o.w = pk2(a[6], a[7]);
            *(LAS v4u*)(lxc + tt * 256 + ((c8 ^ (tt & 15)) << 4)) = o;
            *(LAS v4u*)(lgt + tt * 256 + ((c8 ^ (tt & 15)) << 4)) = *(const GAS v4u*)(proj + (rowb + t) * INC + 2048 + ch0); }
    }
    __syncthreads();
    const int w = tid >> 6, lane = tid & 63, q = lane & 15, G = lane >> 4;
    bf16x8 Xf[4];
#pragma unroll
    for (int ks = 0; ks < 4; ++ks) Xf[ks] = *(const LAS bf16x8*)(lxc + (16 * w + q) * 256 + (((4 * ks + G) ^ q) << 4));
    float Ac[8][4], Hc[8][4];
#pragma unroll
    for (int nt = 0; nt < 8; ++nt) {
        const int dd = 16 * nt + q, ch = 128 * g + dd;
        f32x4 aA = (f32x4){0.f, 0.f, 0.f, 0.f}, aX = (f32x4){0.f, 0.f, 0.f, 0.f};
#pragma unroll
        for (int ks = 0; ks < 4; ++ks) { const bf16x8 Wa = __builtin_bit_cast(bf16x8, *(const GAS v4u*)(GaT + dd * 128 + 32 * ks + 8 * G)), Wx = __builtin_bit_cast(bf16x8, *(const GAS v4u*)(GxT + dd * 128 + 32 * ks + 8 * G));
            aA = __builtin_amdgcn_mfma_f32_16x16x32_bf16(Xf[ks], Wa, aA, 0, 0, 0); aX = __builtin_amdgcn_mfma_f32_16x16x32_bf16(Xf[ks], Wx, aX, 0, 0, 0); }
        const float bav = ba[ch], bxv = bx[ch], lv = lam[ch]; const float sp8 = 8.0f * __logf(1.0f + __expf(-lv));
        float Arun = 1.f, Hrun = 0.f;
#pragma unroll
        for (int e = 0; e < 4; ++e) { const int tt = 16 * w + 4 * G + e;
            const float xcv = bf1(*(const LAS bf16*)(lxc + tt * 256 + (((dd >> 3) ^ (tt & 15)) << 4) + (dd & 7) * 2));
            const float rg = sigmoidf_(aA[e] + bav), ig = sigmoidf_(aX[e] + bxv), la = -sp8 * rg, a = __expf(la), u = sqrtf(-expm1f(2.0f * la)) * (ig * xcv);
            Hrun = a * Hrun + u; Arun = a * Arun; Ac[nt][e] = Arun; Hc[nt][e] = Hrun; }
        float Ai = Arun, Hi = Hrun;
        { const float Ap = __shfl_up(Ai, 16), Hp = __shfl_up(Hi, 16); if (G >= 1) { Hi = Ai * Hp + Hi; Ai = Ai * Ap; } }
        { const float Ap = __shfl_up(Ai, 32), Hp = __shfl_up(Hi, 32); if (G >= 2) { Hi = Ai * Hp + Hi; Ai = Ai * Ap; } }
        float Ae = __shfl_up(Ai, 16), He = __shfl_up(Hi, 16); if (G == 0) { Ae = 1.f; He = 0.f; }
#pragma unroll
        for (int e = 0; e < 4; ++e) { Hc[nt][e] = Hc[nt][e] + Ac[nt][e] * He; Ac[nt][e] = Ac[nt][e] * Ae; }
        if (G == 3) { sumA[w * 128 + dd] = Ai; sumH[w * 128 + dd] = Hi; }
    }
    __syncthreads();
#pragma unroll
    for (int nt = 0; nt < 8; ++nt) {
        const int dd = 16 * nt + q, ch = 128 * g + dd;
        float Ain = 1.f, Hin = 0.f;
        for (int w2 = 0; w2 < w; ++w2) { const float sa = sumA[w2 * 128 + dd], sh = sumH[w2 * 128 + dd]; Hin = sa * Hin + sh; Ain = sa * Ain; }
        if (w == 7 && G == 3) { const float sa = sumA[7 * 128 + dd], sh = sumH[7 * 128 + dd]; Aend[(size_t)(b * 32 + chunk) * 512 + ch] = sa * Ain; Hend[(size_t)(b * 32 + chunk) * 512 + ch] = sa * Hin + sh; }
#pragma unroll
        for (int e = 0; e < 4; ++e) { const int tt = 16 * w + 4 * G + e;
            const float gt = bf1(*(const LAS bf16*)(lgt + tt * 256 + (((dd >> 3) ^ (tt & 15)) << 4) + (dd & 7) * 2)); const float gg = gelu_tanh(gt);
            const float Pv = Ac[nt][e] * Ain, hl = Hc[nt][e] + Ac[nt][e] * Hin;
            const size_t off = (rowb + t0 + tt) * 512 + ch; Y0[off] = f2bf(hl * gg); Y1[off] = f2bf(Pv * gg); }
    }
    __syncthreads();
}

__device__ __forceinline__ void post_unit(LAS unsigned char* lds, const bf16* num, const float* den, const bf16* Y0, const bf16* Y1, const float* Aend, const float* Hend, bf16* aout, int uid, int tid) {
    asm volatile("" : "+v"(tid));
    const int row0 = uid * 64, b = row0 >> 12, chunk = (row0 & 4095) >> 7;
    LAS float* hin = (LAS float*)lds;
    { float H = 0.f; const float* ae = Aend + (size_t)(b * 32) * 512 + tid; const float* he = Hend + (size_t)(b * 32) * 512 + tid;
      for (int s = 0; s < chunk; ++s) H = ae[(size_t)s * 512] * H + he[(size_t)s * 512];
      hin[tid] = H; }
    __syncthreads();
    const int c8 = tid & 63, rsub = tid >> 6;
    float hv[8];
#pragma unroll
    for (int e = 0; e < 8; ++e) hv[e] = hin[8 * c8 + e];
#pragma unroll
    for (int i = 0; i < 8; ++i) { const size_t row = row0 + rsub + 8 * i;
        {
            const v4u a = *(const GAS v4u*)(Y0 + row * 512 + 8 * c8), p = *(const GAS v4u*)(Y1 + row * 512 + 8 * c8); v4u o;
            o.x = pk2(bflo(a.x) + bflo(p.x) * hv[0], bfhi(a.x) + bfhi(p.x) * hv[1]); o.y = pk2(bflo(a.y) + bflo(p.y) * hv[2], bfhi(a.y) + bfhi(p.y) * hv[3]);
            o.z = pk2(bflo(a.z) + bflo(p.z) * hv[4], bfhi(a.z) + bfhi(p.z) * hv[5]); o.w = pk2(bflo(a.w) + bflo(p.w) * hv[6], bfhi(a.w) + bfhi(p.w) * hv[7]);
            *(GAS v4u*)(aout + row * 1024 + 512 + 8 * c8) = o; }
        {
            const int h = c8 >> 4;
            const float dn = den[((size_t)0 * T + row) * 4 + h] + den[((size_t)1 * T + row) * 4 + h] + den[((size_t)2 * T + row) * 4 + h]; const float inv = 1.0f / dn;
            const v4u a = *(const GAS v4u*)(num + ((size_t)0 * T + row) * 512 + 8 * c8), bq = *(const GAS v4u*)(num + ((size_t)1 * T + row) * 512 + 8 * c8), c = *(const GAS v4u*)(num + ((size_t)2 * T + row) * 512 + 8 * c8); v4u o;
            o.x = pk2((bflo(a.x) + bflo(bq.x) + bflo(c.x)) * inv, (bfhi(a.x) + bfhi(bq.x) + bfhi(c.x)) * inv); o.y = pk2((bflo(a.y) + bflo(bq.y) + bflo(c.y)) * inv, (bfhi(a.y) + bfhi(bq.y) + bfhi(c.y)) * inv);
            o.z = pk2((bflo(a.z) + bflo(bq.z) + bflo(c.z)) * inv, (bfhi(a.z) + bfhi(bq.z) + bfhi(c.z)) * inv); o.w = pk2((bflo(a.w) + bflo(bq.w) + bflo(c.w)) * inv, (bfhi(a.w) + bfhi(bq.w) + bfhi(c.w)) * inv);
            *(GAS v4u*)(aout + row * 1024 + 8 * c8) = o; }
    }
    __syncthreads();
}

__device__ __forceinline__ void poolprep_unit(LAS unsigned char* lds, const float* x, const float* ss, bf16* dd, int uid, int tid) {
    asm volatile("" : "+v"(tid));
    const int row0 = uid * 64, tb = row0 & 4095;
    LAS float* rs = (LAS float*)lds;
    if (tid < 79) { const int t = tb - 15 + tid; float r = 0.f;
        if (t >= 0) { const float* p = ss + (size_t)(row0 - 15 + tid) * 16; float s = 0.f;
#pragma unroll
            for (int e = 0; e < 16; ++e) s += p[e];
            r = 1.0f / sqrtf(s * (1.0f / 1024.0f) + EPS); }
        rs[tid] = r; }
    __syncthreads();
    const int c4 = tid & 255, half = tid >> 8, c = 4 * c4, wlen = 2 << (c >> 8);
    const int ts = tb + 32 * half;
    f32x4 sum = (f32x4){0.f, 0.f, 0.f, 0.f};
    for (int i = 1; i < wlen; ++i) { const int t = ts - i; if (t >= 0) sum += *(const GAS f32x4*)(x + (size_t)(row0 + 32 * half - i) * 1024 + c) * rs[15 + 32 * half - i]; }
    for (int k = 0; k < 32; ++k) { const int t = ts + k; const size_t row = (size_t)row0 + 32 * half + k;
        const f32x4 hcur = *(const GAS f32x4*)(x + row * 1024 + c) * rs[15 + 32 * half + k];
        sum += hcur;
        const int cnt = (t + 1 < wlen) ? t + 1 : wlen; const float inv = 1.0f / (float)cnt;
        const f32x4 dv = sum * inv - hcur;
        v2u o; o.x = pk2(dv[0], dv[1]); o.y = pk2(dv[2], dv[3]); *(GAS v2u*)(dd + row * 1024 + c) = o;
        const int told = t - wlen + 1;
        if (told >= 0) sum -= *(const GAS f32x4*)(x + (row - wlen + 1) * 1024 + c) * rs[15 + 32 * half + k - wlen + 1]; }
    __syncthreads();
}

#ifndef MK_TEST
constexpr int N_PHASES = 41;
__global__ void __launch_bounds__(NWAVES * 64, 2) mk_fwd(Args args) {
    extern __shared__ __attribute__((aligned(16))) unsigned char lds_raw[];
    LAS unsigned char* lds = (LAS unsigned char*)lds_raw;
    volatile LAS unsigned* MISC = (volatile LAS unsigned*)(lds + MISC_OFF);
#define ws ld_ws(args)
    const int tid = threadIdx.x, wave = __builtin_amdgcn_readfirstlane(tid >> 6);
    const int G = gridDim.x, bid = blockIdx.x;
    const int vcu = (G % 8 == 0) ? (bid % 8) * (G / 8) + bid / 8 : bid;
    const int gw = vcu * NWAVES + wave, NGW = G * NWAVES;
    for (int u = tid; u < (LDS_BYTES - LDSCTL_OFF) / 4; u += NWAVES * 64) ((LAS unsigned*)(lds + LDSCTL_OFF))[u] = 0u;
    __syncthreads();
    unsigned* ctl = (unsigned*)(ws + WS_CTL);
    XcdBarrier bar; bar.bar = ctl + 1024; bar.x = 0; bar.st = nullptr;
    if (MK_N_LAUNCHES == 1) bar = xcd_barrier_post(ctl + 1024, MISC + 8);
#if MK_N_LAUNCHES != 1
    const int lo = args.ph_lo, hi = args.ph_hi;
#endif
#if MK_N_LAUNCHES == 1
#define IN(k) true
#else
#define IN(k) (lo <= (k) && (k) < hi)
#endif
#define SEAM(k) do { if (MK_N_LAUNCHES == 1 && (k) + 1 < N_PHASES) xcd_barrier(bar); } while (0)

#define SS ((float*)(ws + WS_SS))
#define QSS ((float*)(ws + WS_QSS))
#define LSUM ((float*)(ws + WS_LSUM))
#define DEN ((float*)(ws + WS_DEN))
#define AEND ((float*)(ws + WS_AEND))
#define HEND ((float*)(ws + WS_HEND))
#define XB ((bf16*)(ws + WS_XB))
#define PROJ ((bf16*)(ws + WS_PROJ))
#define NUM ((bf16*)(ws + WS_NUM))
#define AOUT ((bf16*)(ws + WS_AOUT))
#define QB ((bf16*)(ws + WS_Q))
#define PB ((bf16*)(ws + WS_P))
#define OB ((bf16*)(ws + WS_O))
#define HID ((bf16*)(ws + WS_HID))
#define Y0 ((bf16*)(ws + WS_Y0))
#define Y1 ((bf16*)(ws + WS_Y1))
#define KVRAW ((bf16*)((unsigned char*)OUTP() + DO_KVRAW))
#define MEMN ((bf16*)((unsigned char*)OUTP() + DO_MEMN))
#ifndef NO_PRO
    if (IN(0)) { p0_prologue(args, lds, gw, NGW, wave); SEAM(0); }
#endif

    for (int l = 0; l < 4; ++l) {
        const int pb = 1 + 10 * l;
        const float* xin = (l == 0) ? INP(0) : OUTP();
        if ((l & 1) == 0) {
            const int e = l >> 1;
            if (IN(pb + 0)) {
                { pg8::Gemm g{XB, (const bf16*)(ws + WS_WIN) + (size_t)e * INC * D, D, D, D, ~0, 0, (long)256 * D, 30, 0};
                  pg8::StaticOrder S; S.init(T / 256, INC / 256, G, bid);
                  pg8::EpiBf16<1> E{PROJ, INC, SS, nullptr};
                  pg8::gemm_phase(lds, g, S, E); }
                if (l == 0) { pg8::Gemm g{MEMN, (const bf16*)(ws + WS_WKV), D, D, D, 3, 0, (long)256 * D, 2, (long)2048 * D};
                  pg8::StaticOrder S; S.init(16, 8, G - 128, bid >= 128 ? bid - 128 : (1 << 20));
                  pg8::EpiBf16<0> E{KVRAW, 2048, nullptr, nullptr};
                  pg8::gemm_phase(lds, g, S, E); }
                SEAM(pb + 0); }
            if (IN(pb + 1)) {
#ifndef NO_KVF
                if (l == 0) kv_finalize(args, gw, NGW);
#endif
                for (int u = bid; u < 2048; u += G) {
#ifndef NO_ATTN
                    if (u < 1536) attn_unit(lds, PROJ, INP(7) + e * 128, INP(8) + e * 128, NUM, DEN, u, tid);
#endif
#ifndef NO_R1
                    if (u >= 1536) r1_unit(lds, PROJ, INP(9) + e * 2048, INP(10) + e * 512, (const bf16*)(ws + WS_GT) + (size_t)((e * 2 + 0) * 4 + ((u - 1536) & 3)) * 16384, (const bf16*)(ws + WS_GT) + (size_t)((e * 2 + 1) * 4 + ((u - 1536) & 3)) * 16384,
                                 INP(12) + e * 512, INP(14) + e * 512, INP(15) + e * 512, Y0, Y1, AEND, HEND, u - 1536, tid);
#endif
                }
                SEAM(pb + 1); }
            if (IN(pb + 2)) {
#ifndef NO_POST
                for (int u = bid; u < 256; u += G) post_unit(lds, NUM, DEN, Y0, Y1, AEND, HEND, AOUT, u, tid);
#endif
                SEAM(pb + 2); }
            if (IN(pb + 3)) {
                pg8::Gemm g{AOUT, (const bf16*)(ws + WS_WOUT) + (size_t)e * D * D, D, D, D, ~0, 0, (long)256 * D, 30, 0};
                pg8::StaticOrder S; S.init(T / 256, 4, G, bid);
                pg8::EpiRes E{xin, OUTP(), XB, SS, nullptr};
                pg8::gemm_phase(lds, g, S, E);
                SEAM(pb + 3); }
        } else {
            const int o = l >> 1;
            if (IN(pb + 0)) {
#ifndef NO_POOL
                for (int u = bid; u < 256; u += G) poolprep_unit(lds, OUTP(), SS, AOUT, u, tid);
#endif
                SEAM(pb + 0); }
            if (IN(pb + 1)) {
                pg8::Gemm g{AOUT, (const bf16*)(ws + WS_POOLT) + (size_t)o * 4 * 65536, D, 256, 256, ~0, 256, (long)65536, 30, 0};
                pg8::StaticOrder S; S.init(T / 256, 4, G, bid);
                pg8::EpiRes E{OUTP(), OUTP(), XB, SS, INP(18) + o * D};
                pg8::gemm_phase(lds, g, S, E);
                SEAM(pb + 3); }
        }
        if (IN(pb + 4)) {
            pg8::Gemm g{XB, (const bf16*)(ws + WS_WQ) + (size_t)l * D * D, D, D, D, ~0, 0, (long)256 * D, 30, 0};
            pg8::StaticOrder S; S.init(T / 256, 4, G, bid);
            pg8::EpiBf16<3> E{QB, D, SS, QSS};
            pg8::gemm_phase(lds, g, S, E);
            SEAM(pb + 4); }
        if (IN(pb + 5)) {
            pg8::Gemm g{QB, (const bf16*)(ws + WS_KN) + (size_t)l * 16 * 65536, D, 256, 256, ~0, 256, (long)65536, 4, (long)4 * 65536};
            pg8::StaticOrder S; S.init(T / 256, 4, G, bid);
            pg8::EpiBf16<4> E{PB, D, QSS, LSUM};
            pg8::gemm_phase(lds, g, S, E);
            SEAM(pb + 5); }
        if (IN(pb + 6)) {
            pg8::Gemm g{PB, (const bf16*)(ws + WS_VT) + (size_t)l * 16 * 65536, D, 256, 256, ~0, 256, (long)65536, 4, (long)4 * 65536};
            pg8::StaticOrder S; S.init(T / 256, 4, G, bid);
            pg8::EpiBf16<5> E{OB, D, LSUM, nullptr};
            pg8::gemm_phase(lds, g, S, E);
            SEAM(pb + 6); }
        if (IN(pb + 7)) {
            pg8::Gemm g{OB, (const bf16*)(ws + WS_WO) + (size_t)l * D * D, D, D, D, ~0, 0, (long)256 * D, 30, 0};
            pg8::StaticOrder S; S.init(T / 256, 4, G, bid);
            pg8::EpiRes E{OUTP(), OUTP(), XB, SS, nullptr};
            pg8::gemm_phase(lds, g, S, E);
            SEAM(pb + 7); }
        if (IN(pb + 8)) {
            pg8::Gemm g{XB, (const bf16*)(ws + WS_W1) + (size_t)l * FF * D, D, D, D, ~0, 0, (long)256 * D, 30, 0};
            pg8::StaticOrder S; S.init(T / 256, FF / 256, G, bid);
            pg8::EpiBf16<2> E{HID, FF, SS, nullptr};
            pg8::gemm_phase(lds, g, S, E);
            SEAM(pb + 8); }
        if (IN(pb + 9)) {
            pg8::Gemm g{HID, (const bf16*)(ws + WS_W2) + (size_t)l * D * FF, FF, FF, FF, ~0, 0, (long)256 * FF, 30, 0};
            pg8::StaticOrder S; S.init(T / 256, 4, G, bid);
            pg8::EpiRes E{OUTP(), OUTP(), XB, SS, nullptr};
            pg8::gemm_phase(lds, g, S, E);
            SEAM(pb + 9); }
    }
#undef IN
#undef SEAM
#undef ws
}

extern "C" void kernel_launch(void* const* d_in, const int* in_sizes, int n_in, void* d_out, int out_size, void* d_ws, size_t ws_size, hipStream_t stream) {
    static int grid = 0;
    if (grid == 0) {
        if (n_in != 26 || in_sizes[0] != T * D || out_size != T * D || ws_size < WS_END) { fprintf(stderr, "kernel_launch: unexpected shapes: n_in %d in0 %d out %d ws %zu (need %zu); nothing launched\n", n_in, n_in > 0 ? in_sizes[0] : -1, out_size, ws_size, (size_t)WS_END); grid = -1; return; }
        int dev = 0, cus = 0, per_cu = 0;
        if (hipGetDevice(&dev) != hipSuccess || hipDeviceGetAttribute(&cus, hipDeviceAttributeMultiprocessorCount, dev) != hipSuccess) { grid = -1; return; }
        if (hipFuncSetAttribute((const void*)mk_fwd, hipFuncAttributeMaxDynamicSharedMemorySize, LDS_BYTES) != hipSuccess) { fprintf(stderr, "kernel_launch: hipFuncSetAttribute failed\n"); grid = -1; return; }
        if (hipOccupancyMaxActiveBlocksPerMultiprocessor(&per_cu, (const void*)mk_fwd, NWAVES * 64, LDS_BYTES) != hipSuccess || per_cu < 1) fprintf(stderr, "kernel_launch: occupancy query reports %d\n", per_cu);
        (void)hipGetLastError();
        grid = cus;
        if (grid != 256) fprintf(stderr, "kernel_launch: %d CUs (built for 256)\n", grid);
    }
    if (grid < 0) return;
    (void)hipMemsetAsync((char*)d_ws + WS_CTL, 0, CTL_ZERO_BYTES, stream);
    Args a{};
    for (int i = 0; i < 26; ++i) a.p.in[i] = (const float*)d_in[i];
    a.p.out = (float*)d_out; a.p.ws = (unsigned char*)d_ws;
    if (MK_N_LAUNCHES == 1) { a.ph_lo = 0; a.ph_hi = N_PHASES; hipLaunchKernelGGL(mk_fwd, dim3(grid), dim3(NWAVES * 64), LDS_BYTES, stream, a); }
    else {
        for (int k = 0; k < N_PHASES; ++k) {
            const int l = (k - 1) / 10, s = (k - 1) % 10;
            if (k > 0 && (l & 1) == 1 && (s == 2 || s == 3)) continue;
            a.ph_lo = k; a.ph_hi = k + 1; hipLaunchKernelGGL(mk_fwd, dim3(grid), dim3(NWAVES * 64), LDS_BYTES, stream, a);
        }
    }
}
#endif
```

```cpp
#include <hip/hip_runtime.h>
#include <cstdio>
#include <cstdint>

#ifndef MK_N_LAUNCHES
#define MK_N_LAUNCHES 1
#endif

namespace pg8 {
#define PG8_LAS __attribute__((address_space(3)))
typedef unsigned short bf16_t;
typedef short bf16x8 __attribute__((ext_vector_type(8)));
typedef float f32x4 __attribute__((ext_vector_type(4)));
typedef float f32x2 __attribute__((ext_vector_type(2)));
typedef unsigned u32x4 __attribute__((ext_vector_type(4)));
typedef unsigned u32x2 __attribute__((ext_vector_type(2)));
constexpr int BM = 256, BK = 64, HALF = 128, HTB = HALF * BK * 2, STAGE_BYTES = 8 * HTB, NXCD = 8, WGM = 8;

__host__ __device__ __forceinline__ int lds_byte(int r, int c) { const int st = (r >> 4) * 2 + (c >> 5), rr = r & 15, cc = c & 31, ob = rr * 64 + cc * 2; return st * 1024 + (ob ^ (((ob >> 9) & 1) << 5)); }
__host__ __device__ __forceinline__ void stage_rc(int b, int& R, int& C) { const int st = b / 1024, sb = b % 1024, swz = sb ^ (((sb >> 9) & 1) << 5); R = (st >> 1) * 16 + swz / 64; C = (st & 1) * 32 + (swz % 64) / 2; }
__host__ __device__ __forceinline__ int perm32(int rho) { const int n = rho >> 4, i = rho & 15; return 8 * (i >> 2) + 4 * n + (i & 3); }

struct Unit { int pm, pn; };
struct Gemm { const bf16_t* A; const bf16_t* Bt; int lda, ldb, K; int a_pm_mask, a_pn_cols; long b_pn_elems; int b_pm_shift; long b_batch_elems; };

struct StaticOrder {
    int nM, nN, nwg, G, c;
    __host__ __device__ void init(int nM_, int nN_, int G_, int c_) { nM = nM_; nN = nN_; nwg = nM * nN; G = G_; c = c_; }
    __host__ __device__ bool next(int i, Unit& u) const {
        const long L = (long)i * G + c; if (L >= nwg) return false;
        int wgid = (int)L; { const int q = nwg / NXCD, r = nwg % NXCD, xcd = wgid % NXCD, off = wgid / NXCD; wgid = (xcd < r ? xcd * (q + 1) : r * (q + 1) + (xcd - r) * q) + off; }
        const int nig = WGM * nN, gid = wgid / nig, fm = gid * WGM, gsz = (nM - fm) < WGM ? (nM - fm) : WGM;
        u.pm = fm + ((wgid % nig) % gsz); u.pn = (wgid % nig) / gsz; return true;
    }
};

__device__ __forceinline__ unsigned cvt_pk_bf16(float lo, float hi) { unsigned r; asm volatile("v_cvt_pk_bf16_f32 %0, %1, %2" : "=v"(r) : "v"(lo), "v"(hi)); return r; }

constexpr float EPS = 1e-6f;
template <int MODE> struct EpiBf16 {
    static constexpr bool PERM = true;
    bf16_t* O; int ldc; const float* aux_in; float* aux_out;
    __device__ __forceinline__ void operator()(const f32x4 (&acc)[2][2][4][2], const Unit& u, int wr, int wc, int fr, int fq) const {
        const int row0 = u.pm * BM + wr * 64 + fr, col0 = u.pn * BM + wc * 32 + 8 * fq;
#pragma unroll
        for (int ai = 0; ai < 2; ++ai)
#pragma unroll
            for (int m = 0; m < 4; ++m) {
                const int row = row0 + ai * HALF + m * 16; float f = 1.f;
                if (MODE >= 1 && MODE <= 3) { const f32x4 v = *(const f32x4*)(aux_in + (size_t)row * 16 + fq * 4); float s = (v[0] + v[1]) + (v[2] + v[3]); s += __shfl_xor(s, 16); s += __shfl_xor(s, 32); f = __builtin_amdgcn_rsqf(s * (1.0f / 1024.0f) + EPS); }
                if (MODE == 4) { const f32x4 v = *(const f32x4*)(aux_in + (size_t)row * 16 + u.pn * 4); const float s = (v[0] + v[1]) + (v[2] + v[3]); f = __builtin_amdgcn_rsqf(s * (1.0f / 256.0f) + EPS); }
                if (MODE == 5) { const f32x4 v = *(const f32x4*)(aux_in + (size_t)row * 16 + u.pn * 4); const float s = (v[0] + v[1]) + (v[2] + v[3]); f = 1.0f / s; }
                bf16_t* rowp = O + (size_t)row * ldc + col0; float part = 0.f;
#pragma unroll
                for (int bj = 0; bj < 2; ++bj) { f32x4 v0 = acc[ai][bj][m][0] * f, v1 = acc[ai][bj][m][1] * f;
                    if (MODE == 2) {
#pragma unroll
                        for (int e = 0; e < 4; ++e) { const float a = v0[e] > 0.f ? v0[e] : 0.f, b = v1[e] > 0.f ? v1[e] : 0.f; v0[e] = a * a; v1[e] = b * b; } }
                    if (MODE == 4) {
#pragma unroll
                        for (int e = 0; e < 4; ++e) { v0[e] = __builtin_amdgcn_exp2f(v0[e]); v1[e] = __builtin_amdgcn_exp2f(v1[e]); } }
                    if (MODE == 3) part += (v0[0] * v0[0] + v0[1] * v0[1]) + (v0[2] * v0[2] + v0[3] * v0[3]) + (v1[0] * v1[0] + v1[1] * v1[1]) + (v1[2] * v1[2] + v1[3] * v1[3]);
                    if (MODE == 4) part += (v0[0] + v0[1]) + (v0[2] + v0[3]) + (v1[0] + v1[1]) + (v1[2] + v1[3]);
                    u32x4 w; w.x = cvt_pk_bf16(v0[0], v0[1]); w.y = cvt_pk_bf16(v0[2], v0[3]); w.z = cvt_pk_bf16(v1[0], v1[1]); w.w = cvt_pk_bf16(v1[2], v1[3]);
                    *(u32x4*)(rowp + bj * HALF) = w; }
                if (MODE == 3 || MODE == 4) { part += __shfl_xor(part, 16); part += __shfl_xor(part, 32); if (fq == 0) aux_out[(size_t)row * 16 + u.pn * 4 + wc] = part; }
            }
    }
};
struct EpiRes {
    static constexpr bool PERM = false;
    const float* xin; float* xout; bf16_t* xb; float* ss; const float* scale;
    __device__ __forceinline__ void operator()(const f32x4 (&acc)[2][2][4][2], const Unit& u, int wr, int wc, int fr, int fq) const {
        const int row0 = u.pm * BM + wr * 64 + fr, col0 = u.pn * BM + wc * 32 + 4 * fq;
#pragma unroll
        for (int ai = 0; ai < 2; ++ai)
#pragma unroll
            for (int m = 0; m < 4; ++m) {
                const int row = row0 + ai * HALF + m * 16; const size_t off = (size_t)row * 1024 + col0; float sq = 0.f;
#pragma unroll
                for (int bj = 0; bj < 2; ++bj)
#pragma unroll
                    for (int n = 0; n < 2; ++n) { const int co = bj * HALF + n * 16; f32x4 a = acc[ai][bj][m][n];
                        if (scale) a = a * *(const f32x4*)(scale + col0 + co);
                        const f32x4 x = *(const f32x4*)(xin + off + co) + a; *(f32x4*)(xout + off + co) = x;
                        sq += (x[0] * x[0] + x[1] * x[1]) + (x[2] * x[2] + x[3] * x[3]);
                        u32x2 w; w.x = cvt_pk_bf16(x[0], x[1]); w.y = cvt_pk_bf16(x[2], x[3]); *(u32x2*)(xb + off + co) = w; }
                sq += __shfl_xor(sq, 16); sq += __shfl_xor(sq, 32); if (fq == 0) ss[(size_t)row * 16 + u.pn * 4 + wc] = sq;
                asm volatile("" ::: "memory");
            }
    }
};

template <class Epi, class Sched>
__device__ __forceinline__ void gemm_phase(PG8_LAS unsigned char* lds, const Gemm g, const Sched& S, const Epi& E) {
    int tid_ = threadIdx.x; asm volatile("" : "+v"(tid_));
    const int tid = tid_, wid = __builtin_amdgcn_readfirstlane(tid >> 6), lane = tid & 63, wr = wid >> 2, wc = wid & 3, fr = lane & 15, fq = lane >> 4;
    int K_ = g.K; asm volatile("" : "+s"(K_));
    const int K = K_, nt = K / BK;
    unsigned voffA[2], voffB[2];
#pragma unroll
    for (int i = 0; i < 2; ++i) { int R, C; stage_rc(tid * 16 + i * 8192, R, C); const int Rb = Epi::PERM ? ((R & ~31) + perm32(R & 31)) : R;
        voffA[i] = (unsigned)(R * g.lda + C) * 2u; voffB[i] = (unsigned)(Rb * g.ldb + C) * 2u; }
    const size_t kstep = (size_t)(BK * 2);
    const size_t hstepA = (size_t)HALF * g.lda * 2, hstepB = (size_t)HALF * g.ldb * 2;
    const unsigned ldsw = (unsigned)wid * 1024u;
    const int aoff = lds_byte(wr * 64 + fr, fq * 8), boff = lds_byte(wc * 32 + fr, fq * 8);
#define PG8_SA(b, h) (((b) * 2 + (h)) * HTB)
#define PG8_SB(b, h) ((4 + (b) * 2 + (h)) * HTB)
#define PG8_STAGE(bufoff, gbase, voff) do { _Pragma("unroll") for (int _i = 0; _i < 2; ++_i) \
        __builtin_amdgcn_global_load_lds((const unsigned*)((const char*)(gbase) + (voff)[_i]), (PG8_LAS unsigned*)(lds + (bufoff) + ldsw + _i * 8192), 16, 0, 0); } while (0)
#define PG8_LDA(dst, b, h) do { _Pragma("unroll") for (int m = 0; m < 4; ++m) _Pragma("unroll") for (int k = 0; k < 2; ++k) dst[m][k] = *(const PG8_LAS bf16x8*)(lds + PG8_SA(b, h) + aoff + m * 2048 + k * 1024); } while (0)
#define PG8_LDB(dst, b, h) do { _Pragma("unroll") for (int n = 0; n < 2; ++n) _Pragma("unroll") for (int k = 0; k < 2; ++k) dst[n][k] = *(const PG8_LAS bf16x8*)(lds + PG8_SB(b, h) + boff + n * 2048 + k * 1024); } while (0)
#define PG8_MMA(ai, bj, At, Bt) do { __builtin_amdgcn_s_setprio(1); _Pragma("unroll") for (int m = 0; m < 4; ++m) _Pragma("unroll") for (int n = 0; n < 2; ++n) _Pragma("unroll") for (int k = 0; k < 2; ++k) \
        acc[ai][bj][m][n] = __builtin_amdgcn_mfma_f32_16x16x32_bf16(Bt[n][k], At[m][k], acc[ai][bj][m][n], 0, 0, 0); __builtin_amdgcn_s_setprio(0); } while (0)
#define PG8_WAIT_V(n) asm volatile("s_waitcnt vmcnt(" #n ")" ::: "memory")
#define PG8_WAIT_L(n) asm volatile("s_waitcnt lgkmcnt(" #n ")" ::: "memory")
#define PG8_BAR __builtin_amdgcn_s_barrier()
#define PG8_SCHED __builtin_amdgcn_sched_barrier(0)
#define PG8_APTR(u) ((const char*)g.A + ((size_t)((u).pm & g.a_pm_mask) * 256 * g.lda + (size_t)(u).pn * g.a_pn_cols) * 2)
#define PG8_BPTR(u) ((const char*)g.Bt + ((size_t)(u).pn * g.b_pn_elems + (size_t)((u).pm >> g.b_pm_shift) * g.b_batch_elems) * 2)
    Unit cur, nxt; int ui = 0;
    if (!S.next(0, cur)) return;
    f32x4 acc[2][2][4][2];
#pragma unroll
    for (int a = 0; a < 2; ++a)
#pragma unroll
        for (int b = 0; b < 2; ++b)
#pragma unroll
            for (int m = 0; m < 4; ++m)
#pragma unroll
                for (int n = 0; n < 2; ++n) acc[a][b][m][n] = (f32x4){0.f, 0.f, 0.f, 0.f};
    bf16x8 At[4][2], B0[2][2], B1[2][2];
    const char* cA = PG8_APTR(cur); const char* cB = PG8_BPTR(cur);
    PG8_STAGE(PG8_SB(0, 0), cB, voffB); PG8_STAGE(PG8_SB(0, 1), cB + hstepB, voffB); PG8_STAGE(PG8_SA(0, 0), cA, voffA); PG8_STAGE(PG8_SA(0, 1), cA + hstepA, voffA);
    if (wr == 1) PG8_BAR;
    PG8_WAIT_V(2); PG8_BAR;
    PG8_STAGE(PG8_SB(1, 0), cB + kstep, voffB); PG8_STAGE(PG8_SA(1, 0), cA + kstep, voffA); PG8_STAGE(PG8_SB(1, 1), cB + hstepB + kstep, voffB);
    PG8_WAIT_V(6); PG8_BAR;
    for (;;) {
        const bool has_next = S.next(ui + 1, nxt);
        const char* nA = has_next ? PG8_APTR(nxt) : cA; const char* nB = has_next ? PG8_BPTR(nxt) : cB;
        for (int t = 0; t < nt; t += 2) {
            const bool last = (t == nt - 2);
            const char* a1 = cA + (size_t)(t + 1) * kstep;
            const char* a2 = last ? nA : cA + (size_t)(t + 2) * kstep; const char* b2 = last ? nB : cB + (size_t)(t + 2) * kstep;
            const char* a3 = a2 + kstep; const char* b3 = b2 + kstep;
            PG8_LDB(B0, 0, 0); PG8_LDB(B1, 0, 1); PG8_SCHED; PG8_LDA(At, 0, 0); PG8_STAGE(PG8_SA(1, 1), a1 + hstepA, voffA);
            PG8_WAIT_V(8); PG8_WAIT_L(0); PG8_BAR; PG8_MMA(0, 0, At, B0); PG8_MMA(0, 1, At, B1); PG8_BAR; PG8_SCHED;
            PG8_LDA(At, 0, 1); PG8_STAGE(PG8_SB(0, 0), b2, voffB); PG8_STAGE(PG8_SB(0, 1), b2 + hstepB, voffB); PG8_STAGE(PG8_SA(0, 0), a2, voffA);
            PG8_WAIT_V(8); PG8_WAIT_L(0); PG8_BAR; PG8_MMA(1, 0, At, B0); PG8_MMA(1, 1, At, B1); PG8_BAR; PG8_SCHED;
            PG8_LDB(B0, 1, 0); PG8_LDB(B1, 1, 1); PG8_SCHED; PG8_LDA(At, 1, 0); PG8_STAGE(PG8_SA(0, 1), a2 + hstepA, voffA);
            PG8_WAIT_V(8); PG8_WAIT_L(0); PG8_BAR; PG8_MMA(0, 0, At, B0); PG8_MMA(0, 1, At, B1); PG8_BAR; PG8_SCHED;
            PG8_LDA(At, 1, 1); PG8_STAGE(PG8_SB(1, 0), b3, voffB); PG8_STAGE(PG8_SB(1, 1), b3 + hstepB, voffB); PG8_STAGE(PG8_SA(1, 0), a3, voffA);
            PG8_WAIT_V(8); PG8_WAIT_L(0); PG8_BAR; PG8_MMA(1, 0, At, B0); PG8_MMA(1, 1, At, B1); PG8_BAR; PG8_SCHED;
        }
        if (wr == 0) PG8_BAR;
        E(acc, cur, wr, wc, fr, fq);
        if (!has_next) break;
#pragma unroll
        for (int a = 0; a < 2; ++a)
#pragma unroll
            for (int b = 0; b < 2; ++b)
#pragma unroll
                for (int m = 0; m < 4; ++m)
#pragma unroll
                    for (int n = 0; n < 2; ++n) acc[a][b][m][n] = (f32x4){0.f, 0.f, 0.f, 0.f};
        cur = nxt; cA = nA; cB = nB; ++ui;
        if (wr == 1) PG8_BAR;
    }
    PG8_WAIT_V(0);
    PG8_BAR;
#undef PG8_SA
#undef PG8_SB
#undef PG8_STAGE
#undef PG8_LDA
#undef PG8_LDB
#undef PG8_MMA
#undef PG8_WAIT_V
#undef PG8_WAIT_L
#undef PG8_BAR
#undef PG8_SCHED
#undef PG8_APTR
#undef PG8_BPTR
}
}

constexpr int NWAVES = 8;
constexpr int D = 1024, BATCH = 4, SEQ = 4096, T = BATCH * SEQ, NMEM = 256, TM = BATCH * NMEM, FF = 4096, INC = 2560;
constexpr float EPS = 1e-6f;
constexpr float LOG2E = 1.4426950408889634f;

constexpr size_t MiB = 1u << 20;
constexpr size_t WS_CTL = 0, CTL_ZERO_BYTES = 64 * 1024;
constexpr size_t WS_SS = 1 * MiB, WS_QSS = 2 * MiB, WS_LSUM = 3 * MiB, WS_DEN = 4 * MiB, WS_AEND = 5 * MiB, WS_HEND = 5 * MiB + 256 * 1024;
constexpr size_t WS_GT = 6 * MiB, WS_POOLT = 7 * MiB;
constexpr size_t WS_WIN = 8 * MiB, WS_WOUT = 18 * MiB, WS_WQ = 22 * MiB, WS_WO = 30 * MiB, WS_W1 = 38 * MiB, WS_W2 = 70 * MiB, WS_WKV = 102 * MiB;
constexpr size_t WS_KN = 102 * MiB, WS_VT = 110 * MiB;
constexpr size_t WS_XB = 118 * MiB, WS_Y0 = 118 * MiB, WS_Y1 = 134 * MiB;
constexpr size_t WS_HID = 150 * MiB, WS_PROJ = 150 * MiB, WS_NUM = 230 * MiB, WS_AOUT = 150 * MiB, WS_Q = 182 * MiB, WS_P = 214 * MiB, WS_O = 246 * MiB;
constexpr size_t WS_END = 278 * MiB;
constexpr size_t DO_KVRAW = 0, DO_MEMN = 16 * MiB;

constexpr int RING_BYTES = 131072, LDSCTL_OFF = RING_BYTES, MISC_OFF = LDSCTL_OFF + 320, LDS_BYTES = 147456;

#define GAS __attribute__((address_space(1)))
#define LAS __attribute__((address_space(3)))
typedef unsigned short bf16;
typedef unsigned v4u __attribute__((ext_vector_type(4)));
typedef unsigned v2u __attribute__((ext_vector_type(2)));
typedef float f32x4 __attribute__((ext_vector_type(4)));
typedef short bf16x8 __attribute__((ext_vector_type(8)));
typedef short s16x4 __attribute__((ext_vector_type(4)));
#define LDS_WAIT() asm volatile("s_waitcnt lgkmcnt(0)" ::: "memory")
#define VM_WAIT() asm volatile("s_waitcnt vmcnt(0)" ::: "memory")
__device__ __forceinline__ unsigned pk2(float lo, float hi) { return pg8::cvt_pk_bf16(lo, hi); }
__device__ __forceinline__ float bflo(unsigned w) { return __uint_as_float(w << 16); }
__device__ __forceinline__ float bfhi(unsigned w) { return __uint_as_float(w & 0xffff0000u); }
__device__ __forceinline__ float bf1(bf16 h) { return __uint_as_float((unsigned)h << 16); }
__device__ __forceinline__ bf16 f2bf(float f) { return (bf16)(pg8::cvt_pk_bf16(f, 0.f) & 0xffffu); }

#define XB_TMO      128
#define XB_XCNT(j)  (256  + 64 * (j))
#define XB_XSUB(j)  (1280 + 64 * (j))
#define XB_XGEN(j)  (2304 + 64 * (j))
#define XB_TOP      3328
#define XB_TOPGEN   3392
#define XCD_BAR_WORDS 3456
#define XB_SPIN_CAP (1u << 22)
__device__ __forceinline__ unsigned xb_ld(unsigned* p)              { return __hip_atomic_load(p, __ATOMIC_RELAXED, __HIP_MEMORY_SCOPE_AGENT); }
__device__ __forceinline__ unsigned xb_add(unsigned* p, unsigned v) { return __hip_atomic_fetch_add(p, v, __ATOMIC_RELAXED, __HIP_MEMORY_SCOPE_AGENT); }
__device__ __forceinline__ unsigned xb_xcc_id() { return (unsigned)__builtin_amdgcn_s_getreg((3 << 11) | 20) & 0xFu; }
#define XB_SPIN(cond, bar) do { unsigned _sp = 0; while (cond) { __builtin_amdgcn_s_sleep(1); \
    if ((++_sp & 255u) == 0u) { if (xb_ld(&(bar)[XB_TMO])) break; if (_sp > XB_SPIN_CAP) { atomicAdd(&(bar)[XB_TMO], 1u); break; } } } } while (0)
struct XcdBarrier { unsigned* bar; unsigned x; volatile LAS unsigned* st; };
__device__ __forceinline__ XcdBarrier xcd_barrier_post(unsigned* bar, volatile LAS unsigned* st) {
    XcdBarrier b; b.bar = bar; b.x = xb_xcc_id(); b.st = st;
    if (threadIdx.x == 0) (void)xb_add(&bar[XB_XCNT(b.x)], 1u);
    return b;
}
__device__ __forceinline__ void xcd_barrier_complete(unsigned* bar, unsigned x, unsigned& nloc, unsigned& nx) {
    const unsigned G = gridDim.x * gridDim.y * gridDim.z;
    unsigned sum, cnt, mine, sp = 0u;
    for (;;) {
        sum = 0u; cnt = 0u; mine = 0u;
#pragma unroll
        for (unsigned j = 0; j < 16; ++j) { const unsigned c = xb_ld(&bar[XB_XCNT(j)]); sum += c; cnt += (c > 0u) ? 1u : 0u; mine = (j == x) ? c : mine; }
        if (sum == G) break;
        __builtin_amdgcn_s_sleep(1);
        if ((++sp & 255u) == 0u) { if (xb_ld(&bar[XB_TMO])) break; if (sp > XB_SPIN_CAP) { atomicAdd(&bar[XB_TMO], 1u); break; } }
    }
    nloc = mine > 0u ? mine : 1u; nx = cnt > 0u ? cnt : 1u;
}
__device__ __forceinline__ void xcd_barrier(const XcdBarrier& b) {
    asm volatile("s_waitcnt vmcnt(0)" ::: "memory");
    __syncthreads();
    if (threadIdx.x == 0) {
        unsigned* bar = b.bar;
        __builtin_amdgcn_s_waitcnt(0);
        unsigned nloc = b.st[0], nx = b.st[1];
        if (nloc == 0u) { xcd_barrier_complete(bar, b.x, nloc, nx); b.st[0] = nloc; b.st[1] = nx; }
        const unsigned old = xb_add(&bar[XB_XSUB(b.x)], 1u);
        const unsigned gen = old / nloc;
        if (old + 1u == (gen + 1u) * nloc) {
            __builtin_amdgcn_fence(__ATOMIC_RELEASE, "agent");
            asm volatile("s_waitcnt vmcnt(0)" ::: "memory");
            const unsigned og = xb_add(&bar[XB_TOP], 1u);
            const unsigned tg = og / nx;
            if (og + 1u == (tg + 1u) * nx) xb_add(&bar[XB_TOPGEN], 1u);
            else XB_SPIN(xb_ld(&bar[XB_TOPGEN]) == tg, bar);
            __builtin_amdgcn_fence(__ATOMIC_ACQUIRE, "agent");
            xb_add(&bar[XB_XGEN(b.x)], 1u);
            asm volatile("s_waitcnt vmcnt(0)" ::: "memory");
        } else {
            XB_SPIN(xb_ld(&bar[XB_XGEN(b.x)]) == gen, bar);
            __builtin_amdgcn_fence(__ATOMIC_ACQUIRE, "agent");
            asm volatile("s_waitcnt vmcnt(0)" ::: "memory");
        }
    }
    __syncthreads();
}

__device__ __forceinline__ float wave_sum(float v) {
#pragma unroll
    for (int o = 1; o < 64; o <<= 1) v += __shfl_xor(v, o);
    return v;
}

__device__ __forceinline__ void p0_transpose_item(const float* W, int K, int N, bf16* WT, const float* gain, LAS float* scr, int item, int lane) {
    const int nblk = N / 32, kb = item / nblk, nb = item % nblk, k0 = 64 * kb, n0 = 32 * nb;
#pragma unroll 8
    for (int i = 0; i < 32; ++i) { const int kk = 2 * i + (lane >> 5); float v = W[(size_t)(k0 + kk) * N + n0 + (lane & 31)]; if (gain) v *= gain[k0 + kk]; scr[kk * 33 + (lane & 31)] = v; }
    LDS_WAIT(); asm volatile("" ::: "memory");
    const int c = lane & 7;
#pragma unroll
    for (int j = 0; j < 4; ++j) { const int n = (lane >> 3) + 8 * j; const LAS float* s = scr + (8 * c) * 33 + n;
        v4u o; o.x = pk2(s[0 * 33], s[1 * 33]); o.y = pk2(s[2 * 33], s[3 * 33]); o.z = pk2(s[4 * 33], s[5 * 33]); o.w = pk2(s[6 * 33], s[7 * 33]);
        *(GAS v4u*)(WT + (size_t)(n0 + n) * K + k0 + 8 * c) = o; }
    LDS_WAIT(); asm volatile("" ::: "memory");
}

struct Ptrs {
    const float* in[26]; float* out; unsigned char* ws;
};

struct Args { Ptrs p; int ph_lo, ph_hi; };
__device__ __forceinline__ const float* ld_in(const Args& a, int i) { asm volatile("" : "+s"(i)); return a.p.in[i]; }
__device__ __forceinline__ float* ld_out(const Args& a) { int i = 0; asm volatile("" : "+s"(i)); return (&a.p.out)[i]; }
__device__ __forceinline__ unsigned char* ld_ws(const Args& a) { int i = 0; asm volatile("" : "+s"(i)); return (&a.p.ws)[i]; }
#define INP(i) ld_in(args, (i))
#define OUTP() ld_out(args)
__device__ __forceinline__ void p0_prologue(const Args& args, LAS unsigned char* lds, int gw, int NGW, int wave) {
    int tid_ = threadIdx.x; asm volatile("" : "+v"(tid_)); const int lane = tid_ & 63;
    LAS float* scr = (LAS float*)(lds + wave * 16384);
    unsigned char* ws = ld_ws(args);
    constexpr int I_WIN = 16 * 80, I_SQ = 16 * 32, I_G = 2 * 4, I_POOL = 4 * 8, I_KV = 16 * 64, I_W1 = 16 * 128, I_W2 = 64 * 32;
    constexpr int NITEMS = 2 * I_WIN + 2 * I_SQ + 16 * I_G + 8 * I_POOL + 4 * I_SQ + 4 * I_KV + 4 * I_SQ + 4 * I_W1 + 4 * I_W2;
    for (int it = gw; it < NITEMS; it += NGW) {
        int r = it;
        if (r < 4 * I_W1) { const int l = r / I_W1; p0_transpose_item(INP(24) + (size_t)l * D * FF, D, FF, (bf16*)(ws + WS_W1) + (size_t)l * FF * D, INP(5) + l * D, scr, r % I_W1, lane); continue; } r -= 4 * I_W1;
        if (r < 4 * I_W2) { const int l = r / I_W2; p0_transpose_item(INP(25) + (size_t)l * FF * D, FF, D, (bf16*)(ws + WS_W2) + (size_t)l * D * FF, nullptr, scr, r % I_W2, lane); continue; } r -= 4 * I_W2;
        if (r < 4 * I_KV) { const int l = r / I_KV; p0_transpose_item(INP(20) + (size_t)l * D * 2048, D, 2048, (bf16*)(ws + WS_WKV) + (size_t)l * 2048 * D, nullptr, scr, r % I_KV, lane); continue; } r -= 4 * I_KV;
        if (r < 2 * I_WIN) { const int e = r / I_WIN; p0_transpose_item(INP(6) + (size_t)e * D * INC, D, INC, (bf16*)(ws + WS_WIN) + (size_t)e * INC * D, INP(3) + (2 * e) * D, scr, r % I_WIN, lane); continue; } r -= 2 * I_WIN;
        if (r < 2 * I_SQ) { const int e = r / I_SQ; p0_transpose_item(INP(16) + (size_t)e * D * D, D, D, (bf16*)(ws + WS_WOUT) + (size_t)e * D * D, nullptr, scr, r % I_SQ, lane); continue; } r -= 2 * I_SQ;
        if (r < 4 * I_SQ) { const int l = r / I_SQ; p0_transpose_item(INP(19) + (size_t)l * D * D, D, D, (bf16*)(ws + WS_WQ) + (size_t)l * D * D, INP(4) + l * D, scr, r % I_SQ, lane); continue; } r -= 4 * I_SQ;
        if (r < 4 * I_SQ) { const int l = r / I_SQ; p0_transpose_item(INP(23) + (size_t)l * D * D, D, D, (bf16*)(ws + WS_WO) + (size_t)l * D * D, nullptr, scr, r % I_SQ, lane); continue; } r -= 4 * I_SQ;
        if (r < 8 * I_POOL) { const int mat = r / I_POOL, o = mat >> 2, g = mat & 3; p0_transpose_item(INP(17) + (size_t)mat * 65536, 256, 256, (bf16*)(ws + WS_POOLT) + (size_t)mat * 65536, INP(3) + (2 * o + 1) * D + g * 256, scr, r % I_POOL, lane); continue; } r -= 8 * I_POOL;
        { const int mat = r / I_G, kind = mat >> 3, eg = mat & 7, e = eg >> 2, g = eg & 3;
          p0_transpose_item((kind ? INP(13) : INP(11)) + (size_t)eg * 16384, 128, 128, (bf16*)(ws + WS_GT) + (size_t)((e * 2 + kind) * 4 + g) * 16384, nullptr, scr, r % I_G, lane); }
    }
    for (int m = gw; m < T; m += NGW) {
        const GAS f32x4* xr = (const GAS f32x4*)(INP(0) + (size_t)m * D) + lane; f32x4 v[4]; float s = 0.f;
#pragma unroll
        for (int j = 0; j < 4; ++j) { v[j] = xr[64 * j]; s += (v[j][0] * v[j][0] + v[j][1] * v[j][1]) + (v[j][2] * v[j][2] + v[j][3] * v[j][3]); }
        s = wave_sum(s);
        GAS v2u* o8 = (GAS v2u*)((bf16*)(ws + WS_XB) + (size_t)m * D) + lane;
#pragma unroll
        for (int j = 0; j < 4; ++j) { v2u w; w.x = pk2(v[j][0], v[j][1]); w.y = pk2(v[j][2], v[j][3]); o8[64 * j] = w; }
        if (lane < 16) ((float*)(ws + WS_SS))[(size_t)m * 16 + lane] = lane == 0 ? s : 0.f;
    }
    for (int m = gw; m < TM; m += NGW) {
        const GAS f32x4* xr = (const GAS f32x4*)(INP(1) + (size_t)m * D) + lane; const GAS f32x4* gr = (const GAS f32x4*)(INP(2)) + lane; f32x4 v[4]; float s = 0.f;
#pragma unroll
        for (int j = 0; j < 4; ++j) { v[j] = xr[64 * j]; s += (v[j][0] * v[j][0] + v[j][1] * v[j][1]) + (v[j][2] * v[j][2] + v[j][3] * v[j][3]); }
        const float rs = 1.0f / sqrtf(wave_sum(s) * (1.0f / D) + EPS);
        GAS v2u* o8 = (GAS v2u*)((bf16*)((unsigned char*)OUTP() + DO_MEMN) + (size_t)m * D) + lane;
#pragma unroll
        for (int j = 0; j < 4; ++j) { const f32x4 gg = gr[64 * j]; v2u w; w.x = pk2(v[j][0] * rs * gg[0], v[j][1] * rs * gg[1]); w.y = pk2(v[j][2] * rs * gg[2], v[j][3] * rs * gg[3]); o8[64 * j] = w; }
    }
}

__device__ __forceinline__ void kv_finalize(const Args& args, int gw, int NGW) {
    int tid_ = threadIdx.x; asm volatile("" : "+v"(tid_)); const int lane = tid_ & 63;
    const bf16* kvraw = (const bf16*)((unsigned char*)OUTP() + DO_KVRAW);
    bf16* Kn = (bf16*)(ld_ws(args) + WS_KN); bf16* Vt = (bf16*)(ld_ws(args) + WS_VT);
    for (int row = gw; row < 4 * TM * 4; row += NGW) {
        const int l = row >> 12, m = (row >> 2) & 1023, h = row & 3, b = m >> 8, key = m & 255;
        const v2u w = *(const GAS v2u*)(kvraw + ((size_t)(l * TM + m)) * 2048 + h * 256 + 4 * lane);
        const float k0 = bflo(w.x), k1 = bfhi(w.x), k2 = bflo(w.y), k3 = bfhi(w.y);
        const float ss = wave_sum((k0 * k0 + k1 * k1) + (k2 * k2 + k3 * k3));
        const float sc = (1.0f / sqrtf(ss * (1.0f / 256.0f) + EPS)) * (0.0625f * LOG2E);
        const f32x4 gk = *(const GAS f32x4*)(INP(22) + l * 256 + 4 * lane), gq = *(const GAS f32x4*)(INP(21) + l * 256 + 4 * lane);
        v2u o; o.x = pk2(k0 * sc * gk[0] * gq[0], k1 * sc * gk[1] * gq[1]); o.y = pk2(k2 * sc * gk[2] * gq[2], k3 * sc * gk[3] * gq[3]);
        *(GAS v2u*)(Kn + ((size_t)((l * 4 + b) * 4 + h) * 256 + key) * 256 + 4 * lane) = o;
    }
    for (int it = gw; it < 256; it += NGW) {
        const int l = it >> 6, b = (it >> 4) & 3, h = (it >> 2) & 3, kb = it & 3, key = 64 * kb + lane;
        const bf16* src = kvraw + ((size_t)(l * TM + b * 256 + key)) * 2048 + 1024 + h * 256;
        bf16* dst = Vt + ((size_t)((l * 4 + b) * 4 + h) * 256) * 256 + key;
        for (int dc = 0; dc < 32; ++dc) { const v4u w = *(const GAS v4u*)(src + 8 * dc);
            dst[(size_t)(8 * dc + 0) * 256] = (bf16)(w.x & 0xffffu); dst[(size_t)(8 * dc + 1) * 256] = (bf16)(w.x >> 16);
            dst[(size_t)(8 * dc + 2) * 256] = (bf16)(w.y & 0xffffu); dst[(size_t)(8 * dc + 3) * 256] = (bf16)(w.y >> 16);
            dst[(size_t)(8 * dc + 4) * 256] = (bf16)(w.z & 0xffffu); dst[(size_t)(8 * dc + 5) * 256] = (bf16)(w.z >> 16);
            dst[(size_t)(8 * dc + 6) * 256] = (bf16)(w.w & 0xffffu); dst[(size_t)(8 * dc + 7) * 256] = (bf16)(w.w >> 16); }
    }
}

__device__ __forceinline__ void attn_unit(LAS unsigned char* lds, const bf16* proj, const float* gq, const float* gk, bf16* num, float* den, int uid, int tid) {
    asm volatile("" : "+v"(tid));
    const int g = uid >> 9, rem = uid & 511, bh = rem >> 5, j = rem & 31;
    const int dsh = 2 * g, d = 1 << dsh, n = j >> dsh, r = j & (d - 1), b = bh >> 2, h = bh & 3;
    const int base = n * (128 << dsh) + r;
    const size_t rowb = (size_t)b * SEQ;
    {
        const int c = tid & 15;
        const f32x4 ga = *(const GAS f32x4*)(gk + 8 * c), gb = *(const GAS f32x4*)(gk + 8 * c + 4);
        v4u kk[8], vv[8];
#pragma unroll
        for (int i = 0; i < 8; ++i) { const int kj = (tid >> 4) + 32 * i, pos = base + (kj - 128) * d;
            if (pos >= 0) { const bf16* p = proj + (rowb + pos) * INC + 512 + h * 128 + 8 * c; kk[i] = *(const GAS v4u*)p; vv[i] = *(const GAS v4u*)(p + 512); }
            else { kk[i] = (v4u){0u, 0u, 0u, 0u}; vv[i] = (v4u){0u, 0u, 0u, 0u}; } }
#pragma unroll
        for (int i = 0; i < 8; ++i) { const int kj = (tid >> 4) + 32 * i;
            const float a0 = bflo(kk[i].x), a1 = bfhi(kk[i].x), a2 = bflo(kk[i].y), a3 = bfhi(kk[i].y), a4 = bflo(kk[i].z), a5 = bfhi(kk[i].z), a6 = bflo(kk[i].w), a7 = bfhi(kk[i].w);
            float ss = ((a0 * a0 + a1 * a1) + (a2 * a2 + a3 * a3)) + ((a4 * a4 + a5 * a5) + (a6 * a6 + a7 * a7));
            ss += __shfl_xor(ss, 1); ss += __shfl_xor(ss, 2); ss += __shfl_xor(ss, 4); ss += __shfl_xor(ss, 8);
            const float rk = __builtin_amdgcn_rsqf(ss * (1.0f / 128.0f) + EPS);
            v4u o; o.x = pk2(a0 * rk * ga[0], a1 * rk * ga[1]); o.y = pk2(a2 * rk * ga[2], a3 * rk * ga[3]); o.z = pk2(a4 * rk * gb[0], a5 * rk * gb[1]); o.w = pk2(a6 * rk * gb[2], a7 * rk * gb[3]);
            *(LAS v4u*)(lds + kj * 256 + ((c ^ (kj & 15)) << 4)) = o;
            *(LAS v4u*)(lds + 65536 + kj * 256 + ((c ^ ((kj & 7) << 1)) << 4)) = vv[i]; }
    }
    const int w = tid >> 6, lane = tid & 63, q = lane & 15, G = lane >> 4;
    const size_t qrow = rowb + base + (size_t)(16 * w + q) * d;
    bf16x8 Qf[4];
    {
        v4u qq[4]; float ss = 0.f;
#pragma unroll
        for (int ks = 0; ks < 4; ++ks) { qq[ks] = *(const GAS v4u*)(proj + qrow * INC + h * 128 + 32 * ks + 8 * G);
            const float a0 = bflo(qq[ks].x), a1 = bfhi(qq[ks].x), a2 = bflo(qq[ks].y), a3 = bfhi(qq[ks].y), a4 = bflo(qq[ks].z), a5 = bfhi(qq[ks].z), a6 = bflo(qq[ks].w), a7 = bfhi(qq[ks].w);
            ss += ((a0 * a0 + a1 * a1) + (a2 * a2 + a3 * a3)) + ((a4 * a4 + a5 * a5) + (a6 * a6 + a7 * a7)); }
        ss += __shfl_xor(ss, 16); ss += __shfl_xor(ss, 32);
        const float rq = __builtin_amdgcn_rsqf(ss * (1.0f / 128.0f) + EPS) * (0.08838834764831845f * LOG2E);
#pragma unroll
        for (int ks = 0; ks < 4; ++ks) { const f32x4 ga = *(const GAS f32x4*)(gq + 32 * ks + 8 * G), gb = *(const GAS f32x4*)(gq + 32 * ks + 8 * G + 4);
            v4u o; o.x = pk2(bflo(qq[ks].x) * rq * ga[0], bfhi(qq[ks].x) * rq * ga[1]); o.y = pk2(bflo(qq[ks].y) * rq * ga[2], bfhi(qq[ks].y) * rq * ga[3]);
            o.z = pk2(bflo(qq[ks].z) * rq * gb[0], bfhi(qq[ks].z) * rq * gb[1]); o.w = pk2(bflo(qq[ks].w) * rq * gb[2], bfhi(qq[ks].w) * rq * gb[3]);
            Qf[ks] = __builtin_bit_cast(bf16x8, o); }
    }
    __syncthreads();
    f32x4 s[9];
#pragma unroll
    for (int t = 0; t < 9; ++t) { s[t] = (f32x4){0.f, 0.f, 0.f, 0.f}; const int krow = 16 * (w + t) + q;
#pragma unroll
        for (int ks = 0; ks < 4; ++ks) { const bf16x8 Kf = *(const LAS bf16x8*)(lds + krow * 256 + (((4 * ks + G) ^ q) << 4));
            s[t] = __builtin_amdgcn_mfma_f32_16x16x32_bf16(Kf, Qf[ks], s[t], 0, 0, 0); } }
    float dsum = 0.f; const bool first = (n == 0);
#pragma unroll
    for (int t = 0; t < 9; ++t)
#pragma unroll
        for (int e = 0; e < 4; ++e) { const int kk = 4 * G + e; bool ok = true;
            if (t == 0) ok = kk >= q; if (t == 8) ok = kk <= q; if (first && (w + t) < 8) ok = false;
            const float p = ok ? __builtin_amdgcn_exp2f(s[t][e]) : 0.f; s[t][e] = p; dsum += p; }
    dsum += __shfl_xor(dsum, 16); dsum += __shfl_xor(dsum, 32);
    f32x4 o[8];
#pragma unroll
    for (int nt = 0; nt < 8; ++nt) o[nt] = (f32x4){0.f, 0.f, 0.f, 0.f};
    const int q4 = q >> 2, pp = q & 3;
#pragma unroll
    for (int si = 0; si < 5; ++si) {
        v4u pw; pw.x = pk2(s[2 * si][0], s[2 * si][1]); pw.y = pk2(s[2 * si][2], s[2 * si][3]);
        if (si < 4) { pw.z = pk2(s[2 * si + 1][0], s[2 * si + 1][1]); pw.w = pk2(s[2 * si + 1][2], s[2 * si + 1][3]); } else { pw.z = 0u; pw.w = 0u; }
        const bf16x8 Pf = __builtin_bit_cast(bf16x8, pw);
        const int key0 = 16 * (w + 2 * si) + 4 * G + q4, key1 = (si < 4) ? key0 + 16 : key0;
        const int sw0 = (key0 & 7) << 1, sw1 = (key1 & 7) << 1;
#pragma unroll
        for (int nt = 0; nt < 8; ++nt) { const int chunk = 2 * nt + (pp >> 1);
            const s16x4 v0 = __builtin_bit_cast(s16x4, __builtin_amdgcn_ds_read_tr16_b64_v4i16((LAS s16x4*)(lds + 65536 + key0 * 256 + ((chunk ^ sw0) << 4) + (pp & 1) * 8)));
            const s16x4 v1 = __builtin_bit_cast(s16x4, __builtin_amdgcn_ds_read_tr16_b64_v4i16((LAS s16x4*)(lds + 65536 + key1 * 256 + ((chunk ^ sw1) << 4) + (pp & 1) * 8)));
            const bf16x8 Vf = (bf16x8){v0[0], v0[1], v0[2], v0[3], v1[0], v1[1], v1[2], v1[3]};
            o[nt] = __builtin_amdgcn_mfma_f32_16x16x32_bf16(Vf, Pf, o[nt], 0, 0, 0); }
    }
    bf16* np = num + ((size_t)g * T + qrow) * 512 + h * 128 + 4 * G;
#pragma unroll
    for (int nt = 0; nt < 8; ++nt) { v2u wv; wv.x = pk2(o[nt][0], o[nt][1]); wv.y = pk2(o[nt][2], o[nt][3]); *(GAS v2u*)(np + 16 * nt) = wv; }
    if (G == 0) den[((size_t)g * T + qrow) * 4 + h] = dsum;
    __syncthreads();
}

__device__ __forceinline__ float sigmoidf_(float x) { return 1.0f / (1.0f + __expf(-x)); }
__device__ __forceinline__ float gelu_tanh(float x) { const float u = 0.7978845608028654f * (x + 0.044715f * x * x * x); const float e = __expf(2.0f * u); return x * (1.0f - 1.0f / (e + 1.0f)); }
__device__ __forceinline__ void r1_unit(LAS unsigned char* lds, const bf16* proj, const float* cw, const float* cb, const bf16* GaT, const bf16* GxT, const float* ba, const float* bx, const float* lam,
                                        bf16* Y0, bf16* Y1, float* Aend, float* Hend, int uid, int tid) {
    asm volatile("" : "+v"(tid));
    const int g = uid & 3, chunk = (uid >> 2) & 31, b = uid >> 7, t0 = chunk * 128;
    const size_t rowb = (size_t)b * SEQ;
    LAS unsigned char* lxc = lds; LAS unsigned char* lgt = lds + 32768; LAS float* sumA = (LAS float*)(lds + 65536); LAS float* sumH = (LAS float*)(lds + 65536 + 4096);
    {
        const int c8 = tid & 15, ch0 = 128 * g + 8 * c8;
        float wj[4][8], bb[8];
#pragma unroll
        for (int jj = 0; jj < 4; ++jj) { const f32x4 a = *(const GAS f32x4*)(cw + jj * 512 + ch0), c = *(const GAS f32x4*)(cw + jj * 512 + ch0 + 4);
            wj[jj][0] = a[0]; wj[jj][1] = a[1]; wj[jj][2] = a[2]; wj[jj][3] = a[3]; wj[jj][4] = c[0]; wj[jj][5] = c[1]; wj[jj][6] = c[2]; wj[jj][7] = c[3]; }
        { const f32x4 a = *(const GAS f32x4*)(cb + ch0), c = *(const GAS f32x4*)(cb + ch0 + 4); bb[0] = a[0]; bb[1] = a[1]; bb[2] = a[2]; bb[3] = a[3]; bb[4] = c[0]; bb[5] = c[1]; bb[6] = c[2]; bb[7] = c[3]; }
#pragma unroll
        for (int i = 0; i < 4; ++i) { const int tt = (tid >> 4) + 32 * i, t = t0 + tt;
            float a[8];
#pragma unroll
            for (int e = 0; e < 8; ++e) a[e] = bb[e];
#pragma unroll
            for (int jj = 0; jj < 4; ++jj) { const int ts = t - 3 + jj;
                if (ts >= 0) { const v4u x = *(const GAS v4u*)(proj + (rowb + ts) * INC + 1536 + ch0);
                    a[0] += wj[jj][0] * bflo(x.x); a[1] += wj[jj][1] * bfhi(x.x); a[2] += wj[jj][2] * bflo(x.y); a[3] += wj[jj][3] * bfhi(x.y);
                    a[4] += wj[jj][4] * bflo(x.z); a[5] += wj[jj][5] * bfhi(x.z); a[6] += wj[jj][6] * bflo(x.w); a[7] += wj[jj][7] * bfhi(x.w); } }
            v4u o; o.x = pk2(a[0], a[1]); o.y = pk2(a[2], a[3]); o.z = pk2(a[4], a[5]); o.w = pk2(a[6], a[7]);
            *(LAS v4u*)(lxc + tt * 256 + ((c8 ^ (tt & 15)) << 4)) = o;
            *(LAS v4u*)(lgt + tt * 256 + ((c8 ^ (tt & 15)) << 4)) = *(const GAS v4u*)(proj + (rowb + t) * INC + 2048 + ch0); }
    }
    __syncthreads();
    const int w = tid >> 6, lane = tid & 63, q = lane & 15, G = lane >> 4;
    bf16x8 Xf[4];
#pragma unroll
    for (int ks = 0; ks < 4; ++ks) Xf[ks] = *(const LAS bf16x8*)(lxc + (16 * w + q) * 256 + (((4 * ks + G) ^ q) << 4));
    float Ac[8][4], Hc[8][4];
#pragma unroll
    for (int nt = 0; nt < 8; ++nt) {
        const int dd = 16 * nt + q, ch = 128 * g + dd;
        f32x4 aA = (f32x4){0.f, 0.f, 0.f, 0.f}, aX = (f32x4){0.f, 0.f, 0.f, 0.f};
#pragma unroll
        for (int ks = 0; ks < 4; ++ks) { const bf16x8 Wa = __builtin_bit_cast(bf16x8, *(const GAS v4u*)(GaT + dd * 128 + 32 * ks + 8 * G)), Wx = __builtin_bit_cast(bf16x8, *(const GAS v4u*)(GxT + dd * 128 + 32 * ks + 8 * G));
            aA = __builtin_amdgcn_mfma_f32_16x16x32_bf16(Xf[ks], Wa, aA, 0, 0, 0); aX = __builtin_amdgcn_mfma_f32_16x16x32_bf16(Xf[ks], Wx, aX, 0, 0, 0); }
        const float bav = ba[ch], bxv = bx[ch], lv = lam[ch]; const float sp8 = 8.0f * __logf(1.0f + __expf(-lv));
        float Arun = 1.f, Hrun = 0.f;
#pragma unroll
        for (int e = 0; e < 4; ++e) { const int tt = 16 * w + 4 * G + e;
            const float xcv = bf1(*(const LAS bf16*)(lxc + tt * 256 + (((dd >> 3) ^ (tt & 15)) << 4) + (dd & 7) * 2));
            const float rg = sigmoidf_(aA[e] + bav), ig = sigmoidf_(aX[e] + bxv), la = -sp8 * rg, a = __expf(la), u = sqrtf(-expm1f(2.0f * la)) * (ig * xcv);
            Hrun = a * Hrun + u; Arun = a * Arun; Ac[nt][e] = Arun; Hc[nt][e] = Hrun; }
        float Ai = Arun, Hi = Hrun;
        { const float Ap = __shfl_up(Ai, 16), Hp = __shfl_up(Hi, 16); if (G >= 1) { Hi = Ai * Hp + Hi; Ai = Ai * Ap; } }
        { const float Ap = __shfl_up(Ai, 32), Hp = __shfl_up(Hi, 32); if (G >= 2) { Hi = Ai * Hp + Hi; Ai = Ai * Ap; } }
        float Ae = __shfl_up(Ai, 16), He = __shfl_up(Hi, 16); if (G == 0) { Ae = 1.f; He = 0.f; }
#pragma unroll
        for (int e = 0; e < 4; ++e) { Hc[nt][e] = Hc[nt][e] + Ac[nt][e] * He; Ac[nt][e] = Ac[nt][e] * Ae; }
        if (G == 3) { sumA[w * 128 + dd] = Ai; sumH[w * 128 + dd] = Hi; }
    }
    __syncthreads();
#pragma unroll
    for (int nt = 0; nt < 8; ++nt) {
        const int dd = 16 * nt + q, ch = 128 * g + dd;
        float Ain = 1.f, Hin = 0.f;
        for (int w2 = 0; w2 < w; ++w2) { const float sa = sumA[w2 * 128 + dd], sh = sumH[w2 * 128 + dd]; Hin = sa * Hin + sh; Ain = sa * Ain; }
        if (w == 7 && G == 3) { const float sa = sumA[7 * 128 + dd], sh = sumH[7 * 128 + dd]; Aend[(size_t)(b * 32 + chunk) * 512 + ch] = sa * Ain; Hend[(size_t)(b * 32 + chunk) * 512 + ch] = sa * Hin + sh; }
#pragma unroll
        for (int e = 0; e < 4; ++e) { const int tt = 16 * w + 4 * G + e;
            const float gt = bf1(*(const LAS bf16*)(lgt + tt * 256 + (((dd >> 3) ^ (tt & 15)) << 4) + (dd & 7) * 2)); const float gg = gelu_tanh(gt);
            const float Pv = Ac[nt][e] * Ain, hl = Hc[nt][e] + Ac[nt][e] * Hin;
            const size_t off = (rowb + t0 + tt) * 512 + ch; Y0[off] = f2bf(hl * gg); Y1[off] = f2bf(Pv * gg); }
    }
    __syncthreads();
}

__device__ __forceinline__ void post_unit(LAS unsigned char* lds, const bf16* num, const float* den, const bf16* Y0, const bf16* Y1, const float* Aend, const float* Hend, bf16* aout, int uid, int tid) {
    asm volatile("" : "+v"(tid));
    const int row0 = uid * 64, b = row0 >> 12, chunk = (row0 & 4095) >> 7;
    LAS float* hin = (LAS float*)lds;
    { float H = 0.f; const float* ae = Aend + (size_t)(b * 32) * 512 + tid; const float* he = Hend + (size_t)(b * 32) * 512 + tid;
      for (int s = 0; s < chunk; ++s) H = ae[(size_t)s * 512] * H + he[(size_t)s * 512];
      hin[tid] = H; }
    __syncthreads();
    const int c8 = tid & 63, rsub = tid >> 6;
    float hv[8];
#pragma unroll
    for (int e = 0; e < 8; ++e) hv[e] = hin[8 * c8 + e];
#pragma unroll
    for (int i = 0; i < 8; ++i) { const size_t row = row0 + rsub + 8 * i;
        {
            const v4u a = *(const GAS v4u*)(Y0 + row * 512 + 8 * c8), p = *(const GAS v4u*)(Y1 + row * 512 + 8 * c8); v4u o;
            o.x = pk2(bflo(a.x) + bflo(p.x) * hv[0], bfhi(a.x) + bfhi(p.x) * hv[1]); o.y = pk2(bflo(a.y) + bflo(p.y) * hv[2], bfhi(a.y) + bfhi(p.y) * hv[3]);
            o.z = pk2(bflo(a.z) + bflo(p.z) * hv[4], bfhi(a.z) + bfhi(p.z) * hv[5]); o.w = pk2(bflo(a.w) + bflo(p.w) * hv[6], bfhi(a.w) + bfhi(p.w) * hv[7]);
            *(GAS v4u*)(aout + row * 1024 + 512 + 8 * c8) = o; }
        {
            const int h = c8 >> 4;
            const float dn = den[((size_t)0 * T + row) * 4 + h] + den[((size_t)1 * T + row) * 4 + h] + den[((size_t)2 * T + row) * 4 + h]; const float inv = 1.0f / dn;
            const v4u a = *(const GAS v4u*)(num + ((size_t)0 * T + row) * 512 + 8 * c8), bq = *(const GAS v4u*)(num + ((size_t)1 * T + row) * 512 + 8 * c8), c = *(const GAS v4u*)(num + ((size_t)2 * T + row) * 512 + 8 * c8); v4u o;
            o.x = pk2((bflo(a.x) + bflo(bq.x) + bflo(c.x)) * inv, (bfhi(a.x) + bfhi(bq.x) + bfhi(c.x)) * inv); o.y = pk2((bflo(a.y) + bflo(bq.y) + bflo(c.y)) * inv, (bfhi(a.y) + bfhi(bq.y) + bfhi(c.y)) * inv);
            o.z = pk2((bflo(a.z) + bflo(bq.z) + bflo(c.z)) * inv, (bfhi(a.z) + bfhi(bq.z) + bfhi(c.z)) * inv); o.w = pk2((bflo(a.w) + bflo(bq.w) + bflo(c.w)) * inv, (bfhi(a.w) + bfhi(bq.w) + bfhi(c.w)) * inv);
            *(GAS v4u*)(aout + row * 1024 + 8 * c8) = o; }
    }
    __syncthreads();
}

__device__ __forceinline__ void poolprep_unit(LAS unsigned char* lds, const float* x, const float* ss, bf16* dd, int uid, int tid) {
    asm volatile("" : "+v"(tid));
    const int row0 = uid * 64, tb = row0 & 4095;
    LAS float* rs = (LAS float*)lds;
    if (tid < 79) { const int t = tb - 15 + tid; float r = 0.f;
        if (t >= 0) { const float* p = ss + (size_t)(row0 - 15 + tid) * 16; float s = 0.f;
#pragma unroll
            for (int e = 0; e < 16; ++e) s += p[e];
            r = 1.0f / sqrtf(s * (1.0f / 1024.0f) + EPS); }
        rs[tid] = r; }
    __syncthreads();
    const int c4 = tid & 255, half = tid >> 8, c = 4 * c4, wlen = 2 << (c >> 8);
    const int ts = tb + 32 * half;
    f32x4 sum = (f32x4){0.f, 0.f, 0.f, 0.f};
    for (int i = 1; i < wlen; ++i) { const int t = ts - i; if (t >= 0) sum += *(const GAS f32x4*)(x + (size_t)(row0 + 32 * half - i) * 1024 + c) * rs[15 + 32 * half - i]; }
    for (int k = 0; k < 32; ++k) { const int t = ts + k; const size_t row = (size_t)row0 + 32 * half + k;
        const f32x4 hcur = *(const GAS f32x4*)(x + row * 1024 + c) * rs[15 + 32 * half + k];
        sum += hcur;
        const int cnt = (t + 1 < wlen) ? t + 1 : wlen; const float inv = 1.0f / (float)cnt;
        const f32x4 dv = sum * inv - hcur;
        v2u o; o.x = pk2(dv[0], dv[1]); o.y = pk2(dv[2], dv[3]); *(GAS v2u*)(dd + row * 1024 + c) = o;
        const int told = t - wlen + 1;
        if (told >= 0) sum -= *(const GAS f32x4*)(x + (row - wlen + 1) * 1024 + c) * rs[15 + 32 * half + k - wlen + 1]; }
    __syncthreads();
}

#ifndef MK_TEST
constexpr int N_PHASES = 41;
__global__ void __launch_bounds__(NWAVES * 64, 2) mk_fwd(Args args) {
    extern __shared__ __attribute__((aligned(16))) unsigned char lds_raw[];
    LAS unsigned char* lds = (LAS unsigned char*)lds_raw;
    volatile LAS unsigned* MISC = (volatile LAS unsigned*)(lds + MISC_OFF);
#define ws ld_ws(args)
    const int tid = threadIdx.x, wave = __builtin_amdgcn_readfirstlane(tid >> 6);
    const int G = gridDim.x, bid = blockIdx.x;
    const int vcu = (G % 8 == 0) ? (bid % 8) * (G / 8) + bid / 8 : bid;
    const int gw = vcu * NWAVES + wave, NGW = G * NWAVES;
    for (int u = tid; u < (LDS_BYTES - LDSCTL_OFF) / 4; u += NWAVES * 64) ((LAS unsigned*)(lds + LDSCTL_OFF))[u] = 0u;
    __syncthreads();
    unsigned* ctl = (unsigned*)(ws + WS_CTL);
    XcdBarrier bar; bar.bar = ctl + 1024; bar.x = 0; bar.st = nullptr;
    if (MK_N_LAUNCHES == 1) bar = xcd_barrier_post(ctl + 1024, MISC + 8);
#if MK_N_LAUNCHES != 1
    const int lo = args.ph_lo, hi = args.ph_hi;
#endif
#if MK_N_LAUNCHES == 1
#define IN(k) true
#else
#define IN(k) (lo <= (k) && (k) < hi)
#endif
#define SEAM(k) do { if (MK_N_LAUNCHES == 1 && (k) + 1 < N_PHASES) xcd_barrier(bar); } while (0)

#define SS ((float*)(ws + WS_SS))
#define QSS ((float*)(ws + WS_QSS))
#define LSUM ((float*)(ws + WS_LSUM))
#define DEN ((float*)(ws + WS_DEN))
#define AEND ((float*)(ws + WS_AEND))
#define HEND ((float*)(ws + WS_HEND))
#define XB ((bf16*)(ws + WS_XB))
#define PROJ ((bf16*)(ws + WS_PROJ))
#define NUM ((bf16*)(ws + WS_NUM))
#define AOUT ((bf16*)(ws + WS_AOUT))
#define QB ((bf16*)(ws + WS_Q))
#define PB ((bf16*)(ws + WS_P))
#define OB ((bf16*)(ws + WS_O))
#define HID ((bf16*)(ws + WS_HID))
#define Y0 ((bf16*)(ws + WS_Y0))
#define Y1 ((bf16*)(ws + WS_Y1))
#define KVRAW ((bf16*)((unsigned char*)OUTP() + DO_KVRAW))
#define MEMN ((bf16*)((unsigned char*)OUTP() + DO_MEMN))
#ifndef NO_PRO
    if (IN(0)) { p0_prologue(args, lds, gw, NGW, wave); SEAM(0); }
#endif

    for (int l = 0; l < 4; ++l) {
        const int pb = 1 + 10 * l;
        const float* xin = (l == 0) ? INP(0) : OUTP();
        if ((l & 1) == 0) {
            const int e = l >> 1;
            if (IN(pb + 0)) {
                { pg8::Gemm g{XB, (const bf16*)(ws + WS_WIN) + (size_t)e * INC * D, D, D, D, ~0, 0, (long)256 * D, 30, 0};
                  pg8::StaticOrder S; S.init(T / 256, INC / 256, G, bid);
                  pg8::EpiBf16<1> E{PROJ, INC, SS, nullptr};
                  pg8::gemm_phase(lds, g, S, E); }
                if (l == 0) { pg8::Gemm g{MEMN, (const bf16*)(ws + WS_WKV), D, D, D, 3, 0, (long)256 * D, 2, (long)2048 * D};
                  pg8::StaticOrder S; S.init(16, 8, G - 128, bid >= 128 ? bid - 128 : (1 << 20));
                  pg8::EpiBf16<0> E{KVRAW, 2048, nullptr, nullptr};
                  pg8::gemm_phase(lds, g, S, E); }
                SEAM(pb + 0); }
            if (IN(pb + 1)) {
#ifndef NO_KVF
                if (l == 0) kv_finalize(args, gw, NGW);
#endif
                for (int u = bid; u < 2048; u += G) {
#ifndef NO_ATTN
                    if (u < 1536) attn_unit(lds, PROJ, INP(7) + e * 128, INP(8) + e * 128, NUM, DEN, u, tid);
#endif
#ifndef NO_R1
                    if (u >= 1536) r1_unit(lds, PROJ, INP(9) + e * 2048, INP(10) + e * 512, (const bf16*)(ws + WS_GT) + (size_t)((e * 2 + 0) * 4 + ((u - 1536) & 3)) * 16384, (const bf16*)(ws + WS_GT) + (size_t)((e * 2 + 1) * 4 + ((u - 1536) & 3)) * 16384,
                                 INP(12) + e * 512, INP(14) + e * 512, INP(15) + e * 512, Y0, Y1, AEND, HEND, u - 1536, tid);
#endif
                }
                SEAM(pb + 1); }
            if (IN(pb + 2)) {
#ifndef NO_POST
                for (int u = bid; u < 256; u += G) post_unit(lds, NUM, DEN, Y0, Y1, AEND, HEND, AOUT, u, tid);
#endif
                SEAM(pb + 2); }
            if (IN(pb + 3)) {
                pg8::Gemm g{AOUT, (const bf16*)(ws + WS_WOUT) + (size_t)e * D * D, D, D, D, ~0, 0, (long)256 * D, 30, 0};
                pg8::StaticOrder S; S.init(T / 256, 4, G, bid);
                pg8::EpiRes E{xin, OUTP(), XB, SS, nullptr};
                pg8::gemm_phase(lds, g, S, E);
                SEAM(pb + 3); }
        } else {
            const int o = l >> 1;
            if (IN(pb + 0)) {
#ifndef NO_POOL
                for (int u = bid; u < 256; u += G) poolprep_unit(lds, OUTP(), SS, AOUT, u, tid);
#endif
                SEAM(pb + 0); }
            if (IN(pb + 1)) {
                pg8::Gemm g{AOUT, (const bf16*)(ws + WS_POOLT) + (size_t)o * 4 * 65536, D, 256, 256, ~0, 256, (long)65536, 30, 0};
                pg8::StaticOrder S; S.init(T / 256, 4, G, bid);
                pg8::EpiRes E{OUTP(), OUTP(), XB, SS, INP(18) + o * D};
                pg8::gemm_phase(lds, g, S, E);
                SEAM(pb + 3); }
        }
        if (IN(pb + 4)) {
            pg8::Gemm g{XB, (const bf16*)(ws + WS_WQ) + (size_t)l * D * D, D, D, D, ~0, 0, (long)256 * D, 30, 0};
            pg8::StaticOrder S; S.init(T / 256, 4, G, bid);
            pg8::EpiBf16<3> E{QB, D, SS, QSS};
            pg8::gemm_phase(lds, g, S, E);
            SEAM(pb + 4); }
        if (IN(pb + 5)) {
            pg8::Gemm g{QB, (const bf16*)(ws + WS_KN) + (size_t)l * 16 * 65536, D, 256, 256, ~0, 256, (long)65536, 4, (long)4 * 65536};
            pg8::StaticOrder S; S.init(T / 256, 4, G, bid);
            pg8::EpiBf16<4> E{PB, D, QSS, LSUM};
            pg8::gemm_phase(lds, g, S, E);
            SEAM(pb + 5); }
        if (IN(pb + 6)) {
            pg8::Gemm g{PB, (const bf16*)(ws + WS_VT) + (size_t)l * 16 * 65536, D, 256, 256, ~0, 256, (long)65536, 4, (long)4 * 65536};
            pg8::StaticOrder S; S.init(T / 256, 4, G, bid);
            pg8::EpiBf16<5> E{OB, D, LSUM, nullptr};
            pg8::gemm_phase(lds, g, S, E);
            SEAM(pb + 6); }
        if (IN(pb + 7)) {
            pg8::Gemm g{OB, (const bf16*)(ws + WS_WO) + (size_t)l * D * D, D, D, D, ~0, 0, (long)256 * D, 30, 0};
            pg8::StaticOrder S; S.init(T / 256, 4, G, bid);
            pg8::EpiRes E{OUTP(), OUTP(), XB, SS, nullptr};
            pg8::gemm_phase(lds, g, S, E);
            SEAM(pb + 7); }
        if (IN(pb + 8)) {
            pg8::Gemm g{XB, (const bf16*)(ws + WS_W1) + (size_t)l * FF * D, D, D, D, ~0, 0, (long)256 * D, 30, 0};
            pg8::StaticOrder S; S.init(T / 256, FF / 256, G, bid);
            pg8::EpiBf16<2> E{HID, FF, SS, nullptr};
            pg8::gemm_phase(lds, g, S, E);
            SEAM(pb + 8); }
        if (IN(pb + 9)) {
            pg8::Gemm g{HID, (const bf16*)(ws + WS_W2) + (size_t)l * D * FF, FF, FF, FF, ~0, 0, (long)256 * FF, 30, 0};
            pg8::StaticOrder S; S.init(T / 256, 4, G, bid);
            pg8::EpiRes E{OUTP(), OUTP(), XB, SS, nullptr};
            pg8::gemm_phase(lds, g, S, E);
            SEAM(pb + 9); }
    }
#undef IN
#undef SEAM
#undef ws
}

extern "C" void kernel_launch(void* const* d_in, const int* in_sizes, int n_in, void* d_out, int out_size, void* d_ws, size_t ws_size, hipStream_t stream) {
    static int grid = 0;
    if (grid == 0) {
        if (n_in != 26 || in_sizes[0] != T * D || out_size != T * D || ws_size < WS_END) { fprintf(stderr, "kernel_launch: unexpected shapes: n_in %d in0 %d out %d ws %zu (need %zu); nothing launched\n", n_in, n_in > 0 ? in_sizes[0] : -1, out_size, ws_size, (size_t)WS_END); grid = -1; return; }
        int dev = 0, cus = 0, per_cu = 0;
        if (hipGetDevice(&dev) != hipSuccess || hipDeviceGetAttribute(&cus, hipDeviceAttributeMultiprocessorCount, dev) != hipSuccess) { grid = -1; return; }
        if (hipFuncSetAttribute((const void*)mk_fwd, hipFuncAttributeMaxDynamicSharedMemorySize, LDS_BYTES) != hipSuccess) { fprintf(stderr, "kernel_launch: hipFuncSetAttribute failed\n"); grid = -1; return; }
        if (hipOccupancyMaxActiveBlocksPerMultiprocessor(&per_cu, (const void*)mk_fwd, NWAVES * 64, LDS_BYTES) != hipSuccess || per_cu < 1) fprintf(stderr, "kernel_launch: occupancy query reports %d\n", per_cu);
        (void)hipGetLastError();
        grid = cus;
        if (grid != 256) fprintf(stderr, "kernel_launch: %d CUs (built for 256)\n", grid);
    }
    if (grid < 0) return;
    (void)hipMemsetAsync((char*)d_ws + WS_CTL, 0, CTL_ZERO_BYTES, stream);
    Args a{};
    for (int i = 0; i < 26; ++i) a.p.in[i] = (const float*)d_in[i];
    a.p.out = (float*)d_out; a.p.ws = (unsigned char*)d_ws;
    if (MK_N_LAUNCHES == 1) { a.ph_lo = 0; a.ph_hi = N_PHASES; hipLaunchKernelGGL(mk_fwd, dim3(grid), dim3(NWAVES * 64), LDS_BYTES, stream, a); }
    else {
        for (int k = 0; k < N_PHASES; ++k) {
            const int l = (k - 1) / 10, s = (k - 1) % 10;
            if (k > 0 && (l & 1) == 1 && (s == 2 || s == 3)) continue;
            a.ph_lo = k; a.ph_hi = k + 1; hipLaunchKernelGGL(mk_fwd, dim3(grid), dim3(NWAVES * 64), LDS_BYTES, stream, a);
        }
    }
}
#endif
```

```cpp
#include <hip/hip_runtime.h>
#include <cstdio>
#include <cstdint>

#ifndef MK_N_LAUNCHES
#define MK_N_LAUNCHES 1
#endif

#ifndef REP_P0
#define REP_P0 1
#endif
#ifndef REP_A1
#define REP_A1 1
#endif
#ifndef REP_A2
#define REP_A2 1
#endif
#ifndef REP_A3
#define REP_A3 1
#endif
#ifndef REP_A4
#define REP_A4 1
#endif
#ifndef REP_B1
#define REP_B1 1
#endif
#ifndef REP_B2
#define REP_B2 1
#endif
#ifndef REP_X1
#define REP_X1 1
#endif
#ifndef REP_X2
#define REP_X2 1
#endif
#ifndef REP_X3
#define REP_X3 1
#endif
#ifndef REP_X4
#define REP_X4 1
#endif
#ifndef REP_M1
#define REP_M1 1
#endif
#ifndef REP_M2
#define REP_M2 1
#endif
#ifndef REP_BAR
#define REP_BAR 1
#endif
#ifndef REP_ATTN
#define REP_ATTN 1
#endif
#ifndef REP_R1
#define REP_R1 1
#endif
#ifndef REP_KVF
#define REP_KVF 1
#endif
#define REPEAT(n) for (int rep_ = 0; rep_ < (n); ++rep_)
#define REP_SEAM(n) do { if (rep_ + 1 < (n)) xcd_barrier(bar); } while (0)
namespace pg8 {
#define PG8_LAS __attribute__((address_space(3)))
typedef unsigned short bf16_t;
typedef short bf16x8 __attribute__((ext_vector_type(8)));
typedef float f32x4 __attribute__((ext_vector_type(4)));
typedef float f32x2 __attribute__((ext_vector_type(2)));
typedef unsigned u32x4 __attribute__((ext_vector_type(4)));
typedef unsigned u32x2 __attribute__((ext_vector_type(2)));
constexpr int BM = 256, BK = 64, HALF = 128, HTB = HALF * BK * 2, STAGE_BYTES = 8 * HTB, NXCD = 8, WGM = 8;

__host__ __device__ __forceinline__ int lds_byte(int r, int c) { const int st = (r >> 4) * 2 + (c >> 5), rr = r & 15, cc = c & 31, ob = rr * 64 + cc * 2; return st * 1024 + (ob ^ (((ob >> 9) & 1) << 5)); }
__host__ __device__ __forceinline__ void stage_rc(int b, int& R, int& C) { const int st = b / 1024, sb = b % 1024, swz = sb ^ (((sb >> 9) & 1) << 5); R = (st >> 1) * 16 + swz / 64; C = (st & 1) * 32 + (swz % 64) / 2; }
__host__ __device__ __forceinline__ int perm32(int rho) { const int n = rho >> 4, i = rho & 15; return 8 * (i >> 2) + 4 * n + (i & 3); }

struct Unit { int pm, pn; };
struct Gemm { const bf16_t* A; const bf16_t* Bt; int lda, ldb, K; int a_pm_mask, a_pn_cols; long b_pn_elems; int b_pm_shift; long b_batch_elems; };

struct StaticOrder {
    int nM, nN, nwg, G, c;
    __host__ __device__ void init(int nM_, int nN_, int G_, int c_) { nM = nM_; nN = nN_; nwg = nM * nN; G = G_; c = c_; }
    __host__ __device__ bool next(int i, Unit& u) const {
        const long L = (long)i * G + c; if (L >= nwg) return false;
        int wgid = (int)L; { const int q = nwg / NXCD, r = nwg % NXCD, xcd = wgid % NXCD, off = wgid / NXCD; wgid = (xcd < r ? xcd * (q + 1) : r * (q + 1) + (xcd - r) * q) + off; }
        const int nig = WGM * nN, gid = wgid / nig, fm = gid * WGM, gsz = (nM - fm) < WGM ? (nM - fm) : WGM;
        u.pm = fm + ((wgid % nig) % gsz); u.pn = (wgid % nig) / gsz; return true;
    }
};

__device__ __forceinline__ unsigned cvt_pk_bf16(float lo, float hi) { unsigned r; asm volatile("v_cvt_pk_bf16_f32 %0, %1, %2" : "=v"(r) : "v"(lo), "v"(hi)); return r; }

constexpr float EPS = 1e-6f;
template <int MODE> struct EpiBf16 {
    static constexpr bool PERM = true;
    bf16_t* O; int ldc; const float* aux_in; float* aux_out;
    __device__ __forceinline__ void operator()(const f32x4 (&acc)[2][2][4][2], const Unit& u, int wr, int wc, int fr, int fq) const {
        const int row0 = u.pm * BM + wr * 64 + fr, col0 = u.pn * BM + wc * 32 + 8 * fq;
#pragma unroll
        for (int ai = 0; ai < 2; ++ai)
#pragma unroll
            for (int m = 0; m < 4; ++m) {
                const int row = row0 + ai * HALF + m * 16; float f = 1.f;
                if (MODE >= 1 && MODE <= 3) { const f32x4 v = *(const f32x4*)(aux_in + (size_t)row * 16 + fq * 4); float s = (v[0] + v[1]) + (v[2] + v[3]); s += __shfl_xor(s, 16); s += __shfl_xor(s, 32); f = __builtin_amdgcn_rsqf(s * (1.0f / 1024.0f) + EPS); }
                if (MODE == 4) { const f32x4 v = *(const f32x4*)(aux_in + (size_t)row * 16 + u.pn * 4); const float s = (v[0] + v[1]) + (v[2] + v[3]); f = __builtin_amdgcn_rsqf(s * (1.0f / 256.0f) + EPS); }
                if (MODE == 5) { const f32x4 v = *(const f32x4*)(aux_in + (size_t)row * 16 + u.pn * 4); const float s = (v[0] + v[1]) + (v[2] + v[3]); f = 1.0f / s; }
                bf16_t* rowp = O + (size_t)row * ldc + col0; float part = 0.f;
#pragma unroll
                for (int bj = 0; bj < 2; ++bj) { f32x4 v0 = acc[ai][bj][m][0] * f, v1 = acc[ai][bj][m][1] * f;
                    if (MODE == 2) {
#pragma unroll
                        for (int e = 0; e < 4; ++e) { const float a = v0[e] > 0.f ? v0[e] : 0.f, b = v1[e] > 0.f ? v1[e] : 0.f; v0[e] = a * a; v1[e] = b * b; } }
                    if (MODE == 4) {
#pragma unroll
                        for (int e = 0; e < 4; ++e) { v0[e] = __builtin_amdgcn_exp2f(v0[e]); v1[e] = __builtin_amdgcn_exp2f(v1[e]); } }
                    if (MODE == 3) part += (v0[0] * v0[0] + v0[1] * v0[1]) + (v0[2] * v0[2] + v0[3] * v0[3]) + (v1[0] * v1[0] + v1[1] * v1[1]) + (v1[2] * v1[2] + v1[3] * v1[3]);
                    if (MODE == 4) part += (v0[0] + v0[1]) + (v0[2] + v0[3]) + (v1[0] + v1[1]) + (v1[2] + v1[3]);
                    u32x4 w; w.x = cvt_pk_bf16(v0[0], v0[1]); w.y = cvt_pk_bf16(v0[2], v0[3]); w.z = cvt_pk_bf16(v1[0], v1[1]); w.w = cvt_pk_bf16(v1[2], v1[3]);
                    *(u32x4*)(rowp + bj * HALF) = w; }
                if (MODE == 3 || MODE == 4) { part += __shfl_xor(part, 16); part += __shfl_xor(part, 32); if (fq == 0) aux_out[(size_t)row * 16 + u.pn * 4 + wc] = part; }
            }
    }
};
struct EpiRes {
    static constexpr bool PERM = false;
    const float* xin; float* xout; bf16_t* xb; float* ss; const float* scale;
    __device__ __forceinline__ void operator()(const f32x4 (&acc)[2][2][4][2], const Unit& u, int wr, int wc, int fr, int fq) const {
        const int row0 = u.pm * BM + wr * 64 + fr, col0 = u.pn * BM + wc * 32 + 4 * fq;
#pragma unroll
        for (int ai = 0; ai < 2; ++ai)
#pragma unroll
            for (int m = 0; m < 4; ++m) {
                const int row = row0 + ai * HALF + m * 16; const size_t off = (size_t)row * 1024 + col0; float sq = 0.f;
#pragma unroll
                for (int bj = 0; bj < 2; ++bj)
#pragma unroll
                    for (int n = 0; n < 2; ++n) { const int co = bj * HALF + n * 16; f32x4 a = acc[ai][bj][m][n];
                        if (scale) a = a * *(const f32x4*)(scale + col0 + co);
                        const f32x4 x = *(const f32x4*)(xin + off + co) + a; *(f32x4*)(xout + off + co) = x;
                        sq += (x[0] * x[0] + x[1] * x[1]) + (x[2] * x[2] + x[3] * x[3]);
                        u32x2 w; w.x = cvt_pk_bf16(x[0], x[1]); w.y = cvt_pk_bf16(x[2], x[3]); *(u32x2*)(xb + off + co) = w; }
                sq += __shfl_xor(sq, 16); sq += __shfl_xor(sq, 32); if (fq == 0) ss[(size_t)row * 16 + u.pn * 4 + wc] = sq;
                asm volatile("" ::: "memory");
            }
    }
};

template <class Epi, class Sched>
__device__ __forceinline__ void gemm_phase(PG8_LAS unsigned char* lds, const Gemm g, const Sched& S, const Epi& E) {
    int tid_ = threadIdx.x; asm volatile("" : "+v"(tid_));
    const int tid = tid_, wid = __builtin_amdgcn_readfirstlane(tid >> 6), lane = tid & 63, wr = wid >> 2, wc = wid & 3, fr = lane & 15, fq = lane >> 4;
    int K_ = g.K; asm volatile("" : "+s"(K_));
    const int K = K_, nt = K / BK;
    unsigned voffA[2], voffB[2];
#pragma unroll
    for (int i = 0; i < 2; ++i) { int R, C; stage_rc(tid * 16 + i * 8192, R, C); const int Rb = Epi::PERM ? ((R & ~31) + perm32(R & 31)) : R;
        voffA[i] = (unsigned)(R * g.lda + C) * 2u; voffB[i] = (unsigned)(Rb * g.ldb + C) * 2u; }
    const size_t kstep = (size_t)(BK * 2);
    const size_t hstepA = (size_t)HALF * g.lda * 2, hstepB = (size_t)HALF * g.ldb * 2;
    const unsigned ldsw = (unsigned)wid * 1024u;
    const int aoff = lds_byte(wr * 64 + fr, fq * 8), boff = lds_byte(wc * 32 + fr, fq * 8);
#define PG8_SA(b, h) (((b) * 2 + (h)) * HTB)
#define PG8_SB(b, h) ((4 + (b) * 2 + (h)) * HTB)
#define PG8_STAGE(bufoff, gbase, voff) do { _Pragma("unroll") for (int _i = 0; _i < 2; ++_i) \
        __builtin_amdgcn_global_load_lds((const unsigned*)((const char*)(gbase) + (voff)[_i]), (PG8_LAS unsigned*)(lds + (bufoff) + ldsw + _i * 8192), 16, 0, 0); } while (0)
#define PG8_LDA(dst, b, h) do { _Pragma("unroll") for (int m = 0; m < 4; ++m) _Pragma("unroll") for (int k = 0; k < 2; ++k) dst[m][k] = *(const PG8_LAS bf16x8*)(lds + PG8_SA(b, h) + aoff + m * 2048 + k * 1024); } while (0)
#define PG8_LDB(dst, b, h) do { _Pragma("unroll") for (int n = 0; n < 2; ++n) _Pragma("unroll") for (int k = 0; k < 2; ++k) dst[n][k] = *(const PG8_LAS bf16x8*)(lds + PG8_SB(b, h) + boff + n * 2048 + k * 1024); } while (0)
#define PG8_MMA(ai, bj, At, Bt) do { __builtin_amdgcn_s_setprio(1); _Pragma("unroll") for (int m = 0; m < 4; ++m) _Pragma("unroll") for (int n = 0; n < 2; ++n) _Pragma("unroll") for (int k = 0; k < 2; ++k) \
        acc[ai][bj][m][n] = __builtin_amdgcn_mfma_f32_16x16x32_bf16(Bt[n][k], At[m][k], acc[ai][bj][m][n], 0, 0, 0); __builtin_amdgcn_s_setprio(0); } while (0)
#define PG8_WAIT_V(n) asm volatile("s_waitcnt vmcnt(" #n ")" ::: "memory")
#define PG8_WAIT_L(n) asm volatile("s_waitcnt lgkmcnt(" #n ")" ::: "memory")
#define PG8_BAR __builtin_amdgcn_s_barrier()
#define PG8_SCHED __builtin_amdgcn_sched_barrier(0)
#define PG8_APTR(u) ((const char*)g.A + ((size_t)((u).pm & g.a_pm_mask) * 256 * g.lda + (size_t)(u).pn * g.a_pn_cols) * 2)
#define PG8_BPTR(u) ((const char*)g.Bt + ((size_t)(u).pn * g.b_pn_elems + (size_t)((u).pm >> g.b_pm_shift) * g.b_batch_elems) * 2)
    Unit cur, nxt; int ui = 0;
    if (!S.next(0, cur)) return;
    f32x4 acc[2][2][4][2];
#pragma unroll
    for (int a = 0; a < 2; ++a)
#pragma unroll
        for (int b = 0; b < 2; ++b)
#pragma unroll
            for (int m = 0; m < 4; ++m)
#pragma unroll
                for (int n = 0; n < 2; ++n) acc[a][b][m][n] = (f32x4){0.f, 0.f, 0.f, 0.f};
    bf16x8 At[4][2], B0[2][2], B1[2][2];
    const char* cA = PG8_APTR(cur); const char* cB = PG8_BPTR(cur);
    PG8_STAGE(PG8_SB(0, 0), cB, voffB); PG8_STAGE(PG8_SB(0, 1), cB + hstepB, voffB); PG8_STAGE(PG8_SA(0, 0), cA, voffA); PG8_STAGE(PG8_SA(0, 1), cA + hstepA, voffA);
    if (wr == 1) PG8_BAR;
    PG8_WAIT_V(2); PG8_BAR;
    PG8_STAGE(PG8_SB(1, 0), cB + kstep, voffB); PG8_STAGE(PG8_SA(1, 0), cA + kstep, voffA); PG8_STAGE(PG8_SB(1, 1), cB + hstepB + kstep, voffB);
    PG8_WAIT_V(6); PG8_BAR;
    for (;;) {
        const bool has_next = S.next(ui + 1, nxt);
        const char* nA = has_next ? PG8_APTR(nxt) : cA; const char* nB = has_next ? PG8_BPTR(nxt) : cB;
        for (int t = 0; t < nt; t += 2) {
            const bool last = (t == nt - 2);
            const char* a1 = cA + (size_t)(t + 1) * kstep;
            const char* a2 = last ? nA : cA + (size_t)(t + 2) * kstep; const char* b2 = last ? nB : cB + (size_t)(t + 2) * kstep;
            const char* a3 = a2 + kstep; const char* b3 = b2 + kstep;
            PG8_LDB(B0, 0, 0); PG8_LDB(B1, 0, 1); PG8_SCHED; PG8_LDA(At, 0, 0); PG8_STAGE(PG8_SA(1, 1), a1 + hstepA, voffA);
            PG8_WAIT_V(8); PG8_WAIT_L(0); PG8_BAR; PG8_MMA(0, 0, At, B0); PG8_MMA(0, 1, At, B1); PG8_BAR; PG8_SCHED;
            PG8_LDA(At, 0, 1); PG8_STAGE(PG8_SB(0, 0), b2, voffB); PG8_STAGE(PG8_SB(0, 1), b2 + hstepB, voffB); PG8_STAGE(PG8_SA(0, 0), a2, voffA);
            PG8_WAIT_V(8); PG8_WAIT_L(0); PG8_BAR; PG8_MMA(1, 0, At, B0); PG8_MMA(1, 1, At, B1); PG8_BAR; PG8_SCHED;
            PG8_LDB(B0, 1, 0); PG8_LDB(B1, 1, 1); PG8_SCHED; PG8_LDA(At, 1, 0); PG8_STAGE(PG8_SA(0, 1), a2 + hstepA, voffA);
            PG8_WAIT_V(8); PG8_WAIT_L(0); PG8_BAR; PG8_MMA(0, 0, At, B0); PG8_MMA(0, 1, At, B1); PG8_BAR; PG8_SCHED;
            PG8_LDA(At, 1, 1); PG8_STAGE(PG8_SB(1, 0), b3, voffB); PG8_STAGE(PG8_SB(1, 1), b3 + hstepB, voffB); PG8_STAGE(PG8_SA(1, 0), a3, voffA);
            PG8_WAIT_V(8); PG8_WAIT_L(0); PG8_BAR; PG8_MMA(1, 0, At, B0); PG8_MMA(1, 1, At, B1); PG8_BAR; PG8_SCHED;
        }
        if (wr == 0) PG8_BAR;
        E(acc, cur, wr, wc, fr, fq);
        if (!has_next) break;
#pragma unroll
        for (int a = 0; a < 2; ++a)
#pragma unroll
            for (int b = 0; b < 2; ++b)
#pragma unroll
                for (int m = 0; m < 4; ++m)
#pragma unroll
                    for (int n = 0; n < 2; ++n) acc[a][b][m][n] = (f32x4){0.f, 0.f, 0.f, 0.f};
        cur = nxt; cA = nA; cB = nB; ++ui;
        if (wr == 1) PG8_BAR;
    }
    PG8_WAIT_V(0);
    PG8_BAR;
#undef PG8_SA
#undef PG8_SB
#undef PG8_STAGE
#undef PG8_LDA
#undef PG8_LDB
#undef PG8_MMA
#undef PG8_WAIT_V
#undef PG8_WAIT_L
#undef PG8_BAR
#undef PG8_SCHED
#undef PG8_APTR
#undef PG8_BPTR
}
}

constexpr int NWAVES = 8;
constexpr int D = 1024, BATCH = 4, SEQ = 4096, T = BATCH * SEQ, NMEM = 256, TM = BATCH * NMEM, FF = 4096, INC = 2560;
constexpr float EPS = 1e-6f;
constexpr float LOG2E = 1.4426950408889634f;

constexpr size_t MiB = 1u << 20;
constexpr size_t WS_CTL = 0, CTL_ZERO_BYTES = 64 * 1024;
constexpr size_t WS_SS = 1 * MiB, WS_QSS = 2 * MiB, WS_LSUM = 3 * MiB, WS_DEN = 4 * MiB, WS_AEND = 5 * MiB, WS_HEND = 5 * MiB + 256 * 1024;
constexpr size_t WS_GT = 6 * MiB, WS_POOLT = 7 * MiB;
constexpr size_t WS_WIN = 8 * MiB, WS_WOUT = 18 * MiB, WS_WQ = 22 * MiB, WS_WO = 30 * MiB, WS_W1 = 38 * MiB, WS_W2 = 70 * MiB, WS_WKV = 102 * MiB;
constexpr size_t WS_KN = 102 * MiB, WS_VT = 110 * MiB;
constexpr size_t WS_XB = 118 * MiB, WS_Y0 = 118 * MiB, WS_Y1 = 134 * MiB;
constexpr size_t WS_HID = 150 * MiB, WS_PROJ = 150 * MiB, WS_NUM = 230 * MiB, WS_AOUT = 150 * MiB, WS_Q = 182 * MiB, WS_P = 214 * MiB, WS_O = 246 * MiB;
constexpr size_t WS_END = 278 * MiB;
constexpr size_t DO_KVRAW = 0, DO_MEMN = 16 * MiB;

constexpr int RING_BYTES = 131072, LDSCTL_OFF = RING_BYTES, MISC_OFF = LDSCTL_OFF + 320, LDS_BYTES = 147456;

#define GAS __attribute__((address_space(1)))
#define LAS __attribute__((address_space(3)))
typedef unsigned short bf16;
typedef unsigned v4u __attribute__((ext_vector_type(4)));
typedef unsigned v2u __attribute__((ext_vector_type(2)));
typedef float f32x4 __attribute__((ext_vector_type(4)));
typedef short bf16x8 __attribute__((ext_vector_type(8)));
typedef short s16x4 __attribute__((ext_vector_type(4)));
#define LDS_WAIT() asm volatile("s_waitcnt lgkmcnt(0)" ::: "memory")
#define VM_WAIT() asm volatile("s_waitcnt vmcnt(0)" ::: "memory")
__device__ __forceinline__ unsigned pk2(float lo, float hi) { return pg8::cvt_pk_bf16(lo, hi); }
__device__ __forceinline__ float bflo(unsigned w) { return __uint_as_float(w << 16); }
__device__ __forceinline__ float bfhi(unsigned w) { return __uint_as_float(w & 0xffff0000u); }
__device__ __forceinline__ float bf1(bf16 h) { return __uint_as_float((unsigned)h << 16); }
__device__ __forceinline__ bf16 f2bf(float f) { return (bf16)(pg8::cvt_pk_bf16(f, 0.f) & 0xffffu); }

#define XB_TMO      128
#define XB_XCNT(j)  (256  + 64 * (j))
#define XB_XSUB(j)  (1280 + 64 * (j))
#define XB_XGEN(j)  (2304 + 64 * (j))
#define XB_TOP      3328
#define XB_TOPGEN   3392
#define XCD_BAR_WORDS 3456
#define XB_SPIN_CAP (1u << 22)
__device__ __forceinline__ unsigned xb_ld(unsigned* p)              { return __hip_atomic_load(p, __ATOMIC_RELAXED, __HIP_MEMORY_SCOPE_AGENT); }
__device__ __forceinline__ unsigned xb_add(unsigned* p, unsigned v) { return __hip_atomic_fetch_add(p, v, __ATOMIC_RELAXED, __HIP_MEMORY_SCOPE_AGENT); }
__device__ __forceinline__ unsigned xb_xcc_id() { return (unsigned)__builtin_amdgcn_s_getreg((3 << 11) | 20) & 0xFu; }
#define XB_SPIN(cond, bar) do { unsigned _sp = 0; while (cond) { __builtin_amdgcn_s_sleep(1); \
    if ((++_sp & 255u) == 0u) { if (xb_ld(&(bar)[XB_TMO])) break; if (_sp > XB_SPIN_CAP) { atomicAdd(&(bar)[XB_TMO], 1u); break; } } } } while (0)
struct XcdBarrier { unsigned* bar; unsigned x; volatile LAS unsigned* st; };
__device__ __forceinline__ XcdBarrier xcd_barrier_post(unsigned* bar, volatile LAS unsigned* st) {
    XcdBarrier b; b.bar = bar; b.x = xb_xcc_id(); b.st = st;
    if (threadIdx.x == 0) (void)xb_add(&bar[XB_XCNT(b.x)], 1u);
    return b;
}
__device__ __forceinline__ void xcd_barrier_complete(unsigned* bar, unsigned x, unsigned& nloc, unsigned& nx) {
    const unsigned G = gridDim.x * gridDim.y * gridDim.z;
    unsigned sum, cnt, mine, sp = 0u;
    for (;;) {
        sum = 0u; cnt = 0u; mine = 0u;
#pragma unroll
        for (unsigned j = 0; j < 16; ++j) { const unsigned c = xb_ld(&bar[XB_XCNT(j)]); sum += c; cnt += (c > 0u) ? 1u : 0u; mine = (j == x) ? c : mine; }
        if (sum == G) break;
        __builtin_amdgcn_s_sleep(1);
        if ((++sp & 255u) == 0u) { if (xb_ld(&bar[XB_TMO])) break; if (sp > XB_SPIN_CAP) { atomicAdd(&bar[XB_TMO], 1u); break; } }
    }
    nloc = mine > 0u ? mine : 1u; nx = cnt > 0u ? cnt : 1u;
}
__device__ __forceinline__ void xcd_barrier(const XcdBarrier& b) {
    asm volatile("s_waitcnt vmcnt(0)" ::: "memory");
    __syncthreads();
    if (threadIdx.x == 0) {
        unsigned* bar = b.bar;
        __builtin_amdgcn_s_waitcnt(0);
        unsigned nloc = b.st[0], nx = b.st[1];
        if (nloc == 0u) { xcd_barrier_complete(bar, b.x, nloc, nx); b.st[0] = nloc; b.st[1] = nx; }
        const unsigned old = xb_add(&bar[XB_XSUB(b.x)], 1u);
        const unsigned gen = old / nloc;
        if (old + 1u == (gen + 1u) * nloc) {
            __builtin_amdgcn_fence(__ATOMIC_RELEASE, "agent");
            asm volatile("s_waitcnt vmcnt(0)" ::: "memory");
            const unsigned og = xb_add(&bar[XB_TOP], 1u);
            const unsigned tg = og / nx;
            if (og + 1u == (tg + 1u) * nx) xb_add(&bar[XB_TOPGEN], 1u);
            else XB_SPIN(xb_ld(&bar[XB_TOPGEN]) == tg, bar);
            __builtin_amdgcn_fence(__ATOMIC_ACQUIRE, "agent");
            xb_add(&bar[XB_XGEN(b.x)], 1u);
            asm volatile("s_waitcnt vmcnt(0)" ::: "memory");
        } else {
            XB_SPIN(xb_ld(&bar[XB_XGEN(b.x)]) == gen, bar);
            __builtin_amdgcn_fence(__ATOMIC_ACQUIRE, "agent");
            asm volatile("s_waitcnt vmcnt(0)" ::: "memory");
        }
    }
    __syncthreads();
}

__device__ __forceinline__ float wave_sum(float v) {
#pragma unroll
    for (int o = 1; o < 64; o <<= 1) v += __shfl_xor(v, o);
    return v;
}

__device__ __forceinline__ void p0_transpose_item(const float* W, int K, int N, bf16* WT, const float* gain, LAS float* scr, int item, int lane) {
    const int nblk = N / 32, kb = item / nblk, nb = item % nblk, k0 = 64 * kb, n0 = 32 * nb;
#pragma unroll
    for (int i = 0; i < 32; ++i) { const int kk = 2 * i + (lane >> 5); float v = W[(size_t)(k0 + kk) * N + n0 + (lane & 31)]; if (gain) v *= gain[k0 + kk]; scr[kk * 33 + (lane & 31)] = v; }
    LDS_WAIT(); asm volatile("" ::: "memory");
    const int c = lane & 7;
#pragma unroll
    for (int j = 0; j < 4; ++j) { const int n = (lane >> 3) + 8 * j; const LAS float* s = scr + (8 * c) * 33 + n;
        v4u o; o.x = pk2(s[0 * 33], s[1 * 33]); o.y = pk2(s[2 * 33], s[3 * 33]); o.z = pk2(s[4 * 33], s[5 * 33]); o.w = pk2(s[6 * 33], s[7 * 33]);
        *(GAS v4u*)(WT + (size_t)(n0 + n) * K + k0 + 8 * c) = o; }
    LDS_WAIT(); asm volatile("" ::: "memory");
}

struct Ptrs {
    const float* in[26]; float* out; unsigned char* ws;
};

struct Args { Ptrs p; int ph_lo, ph_hi; };
__device__ __forceinline__ const float* ld_in(const Args& a, int i) { asm volatile("" : "+s"(i)); return a.p.in[i]; }
__device__ __forceinline__ float* ld_out(const Args& a) { int i = 0; asm volatile("" : "+s"(i)); return (&a.p.out)[i]; }
__device__ __forceinline__ unsigned char* ld_ws(const Args& a) { int i = 0; asm volatile("" : "+s"(i)); return (&a.p.ws)[i]; }
#define INP(i) ld_in(args, (i))
#define OUTP() ld_out(args)
__device__ __forceinline__ void p0_prologue(const Args& args, LAS unsigned char* lds, int gw, int NGW, int wave) {
    int tid_ = threadIdx.x; asm volatile("" : "+v"(tid_)); const int lane = tid_ & 63;
    LAS float* scr = (LAS float*)(lds + wave * 16384);
    unsigned char* ws = ld_ws(args);
    constexpr int I_WIN = 16 * 80, I_SQ = 16 * 32, I_G = 2 * 4, I_POOL = 4 * 8, I_KV = 16 * 64, I_W1 = 16 * 128, I_W2 = 64 * 32;
    constexpr int NITEMS = 2 * I_WIN + 2 * I_SQ + 16 * I_G + 8 * I_POOL + 4 * I_SQ + 4 * I_KV + 4 * I_SQ + 4 * I_W1 + 4 * I_W2;
    for (int it = gw; it < NITEMS; it += NGW) {
        int r = it;
        if (r < 4 * I_W1) { const int l = r / I_W1; p0_transpose_item(INP(24) + (size_t)l * D * FF, D, FF, (bf16*)(ws + WS_W1) + (size_t)l * FF * D, INP(5) + l * D, scr, r % I_W1, lane); continue; } r -= 4 * I_W1;
        if (r < 4 * I_W2) { const int l = r / I_W2; p0_transpose_item(INP(25) + (size_t)l * FF * D, FF, D, (bf16*)(ws + WS_W2) + (size_t)l * D * FF, nullptr, scr, r % I_W2, lane); continue; } r -= 4 * I_W2;
        if (r < 4 * I_KV) { const int l = r / I_KV; p0_transpose_item(INP(20) + (size_t)l * D * 2048, D, 2048, (bf16*)(ws + WS_WKV) + (size_t)l * 2048 * D, nullptr, scr, r % I_KV, lane); continue; } r -= 4 * I_KV;
        if (r < 2 * I_WIN) { const int e = r / I_WIN; p0_transpose_item(INP(6) + (size_t)e * D * INC, D, INC, (bf16*)(ws + WS_WIN) + (size_t)e * INC * D, INP(3) + (2 * e) * D, scr, r % I_WIN, lane); continue; } r -= 2 * I_WIN;
        if (r < 2 * I_SQ) { const int e = r / I_SQ; p0_transpose_item(INP(16) + (size_t)e * D * D, D, D, (bf16*)(ws + WS_WOUT) + (size_t)e * D * D, nullptr, scr, r % I_SQ, lane); continue; } r -= 2 * I_SQ;
        if (r < 4 * I_SQ) { const int l = r / I_SQ; p0_transpose_item(INP(19) + (size_t)l * D * D, D, D, (bf16*)(ws + WS_WQ) + (size_t)l * D * D, INP(4) + l * D, scr, r % I_SQ, lane); continue; } r -= 4 * I_SQ;
        if (r < 4 * I_SQ) { const int l = r / I_SQ; p0_transpose_item(INP(23) + (size_t)l * D * D, D, D, (bf16*)(ws + WS_WO) + (size_t)l * D * D, nullptr, scr, r % I_SQ, lane); continue; } r -= 4 * I_SQ;
        if (r < 8 * I_POOL) { const int mat = r / I_POOL, o = mat >> 2, g = mat & 3; p0_transpose_item(INP(17) + (size_t)mat * 65536, 256, 256, (bf16*)(ws + WS_POOLT) + (size_t)mat * 65536, INP(3) + (2 * o + 1) * D + g * 256, scr, r % I_POOL, lane); continue; } r -= 8 * I_POOL;
        { const int mat = r / I_G, kind = mat >> 3, eg = mat & 7, e = eg >> 2, g = eg & 3;
          p0_transpose_item((kind ? INP(13) : INP(11)) + (size_t)eg * 16384, 128, 128, (bf16*)(ws + WS_GT) + (size_t)((e * 2 + kind) * 4 + g) * 16384, nullptr, scr, r % I_G, lane); }
    }
    for (int m = gw; m < T; m += NGW) {
        const GAS f32x4* xr = (const GAS f32x4*)(INP(0) + (size_t)m * D) + lane; f32x4 v[4]; float s = 0.f;
#pragma unroll
        for (int j = 0; j < 4; ++j) { v[j] = xr[64 * j]; s += (v[j][0] * v[j][0] + v[j][1] * v[j][1]) + (v[j][2] * v[j][2] + v[j][3] * v[j][3]); }
        s = wave_sum(s);
        GAS v2u* o8 = (GAS v2u*)((bf16*)(ws + WS_XB) + (size_t)m * D) + lane;
#pragma unroll
        for (int j = 0; j < 4; ++j) { v2u w; w.x = pk2(v[j][0], v[j][1]); w.y = pk2(v[j][2], v[j][3]); o8[64 * j] = w; }
        if (lane < 16) ((float*)(ws + WS_SS))[(size_t)m * 16 + lane] = lane == 0 ? s : 0.f;
    }
    for (int m = gw; m < TM; m += NGW) {
        const GAS f32x4* xr = (const GAS f32x4*)(INP(1) + (size_t)m * D) + lane; const GAS f32x4* gr = (const GAS f32x4*)(INP(2)) + lane; f32x4 v[4]; float s = 0.f;
#pragma unroll
        for (int j = 0; j < 4; ++j) { v[j] = xr[64 * j]; s += (v[j][0] * v[j][0] + v[j][1] * v[j][1]) + (v[j][2] * v[j][2] + v[j][3] * v[j][3]); }
        const float rs = 1.0f / sqrtf(wave_sum(s) * (1.0f / D) + EPS);
        GAS v2u* o8 = (GAS v2u*)((bf16*)((unsigned char*)OUTP() + DO_MEMN) + (size_t)m * D) + lane;
#pragma unroll
        for (int j = 0; j < 4; ++j) { const f32x4 gg = gr[64 * j]; v2u w; w.x = pk2(v[j][0] * rs * gg[0], v[j][1] * rs * gg[1]); w.y = pk2(v[j][2] * rs * gg[2], v[j][3] * rs * gg[3]); o8[64 * j] = w; }
    }
}

__device__ __forceinline__ void kv_finalize(const Args& args, int gw, int NGW) {
    int tid_ = threadIdx.x; asm volatile("" : "+v"(tid_)); const int lane = tid_ & 63;
    const bf16* kvraw = (const bf16*)((unsigned char*)OUTP() + DO_KVRAW);
    bf16* Kn = (bf16*)(ld_ws(args) + WS_KN); bf16* Vt = (bf16*)(ld_ws(args) + WS_VT);
    for (int row = gw; row < 4 * TM * 4; row += NGW) {
        const int l = row >> 12, m = (row >> 2) & 1023, h = row & 3, b = m >> 8, key = m & 255;
        const v2u w = *(const GAS v2u*)(kvraw + ((size_t)(l * TM + m)) * 2048 + h * 256 + 4 * lane);
        const float k0 = bflo(w.x), k1 = bfhi(w.x), k2 = bflo(w.y), k3 = bfhi(w.y);
        const float ss = wave_sum((k0 * k0 + k1 * k1) + (k2 * k2 + k3 * k3));
        const float sc = (1.0f / sqrtf(ss * (1.0f / 256.0f) + EPS)) * (0.0625f * LOG2E);
        const f32x4 gk = *(const GAS f32x4*)(INP(22) + l * 256 + 4 * lane), gq = *(const GAS f32x4*)(INP(21) + l * 256 + 4 * lane);
        v2u o; o.x = pk2(k0 * sc * gk[0] * gq[0], k1 * sc * gk[1] * gq[1]); o.y = pk2(k2 * sc * gk[2] * gq[2], k3 * sc * gk[3] * gq[3]);
        *(GAS v2u*)(Kn + ((size_t)((l * 4 + b) * 4 + h) * 256 + key) * 256 + 4 * lane) = o;
    }
    for (int it = gw; it < 256; it += NGW) {
        const int l = it >> 6, b = (it >> 4) & 3, h = (it >> 2) & 3, kb = it & 3, key = 64 * kb + lane;
        const bf16* src = kvraw + ((size_t)(l * TM + b * 256 + key)) * 2048 + 1024 + h * 256;
        bf16* dst = Vt + ((size_t)((l * 4 + b) * 4 + h) * 256) * 256 + key;
        for (int dc = 0; dc < 32; ++dc) { const v4u w = *(const GAS v4u*)(src + 8 * dc);
            dst[(size_t)(8 * dc + 0) * 256] = (bf16)(w.x & 0xffffu); dst[(size_t)(8 * dc + 1) * 256] = (bf16)(w.x >> 16);
            dst[(size_t)(8 * dc + 2) * 256] = (bf16)(w.y & 0xffffu); dst[(size_t)(8 * dc + 3) * 256] = (bf16)(w.y >> 16);
            dst[(size_t)(8 * dc + 4) * 256] = (bf16)(w.z & 0xffffu); dst[(size_t)(8 * dc + 5) * 256] = (bf16)(w.z >> 16);
            dst[(size_t)(8 * dc + 6) * 256] = (bf16)(w.w & 0xffffu); dst[(size_t)(8 * dc + 7) * 256] = (bf16)(w.w >> 16); }
    }
}

__device__ __forceinline__ void attn_unit(LAS unsigned char* lds, const bf16* proj, const float* gq, const float* gk, bf16* num, float* den, int uid, int tid) {
    asm volatile("" : "+v"(tid));
    const int g = uid >> 9, rem = uid & 511, bh = rem >> 5, j = rem & 31;
    const int dsh = 2 * g, d = 1 << dsh, n = j >> dsh, r = j & (d - 1), b = bh >> 2, h = bh & 3;
    const int base = n * (128 << dsh) + r;
    const size_t rowb = (size_t)b * SEQ;
    {
        const int c = tid & 15;
        const f32x4 ga = *(const GAS f32x4*)(gk + 8 * c), gb = *(const GAS f32x4*)(gk + 8 * c + 4);
        v4u kk[8], vv[8];
#pragma unroll
        for (int i = 0; i < 8; ++i) { const int kj = (tid >> 4) + 32 * i, pos = base + (kj - 128) * d;
            if (pos >= 0) { const bf16* p = proj + (rowb + pos) * INC + 512 + h * 128 + 8 * c; kk[i] = *(const GAS v4u*)p; vv[i] = *(const GAS v4u*)(p + 512); }
            else { kk[i] = (v4u){0u, 0u, 0u, 0u}; vv[i] = (v4u){0u, 0u, 0u, 0u}; } }
#pragma unroll
        for (int i = 0; i < 8; ++i) { const int kj = (tid >> 4) + 32 * i;
            const float a0 = bflo(kk[i].x), a1 = bfhi(kk[i].x), a2 = bflo(kk[i].y), a3 = bfhi(kk[i].y), a4 = bflo(kk[i].z), a5 = bfhi(kk[i].z), a6 = bflo(kk[i].w), a7 = bfhi(kk[i].w);
            float ss = ((a0 * a0 + a1 * a1) + (a2 * a2 + a3 * a3)) + ((a4 * a4 + a5 * a5) + (a6 * a6 + a7 * a7));
            ss += __shfl_xor(ss, 1); ss += __shfl_xor(ss, 2); ss += __shfl_xor(ss, 4); ss += __shfl_xor(ss, 8);
            const float rk = __builtin_amdgcn_rsqf(ss * (1.0f / 128.0f) + EPS);
            v4u o; o.x = pk2(a0 * rk * ga[0], a1 * rk * ga[1]); o.y = pk2(a2 * rk * ga[2], a3 * rk * ga[3]); o.z = pk2(a4 * rk * gb[0], a5 * rk * gb[1]); o.w = pk2(a6 * rk * gb[2], a7 * rk * gb[3]);
            *(LAS v4u*)(lds + kj * 256 + ((c ^ (kj & 15)) << 4)) = o;
            *(LAS v4u*)(lds + 65536 + kj * 256 + ((c ^ ((kj & 7) << 1)) << 4)) = vv[i]; }
    }
    const int w = tid >> 6, lane = tid & 63, q = lane & 15, G = lane >> 4;
    const size_t qrow = rowb + base + (size_t)(16 * w + q) * d;
    bf16x8 Qf[4];
    {
        v4u qq[4]; float ss = 0.f;
#pragma unroll
        for (int ks = 0; ks < 4; ++ks) { qq[ks] = *(const GAS v4u*)(proj + qrow * INC + h * 128 + 32 * ks + 8 * G);
            const float a0 = bflo(qq[ks].x), a1 = bfhi(qq[ks].x), a2 = bflo(qq[ks].y), a3 = bfhi(qq[ks].y), a4 = bflo(qq[ks].z), a5 = bfhi(qq[ks].z), a6 = bflo(qq[ks].w), a7 = bfhi(qq[ks].w);
            ss += ((a0 * a0 + a1 * a1) + (a2 * a2 + a3 * a3)) + ((a4 * a4 + a5 * a5) + (a6 * a6 + a7 * a7)); }
        ss += __shfl_xor(ss, 16); ss += __shfl_xor(ss, 32);
        const float rq = __builtin_amdgcn_rsqf(ss * (1.0f / 128.0f) + EPS) * (0.08838834764831845f * LOG2E);
#pragma unroll
        for (int ks = 0; ks < 4; ++ks) { const f32x4 ga = *(const GAS f32x4*)(gq + 32 * ks + 8 * G), gb = *(const GAS f32x4*)(gq + 32 * ks + 8 * G + 4);
            v4u o; o.x = pk2(bflo(qq[ks].x) * rq * ga[0], bfhi(qq[ks].x) * rq * ga[1]); o.y = pk2(bflo(qq[ks].y) * rq * ga[2], bfhi(qq[ks].y) * rq * ga[3]);
            o.z = pk2(bflo(qq[ks].z) * rq * gb[0], bfhi(qq[ks].z) * rq * gb[1]); o.w = pk2(bflo(qq[ks].w) * rq * gb[2], bfhi(qq[ks].w) * rq * gb[3]);
            Qf[ks] = __builtin_bit_cast(bf16x8, o); }
    }
    __syncthreads();
    f32x4 s[9];
#pragma unroll
    for (int t = 0; t < 9; ++t) { s[t] = (f32x4){0.f, 0.f, 0.f, 0.f}; const int krow = 16 * (w + t) + q;
#pragma unroll
        for (int ks = 0; ks < 4; ++ks) { const bf16x8 Kf = *(const LAS bf16x8*)(lds + krow * 256 + (((4 * ks + G) ^ q) << 4));
            s[t] = __builtin_amdgcn_mfma_f32_16x16x32_bf16(Kf, Qf[ks], s[t], 0, 0, 0); } }
    float dsum = 0.f; const bool first = (n == 0);
#pragma unroll
    for (int t = 0; t < 9; ++t)
#pragma unroll
        for (int e = 0; e < 4; ++e) { const int kk = 4 * G + e; bool ok = true;
            if (t == 0) ok = kk >= q; if (t == 8) ok = kk <= q; if (first && (w + t) < 8) ok = false;
            const float p = ok ? __builtin_amdgcn_exp2f(s[t][e]) : 0.f; s[t][e] = p; dsum += p; }
    dsum += __shfl_xor(dsum, 16); dsum += __shfl_xor(dsum, 32);
    f32x4 o[8];
#pragma unroll
    for (int nt = 0; nt < 8; ++nt) o[nt] = (f32x4){0.f, 0.f, 0.f, 0.f};
    const int q4 = q >> 2, pp = q & 3;
#pragma unroll
    for (int si = 0; si < 5; ++si) {
        v4u pw; pw.x = pk2(s[2 * si][0], s[2 * si][1]); pw.y = pk2(s[2 * si][2], s[2 * si][3]);
        if (si < 4) { pw.z = pk2(s[2 * si + 1][0], s[2 * si + 1][1]); pw.w = pk2(s[2 * si + 1][2], s[2 * si + 1][3]); } else { pw.z = 0u; pw.w = 0u; }
        const bf16x8 Pf = __builtin_bit_cast(bf16x8, pw);
        const int key0 = 16 * (w + 2 * si) + 4 * G + q4, key1 = (si < 4) ? key0 + 16 : key0;
        const int sw0 = (key0 & 7) << 1, sw1 = (key1 & 7) << 1;
#pragma unroll
        for (int nt = 0; nt < 8; ++nt) { const int chunk = 2 * nt + (pp >> 1);
            const s16x4 v0 = __builtin_bit_cast(s16x4, __builtin_amdgcn_ds_read_tr16_b64_v4i16((LAS s16x4*)(lds + 65536 + key0 * 256 + ((chunk ^ sw0) << 4) + (pp & 1) * 8)));
            const s16x4 v1 = __builtin_bit_cast(s16x4, __builtin_amdgcn_ds_read_tr16_b64_v4i16((LAS s16x4*)(lds + 65536 + key1 * 256 + ((chunk ^ sw1) << 4) + (pp & 1) * 8)));
            const bf16x8 Vf = (bf16x8){v0[0], v0[1], v0[2], v0[3], v1[0], v1[1], v1[2], v1[3]};
            o[nt] = __builtin_amdgcn_mfma_f32_16x16x32_bf16(Vf, Pf, o[nt], 0, 0, 0); }
    }
    bf16* np = num + ((size_t)g * T + qrow) * 512 + h * 128 + 4 * G;
#pragma unroll
    for (int nt = 0; nt < 8; ++nt) { v2u wv; wv.x = pk2(o[nt][0], o[nt][1]); wv.y = pk2(o[nt][2], o[nt][3]); *(GAS v2u*)(np + 16 * nt) = wv; }
    if (G == 0) den[((size_t)g * T + qrow) * 4 + h] = dsum;
    __syncthreads();
}

__device__ __forceinline__ float rcp_(float x) { return __builtin_amdgcn_rcpf(x); }
__device__ __forceinline__ float sigmoid_fast(float x) { return rcp_(1.0f + __builtin_amdgcn_exp2f(-LOG2E * x)); }
__device__ __forceinline__ float gelu_tanh(float x) { const float u = 0.7978845608028654f * (x + 0.044715f * x * x * x); const float e = __builtin_amdgcn_exp2f((2.0f * LOG2E) * u); return x * (1.0f - rcp_(e + 1.0f)); }
__device__ __forceinline__ void r1_unit(LAS unsigned char* lds, const bf16* proj, const float* cw, const float* cb, const bf16* GaT, const bf16* GxT, const float* ba, const float* bx, const float* lam,
                                        bf16* Y0, bf16* Y1, float* Aend, float* Hend, int uid, int tid) {
    asm volatile("" : "+v"(tid));
    const int g = uid & 3, chunk = (uid >> 2) & 31, b = uid >> 7, t0 = chunk * 128;
    const size_t rowb = (size_t)b * SEQ;
    LAS unsigned char* lxc = lds; LAS unsigned char* lgt = lds + 32768; LAS unsigned char* ly0 = lds + 65536; LAS unsigned char* ly1 = lds + 98304;
    {
        const int c8 = tid & 15, ch0 = 128 * g + 8 * c8;
        float wj[4][8], bb[8];
#pragma unroll
        for (int jj = 0; jj < 4; ++jj) { const f32x4 a = *(const GAS f32x4*)(cw + jj * 512 + ch0), c = *(const GAS f32x4*)(cw + jj * 512 + ch0 + 4);
            wj[jj][0] = a[0]; wj[jj][1] = a[1]; wj[jj][2] = a[2]; wj[jj][3] = a[3]; wj[jj][4] = c[0]; wj[jj][5] = c[1]; wj[jj][6] = c[2]; wj[jj][7] = c[3]; }
        { const f32x4 a = *(const GAS f32x4*)(cb + ch0), c = *(const GAS f32x4*)(cb + ch0 + 4); bb[0] = a[0]; bb[1] = a[1]; bb[2] = a[2]; bb[3] = a[3]; bb[4] = c[0]; bb[5] = c[1]; bb[6] = c[2]; bb[7] = c[3]; }
#pragma unroll
        for (int i = 0; i < 4; ++i) { const int tt = (tid >> 4) + 32 * i, t = t0 + tt;
            float a[8];
#pragma unroll
            for (int e = 0; e < 8; ++e) a[e] = bb[e];
#pragma unroll
            for (int jj = 0; jj < 4; ++jj) { const int ts = t - 3 + jj;
                if (ts >= 0) { const v4u x = *(const GAS v4u*)(proj + (rowb + ts) * INC + 1536 + ch0);
                    a[0] += wj[jj][0] * bflo(x.x); a[1] += wj[jj][1] * bfhi(x.x); a[2] += wj[jj][2] * bflo(x.y); a[3] += wj[jj][3] * bfhi(x.y);
                    a[4] += wj[jj][4] * bflo(x.z); a[5] += wj[jj][5] * bfhi(x.z); a[6] += wj[jj][6] * bflo(x.w); a[7] += wj[jj][7] * bfhi(x.w); } }
            v4u o; o.x = pk2(a[0], a[1]); o.y = pk2(a[2], a[3]); o.z = pk2(a[4], a[5]); o.w = pk2(a[6], a[7]);
            *(LAS v4u*)(lxc + tt * 256 + ((c8 ^ (tt & 15)) << 4)) = o;
            *(LAS v4u*)(lgt + tt * 256 + ((c8 ^ (tt & 15)) << 4)) = *(const GAS v4u*)(proj + (rowb + t) * INC + 2048 + ch0); }
    }
    const int w = tid >> 6, lane = tid & 63, q = lane & 15, G = lane >> 4;
    const int dd = 16 * w + q, ch = 128 * g + dd;
    bf16x8 Wa[4], Wx[4];
#pragma unroll
    for (int ks = 0; ks < 4; ++ks) { Wa[ks] = __builtin_bit_cast(bf16x8, *(const GAS v4u*)(GaT + dd * 128 + 32 * ks + 8 * G)); Wx[ks] = __builtin_bit_cast(bf16x8, *(const GAS v4u*)(GxT + dd * 128 + 32 * ks + 8 * G)); }
    const float bav = ba[ch], bxv = bx[ch], lv = lam[ch]; const float sp8 = 8.0f * __logf(1.0f + __expf(-lv));
    __syncthreads();
    float Arun = 1.f, Hrun = 0.f;
    const int xoff = ((dd >> 3) << 4), xlo = (dd & 7) * 2;
#pragma unroll 2
    for (int tt8 = 0; tt8 < 8; ++tt8) {
        f32x4 aA = (f32x4){0.f, 0.f, 0.f, 0.f}, aX = (f32x4){0.f, 0.f, 0.f, 0.f};
#pragma unroll
        for (int ks = 0; ks < 4; ++ks) { const bf16x8 Xf = *(const LAS bf16x8*)(lxc + (16 * tt8 + q) * 256 + (((4 * ks + G) ^ q) << 4));
            aA = __builtin_amdgcn_mfma_f32_16x16x32_bf16(Xf, Wa[ks], aA, 0, 0, 0); aX = __builtin_amdgcn_mfma_f32_16x16x32_bf16(Xf, Wx[ks], aX, 0, 0, 0); }
        float Ac[4], Hc[4]; float Ar = 1.f, Hr = 0.f;
#pragma unroll
        for (int e = 0; e < 4; ++e) { const int tt = 16 * tt8 + 4 * G + e;
            const float xcv = bf1(*(const LAS bf16*)(lxc + tt * 256 + (xoff ^ ((tt & 15) << 4)) + xlo));
            const float rg = sigmoid_fast(aA[e] + bav), ig = sigmoid_fast(aX[e] + bxv), la = -sp8 * rg, a = __builtin_amdgcn_exp2f(LOG2E * la);
            const float y = 2.0f * la; float pl = 1.0f / 120.0f; pl = pl * y + (1.0f / 24.0f); pl = pl * y + (1.0f / 6.0f); pl = pl * y + 0.5f; pl = pl * y + 1.0f;
            const float u = __builtin_amdgcn_sqrtf(-y * pl) * (ig * xcv);
            Hr = a * Hr + u; Ar = a * Ar; Ac[e] = Ar; Hc[e] = Hr; }
        float Ai = Ar, Hi = Hr;
        { const float Ap = __shfl_up(Ai, 16), Hp = __shfl_up(Hi, 16); if (G >= 1) { Hi = Ai * Hp + Hi; Ai = Ai * Ap; } }
        { const float Ap = __shfl_up(Ai, 32), Hp = __shfl_up(Hi, 32); if (G >= 2) { Hi = Ai * Hp + Hi; Ai = Ai * Ap; } }
        float Ae = __shfl_up(Ai, 16), He = __shfl_up(Hi, 16); if (G == 0) { Ae = 1.f; He = 0.f; }
        const float At = __shfl(Ai, 48 + q), Ht = __shfl(Hi, 48 + q);
        const float Ap0 = Ae * Arun, Hp0 = Ae * Hrun + He;
#pragma unroll
        for (int e = 0; e < 4; ++e) { const int tt = 16 * tt8 + 4 * G + e;
            const float Pv = Ac[e] * Ap0, hl = Hc[e] + Ac[e] * Hp0;
            const int so = tt * 256 + (xoff ^ ((tt & 15) << 4)) + xlo;
            const float gg = gelu_tanh(bf1(*(const LAS bf16*)(lgt + so)));
            *(LAS bf16*)(ly0 + so) = f2bf(hl * gg); *(LAS bf16*)(ly1 + so) = f2bf(Pv * gg); }
        Hrun = At * Hrun + Ht; Arun = At * Arun;
    }
    if (G == 0) { Aend[(size_t)(b * 32 + chunk) * 512 + ch] = Arun; Hend[(size_t)(b * 32 + chunk) * 512 + ch] = Hrun; }
    __syncthreads();
    {
        const int c8 = tid & 15;
#pragma unroll
        for (int i = 0; i < 4; ++i) { const int tt = (tid >> 4) + 32 * i; const int so = tt * 256 + ((c8 ^ (tt & 15)) << 4); const size_t off = (rowb + t0 + tt) * 512 + 128 * g + 8 * c8;
            *(GAS v4u*)(Y0 + off) = *(const LAS v4u*)(ly0 + so); *(GAS v4u*)(Y1 + off) = *(const LAS v4u*)(ly1 + so); }
    }
    __syncthreads();
}

__device__ __forceinline__ void post_unit(LAS unsigned char* lds, const bf16* num, const float* den, const bf16* Y0, const bf16* Y1, const float* Aend, const float* Hend, bf16* aout, int uid, int tid) {
    asm volatile("" : "+v"(tid));
    const int row0 = uid * 64, b = row0 >> 12, chunk = (row0 & 4095) >> 7;
    LAS float* hin = (LAS float*)lds;
    { float H = 0.f; const float* ae = Aend + (size_t)(b * 32) * 512 + tid; const float* he = Hend + (size_t)(b * 32) * 512 + tid;
      for (int s = 0; s < chunk; ++s) H = ae[(size_t)s * 512] * H + he[(size_t)s * 512];
      hin[tid] = H; }
    __syncthreads();
    const int c8 = tid & 63, rsub = tid >> 6;
    float hv[8];
#pragma unroll
    for (int e = 0; e < 8; ++e) hv[e] = hin[8 * c8 + e];
#pragma unroll
    for (int i = 0; i < 8; ++i) { const size_t row = row0 + rsub + 8 * i;
        {
            const v4u a = *(const GAS v4u*)(Y0 + row * 512 + 8 * c8), p = *(const GAS v4u*)(Y1 + row * 512 + 8 * c8); v4u o;
            o.x = pk2(bflo(a.x) + bflo(p.x) * hv[0], bfhi(a.x) + bfhi(p.x) * hv[1]); o.y = pk2(bflo(a.y) + bflo(p.y) * hv[2], bfhi(a.y) + bfhi(p.y) * hv[3]);
            o.z = pk2(bflo(a.z) + bflo(p.z) * hv[4], bfhi(a.z) + bfhi(p.z) * hv[5]); o.w = pk2(bflo(a.w) + bflo(p.w) * hv[6], bfhi(a.w) + bfhi(p.w) * hv[7]);
            *(GAS v4u*)(aout + row * 1024 + 512 + 8 * c8) = o; }
        {
            const int h = c8 >> 4;
            const float dn = den[((size_t)0 * T + row) * 4 + h] + den[((size_t)1 * T + row) * 4 + h] + den[((size_t)2 * T + row) * 4 + h]; const float inv = 1.0f / dn;
            const v4u a = *(const GAS v4u*)(num + ((size_t)0 * T + row) * 512 + 8 * c8), bq = *(const GAS v4u*)(num + ((size_t)1 * T + row) * 512 + 8 * c8), c = *(const GAS v4u*)(num + ((size_t)2 * T + row) * 512 + 8 * c8); v4u o;
            o.x = pk2((bflo(a.x) + bflo(bq.x) + bflo(c.x)) * inv, (bfhi(a.x) + bfhi(bq.x) + bfhi(c.x)) * inv); o.y = pk2((bflo(a.y) + bflo(bq.y) + bflo(c.y)) * inv, (bfhi(a.y) + bfhi(bq.y) + bfhi(c.y)) * inv);
            o.z = pk2((bflo(a.z) + bflo(bq.z) + bflo(c.z)) * inv, (bfhi(a.z) + bfhi(bq.z) + bfhi(c.z)) * inv); o.w = pk2((bflo(a.w) + bflo(bq.w) + bflo(c.w)) * inv, (bfhi(a.w) + bfhi(bq.w) + bfhi(c.w)) * inv);
            *(GAS v4u*)(aout + row * 1024 + 8 * c8) = o; }
    }
    __syncthreads();
}

__device__ __forceinline__ void poolprep_unit(LAS unsigned char* lds, const float* x, const float* ss, bf16* dd, int uid, int tid) {
    asm volatile("" : "+v"(tid));
    const int row0 = uid * 64, tb = row0 & 4095;
    LAS float* rs = (LAS float*)lds;
    if (tid < 79) { const int t = tb - 15 + tid; float r = 0.f;
        if (t >= 0) { const float* p = ss + (size_t)(row0 - 15 + tid) * 16; float s = 0.f;
#pragma unroll
            for (int e = 0; e < 16; ++e) s += p[e];
            r = 1.0f / sqrtf(s * (1.0f / 1024.0f) + EPS); }
        rs[tid] = r; }
    __syncthreads();
    const int c4 = tid & 255, half = tid >> 8, c = 4 * c4, wlen = 2 << (c >> 8);
    const int ts = tb + 32 * half;
    f32x4 sum = (f32x4){0.f, 0.f, 0.f, 0.f};
    for (int i = 1; i < wlen; ++i) { const int t = ts - i; if (t >= 0) sum += *(const GAS f32x4*)(x + (size_t)(row0 + 32 * half - i) * 1024 + c) * rs[15 + 32 * half - i]; }
    for (int k = 0; k < 32; ++k) { const int t = ts + k; const size_t row = (size_t)row0 + 32 * half + k;
        const f32x4 hcur = *(const GAS f32x4*)(x + row * 1024 + c) * rs[15 + 32 * half + k];
        sum += hcur;
        const int cnt = (t + 1 < wlen) ? t + 1 : wlen; const float inv = 1.0f / (float)cnt;
        const f32x4 dv = sum * inv - hcur;
        v2u o; o.x = pk2(dv[0], dv[1]); o.y = pk2(dv[2], dv[3]); *(GAS v2u*)(dd + row * 1024 + c) = o;
        const int told = t - wlen + 1;
        if (told >= 0) sum -= *(const GAS f32x4*)(x + (row - wlen + 1) * 1024 + c) * rs[15 + 32 * half + k - wlen + 1]; }
    __syncthreads();
}

#ifndef MK_TEST
constexpr int N_PHASES = 41;
__global__ void __launch_bounds__(NWAVES * 64, 2) mk_fwd(Args args) {
    extern __shared__ __attribute__((aligned(16))) unsigned char lds_raw[];
    LAS unsigned char* lds = (LAS unsigned char*)lds_raw;
    volatile LAS unsigned* MISC = (volatile LAS unsigned*)(lds + MISC_OFF);
#define ws ld_ws(args)
    const int tid = threadIdx.x, wave = __builtin_amdgcn_readfirstlane(tid >> 6);
    const int G = gridDim.x, bid = blockIdx.x;
    const int vcu = (G % 8 == 0) ? (bid % 8) * (G / 8) + bid / 8 : bid;
    const int gw = vcu * NWAVES + wave, NGW = G * NWAVES;
    for (int u = tid; u < (LDS_BYTES - LDSCTL_OFF) / 4; u += NWAVES * 64) ((LAS unsigned*)(lds + LDSCTL_OFF))[u] = 0u;
    __syncthreads();
    unsigned* ctl = (unsigned*)(ws + WS_CTL);
    XcdBarrier bar; bar.bar = ctl + 1024; bar.x = 0; bar.st = nullptr;
    if (MK_N_LAUNCHES == 1) bar = xcd_barrier_post(ctl + 1024, MISC + 8);
#if MK_N_LAUNCHES != 1
    const int lo = args.ph_lo, hi = args.ph_hi;
#endif
#if MK_N_LAUNCHES == 1
#define IN(k) true
#else
#define IN(k) (lo <= (k) && (k) < hi)
#endif
#define SEAM(k) do { if (MK_N_LAUNCHES == 1 && (k) + 1 < N_PHASES) { for (int b_ = 0; b_ < REP_BAR; ++b_) xcd_barrier(bar); } } while (0)
#define ZEROS ((const float*)(ws + WS_CTL + 32768))

#define SS ((float*)(ws + WS_SS))
#define QSS ((float*)(ws + WS_QSS))
#define LSUM ((float*)(ws + WS_LSUM))
#define DEN ((float*)(ws + WS_DEN))
#define AEND ((float*)(ws + WS_AEND))
#define HEND ((float*)(ws + WS_HEND))
#define XB ((bf16*)(ws + WS_XB))
#define PROJ ((bf16*)(ws + WS_PROJ))
#define NUM ((bf16*)(ws + WS_NUM))
#define AOUT ((bf16*)(ws + WS_AOUT))
#define QB ((bf16*)(ws + WS_Q))
#define PB ((bf16*)(ws + WS_P))
#define OB ((bf16*)(ws + WS_O))
#define HID ((bf16*)(ws + WS_HID))
#define Y0 ((bf16*)(ws + WS_Y0))
#define Y1 ((bf16*)(ws + WS_Y1))
#define KVRAW ((bf16*)((unsigned char*)OUTP() + DO_KVRAW))
#define MEMN ((bf16*)((unsigned char*)OUTP() + DO_MEMN))
#ifndef NO_PRO
    if (IN(0)) { REPEAT(REP_P0) { p0_prologue(args, lds, gw, NGW, wave); REP_SEAM(REP_P0); } SEAM(0); }
#endif

    for (int l = 0; l < 4; ++l) {
        const int pb = 1 + 10 * l;
        const float* xin = (l == 0) ? INP(0) : OUTP();
        if ((l & 1) == 0) {
            const int e = l >> 1;
            if (IN(pb + 0)) { REPEAT(REP_A1) {
                { pg8::Gemm g{XB, (const bf16*)(ws + WS_WIN) + (size_t)e * INC * D, D, D, D, ~0, 0, (long)256 * D, 30, 0};
                  pg8::StaticOrder S; S.init(T / 256, INC / 256, G, bid);
                  pg8::EpiBf16<1> E{PROJ, INC, SS, nullptr};
                  pg8::gemm_phase(lds, g, S, E); }
                if (l == 0) { pg8::Gemm g{MEMN, (const bf16*)(ws + WS_WKV), D, D, D, 3, 0, (long)256 * D, 2, (long)2048 * D};
                  pg8::StaticOrder S; S.init(16, 8, G - 128, bid >= 128 ? bid - 128 : (1 << 20));
                  pg8::EpiBf16<0> E{KVRAW, 2048, nullptr, nullptr};
                  pg8::gemm_phase(lds, g, S, E); }
                REP_SEAM(REP_A1); }
                SEAM(pb + 0); }
            if (IN(pb + 1)) { REPEAT(REP_A2) {
#ifndef NO_KVF
                if (l == 0) for (int r2_ = 0; r2_ < REP_KVF; ++r2_) kv_finalize(args, gw, NGW);
#endif
                for (int u = bid; u < 2048; u += G) {
#ifndef NO_ATTN
                    if (u < 1536) for (int r2_ = 0; r2_ < REP_ATTN; ++r2_) attn_unit(lds, PROJ, INP(7) + e * 128, INP(8) + e * 128, NUM, DEN, u, tid);
#endif
#ifndef NO_R1
                    if (u >= 1536) for (int r2_ = 0; r2_ < REP_R1; ++r2_) r1_unit(lds, PROJ, INP(9) + e * 2048, INP(10) + e * 512, (const bf16*)(ws + WS_GT) + (size_t)((e * 2 + 0) * 4 + ((u - 1536) & 3)) * 16384, (const bf16*)(ws + WS_GT) + (size_t)((e * 2 + 1) * 4 + ((u - 1536) & 3)) * 16384,
                                 INP(12) + e * 512, INP(14) + e * 512, INP(15) + e * 512, Y0, Y1, AEND, HEND, u - 1536, tid);
#endif
                }
                REP_SEAM(REP_A2); }
                SEAM(pb + 1); }
            if (IN(pb + 2)) { REPEAT(REP_A3) {
#ifndef NO_POST
                for (int u = bid; u < 256; u += G) post_unit(lds, NUM, DEN, Y0, Y1, AEND, HEND, AOUT, u, tid);
#endif
                REP_SEAM(REP_A3); }
                SEAM(pb + 2); }
            if (IN(pb + 3)) { REPEAT(REP_A4) {
                pg8::Gemm g{AOUT, (const bf16*)(ws + WS_WOUT) + (size_t)e * D * D, D, D, D, ~0, 0, (long)256 * D, 30, 0};
                pg8::StaticOrder S; S.init(T / 256, 4, G, bid);
                pg8::EpiRes E{rep_ ? OUTP() : xin, OUTP(), XB, SS, rep_ ? ZEROS : nullptr};
                pg8::gemm_phase(lds, g, S, E);
                REP_SEAM(REP_A4); }
                SEAM(pb + 3); }
        } else {
            const int o = l >> 1;
            if (IN(pb + 0)) { REPEAT(REP_B1) {
#ifndef NO_POOL
                for (int u = bid; u < 256; u += G) poolprep_unit(lds, OUTP(), SS, AOUT, u, tid);
#endif
                REP_SEAM(REP_B1); }
                SEAM(pb + 0); }
            if (IN(pb + 1)) { REPEAT(REP_B2) {
                pg8::Gemm g{AOUT, (const bf16*)(ws + WS_POOLT) + (size_t)o * 4 * 65536, D, 256, 256, ~0, 256, (long)65536, 30, 0};
                pg8::StaticOrder S; S.init(T / 256, 4, G, bid);
                pg8::EpiRes E{OUTP(), OUTP(), XB, SS, rep_ ? ZEROS : INP(18) + o * D};
                pg8::gemm_phase(lds, g, S, E);
                REP_SEAM(REP_B2); }
                SEAM(pb + 3); }
        }
        if (IN(pb + 4)) { REPEAT(REP_X1) {
            pg8::Gemm g{XB, (const bf16*)(ws + WS_WQ) + (size_t)l * D * D, D, D, D, ~0, 0, (long)256 * D, 30, 0};
            pg8::StaticOrder S; S.init(T / 256, 4, G, bid);
            pg8::EpiBf16<3> E{QB, D, SS, QSS};
            pg8::gemm_phase(lds, g, S, E);
            REP_SEAM(REP_X1); }
            SEAM(pb + 4); }
        if (IN(pb + 5)) { REPEAT(REP_X2) {
            pg8::Gemm g{QB, (const bf16*)(ws + WS_KN) + (size_t)l * 16 * 65536, D, 256, 256, ~0, 256, (long)65536, 4, (long)4 * 65536};
            pg8::StaticOrder S; S.init(T / 256, 4, G, bid);
            pg8::EpiBf16<4> E{PB, D, QSS, LSUM};
            pg8::gemm_phase(lds, g, S, E);
            REP_SEAM(REP_X2); }
            SEAM(pb + 5); }
        if (IN(pb + 6)) { REPEAT(REP_X3) {
            pg8::Gemm g{PB, (const bf16*)(ws + WS_VT) + (size_t)l * 16 * 65536, D, 256, 256, ~0, 256, (long)65536, 4, (long)4 * 65536};
            pg8::StaticOrder S; S.init(T / 256, 4, G, bid);
            pg8::EpiBf16<5> E{OB, D, LSUM, nullptr};
            pg8::gemm_phase(lds, g, S, E);
            REP_SEAM(REP_X3); }
            SEAM(pb + 6); }
        if (IN(pb + 7)) { REPEAT(REP_X4) {
            pg8::Gemm g{OB, (const bf16*)(ws + WS_WO) + (size_t)l * D * D, D, D, D, ~0, 0, (long)256 * D, 30, 0};
            pg8::StaticOrder S; S.init(T / 256, 4, G, bid);
            pg8::EpiRes E{OUTP(), OUTP(), XB, SS, rep_ ? ZEROS : nullptr};
            pg8::gemm_phase(lds, g, S, E);
            REP_SEAM(REP_X4); }
            SEAM(pb + 7); }
        if (IN(pb + 8)) { REPEAT(REP_M1) {
            pg8::Gemm g{XB, (const bf16*)(ws + WS_W1) + (size_t)l * FF * D, D, D, D, ~0, 0, (long)256 * D, 30, 0};
            pg8::StaticOrder S; S.init(T / 256, FF / 256, G, bid);
            pg8::EpiBf16<2> E{HID, FF, SS, nullptr};
            pg8::gemm_phase(lds, g, S, E);
            REP_SEAM(REP_M1); }
            SEAM(pb + 8); }
        if (IN(pb + 9)) { REPEAT(REP_M2) {
            pg8::Gemm g{HID, (const bf16*)(ws + WS_W2) + (size_t)l * D * FF, FF, FF, FF, ~0, 0, (long)256 * FF, 30, 0};
            pg8::StaticOrder S; S.init(T / 256, 4, G, bid);
            pg8::EpiRes E{OUTP(), OUTP(), XB, SS, rep_ ? ZEROS : nullptr};
            pg8::gemm_phase(lds, g, S, E);
            REP_SEAM(REP_M2); }
            SEAM(pb + 9); }
    }
#undef IN
#undef SEAM
#undef ws
}

extern "C" void kernel_launch(void* const* d_in, const int* in_sizes, int n_in, void* d_out, int out_size, void* d_ws, size_t ws_size, hipStream_t stream) {
    static int grid = 0;
    if (grid == 0) {
        if (n_in != 26 || in_sizes[0] != T * D || out_size != T * D || ws_size < WS_END) { fprintf(stderr, "kernel_launch: unexpected shapes: n_in %d in0 %d out %d ws %zu (need %zu); nothing launched\n", n_in, n_in > 0 ? in_sizes[0] : -1, out_size, ws_size, (size_t)WS_END); grid = -1; return; }
        int dev = 0, cus = 0, per_cu = 0;
        if (hipGetDevice(&dev) != hipSuccess || hipDeviceGetAttribute(&cus, hipDeviceAttributeMultiprocessorCount, dev) != hipSuccess) { grid = -1; return; }
        if (hipFuncSetAttribute((const void*)mk_fwd, hipFuncAttributeMaxDynamicSharedMemorySize, LDS_BYTES) != hipSuccess) { fprintf(stderr, "kernel_launch: hipFuncSetAttribute failed\n"); grid = -1; return; }
        if (hipOccupancyMaxActiveBlocksPerMultiprocessor(&per_cu, (const void*)mk_fwd, NWAVES * 64, LDS_BYTES) != hipSuccess || per_cu < 1) fprintf(stderr, "kernel_launch: occupancy query reports %d\n", per_cu);
        (void)hipGetLastError();
        grid = cus;
        if (grid != 256) fprintf(stderr, "kernel_launch: %d CUs (built for 256)\n", grid);
    }
    if (grid < 0) return;
    (void)hipMemsetAsync((char*)d_ws + WS_CTL, 0, CTL_ZERO_BYTES, stream);
    Args a{};
    for (int i = 0; i < 26; ++i) a.p.in[i] = (const float*)d_in[i];
    a.p.out = (float*)d_out; a.p.ws = (unsigned char*)d_ws;
    if (MK_N_LAUNCHES == 1) { a.ph_lo = 0; a.ph_hi = N_PHASES; hipLaunchKernelGGL(mk_fwd, dim3(grid), dim3(NWAVES * 64), LDS_BYTES, stream, a); }
    else {
        for (int k = 0; k < N_PHASES; ++k) {
            const int l = (k - 1) / 10, s = (k - 1) % 10;
            if (k > 0 && (l & 1) == 1 && (s == 2 || s == 3)) continue;
            a.ph_lo = k; a.ph_hi = k + 1; hipLaunchKernelGGL(mk_fwd, dim3(grid), dim3(NWAVES * 64), LDS_BYTES, stream, a);
        }
    }
}
#endif
```

```cpp
#include <hip/hip_runtime.h>
#include <cstdio>
#include <cstdint>

#ifndef MK_N_LAUNCHES
#define MK_N_LAUNCHES 1
#endif

#ifndef REP_P0
#define REP_P0 1
#endif
#ifndef REP_A1
#define REP_A1 1
#endif
#ifndef REP_A2
#define REP_A2 1
#endif
#ifndef REP_A3
#define REP_A3 1
#endif
#ifndef REP_A4
#define REP_A4 1
#endif
#ifndef REP_B1
#define REP_B1 1
#endif
#ifndef REP_B2
#define REP_B2 1
#endif
#ifndef REP_X1
#define REP_X1 1
#endif
#ifndef REP_X2
#define REP_X2 1
#endif
#ifndef REP_X3
#define REP_X3 1
#endif
#ifndef REP_X4
#define REP_X4 1
#endif
#ifndef REP_M1
#define REP_M1 1
#endif
#ifndef REP_M2
#define REP_M2 1
#endif
#ifndef REP_BAR
#define REP_BAR 1
#endif
#ifndef REP_ATTN
#define REP_ATTN 1
#endif
#ifndef REP_R1
#define REP_R1 1
#endif
#ifndef REP_KVF
#define REP_KVF 1
#endif
#define REPEAT(n) for (int rep_ = 0; rep_ < (n); ++rep_)
#define REP_SEAM(n) do { if (rep_ + 1 < (n)) xcd_barrier(bar); } while (0)
namespace pg8 {
#define PG8_LAS __attribute__((address_space(3)))
typedef unsigned short bf16_t;
typedef short bf16x8 __attribute__((ext_vector_type(8)));
typedef float f32x4 __attribute__((ext_vector_type(4)));
typedef float f32x2 __attribute__((ext_vector_type(2)));
typedef unsigned u32x4 __attribute__((ext_vector_type(4)));
typedef unsigned u32x2 __attribute__((ext_vector_type(2)));
constexpr int BM = 256, BK = 64, HALF = 128, HTB = HALF * BK * 2, STAGE_BYTES = 8 * HTB, NXCD = 8, WGM = 8;

__host__ __device__ __forceinline__ int lds_byte(int r, int c) { const int st = (r >> 4) * 2 + (c >> 5), rr = r & 15, cc = c & 31, ob = rr * 64 + cc * 2; return st * 1024 + (ob ^ (((ob >> 9) & 1) << 5)); }
__host__ __device__ __forceinline__ void stage_rc(int b, int& R, int& C) { const int st = b / 1024, sb = b % 1024, swz = sb ^ (((sb >> 9) & 1) << 5); R = (st >> 1) * 16 + swz / 64; C = (st & 1) * 32 + (swz % 64) / 2; }
__host__ __device__ __forceinline__ int perm32(int rho) { const int n = rho >> 4, i = rho & 15; return 8 * (i >> 2) + 4 * n + (i & 3); }

struct Unit { int pm, pn; };
struct Gemm { const bf16_t* A; const bf16_t* Bt; int lda, ldb, K; int a_pm_mask, a_pn_cols; long b_pn_elems; int b_pm_shift; long b_batch_elems; };

struct StaticOrder {
    int nM, nN, nwg, G, c;
    __host__ __device__ void init(int nM_, int nN_, int G_, int c_) { nM = nM_; nN = nN_; nwg = nM * nN; G = G_; c = c_; }
    __host__ __device__ bool next(int i, Unit& u) const {
        const long L = (long)i * G + c; if (L >= nwg) return false;
        int wgid = (int)L; { const int q = nwg / NXCD, r = nwg % NXCD, xcd = wgid % NXCD, off = wgid / NXCD; wgid = (xcd < r ? xcd * (q + 1) : r * (q + 1) + (xcd - r) * q) + off; }
        const int nig = WGM * nN, gid = wgid / nig, fm = gid * WGM, gsz = (nM - fm) < WGM ? (nM - fm) : WGM;
        u.pm = fm + ((wgid % nig) % gsz); u.pn = (wgid % nig) / gsz; return true;
    }
};

__device__ __forceinline__ unsigned cvt_pk_bf16(float lo, float hi) { unsigned r; asm volatile("v_cvt_pk_bf16_f32 %0, %1, %2" : "=v"(r) : "v"(lo), "v"(hi)); return r; }

constexpr float EPS = 1e-6f;
template <int MODE> struct EpiBf16 {
    static constexpr bool PERM = true;
    bf16_t* O; int ldc; const float* aux_in; float* aux_out;
    __device__ __forceinline__ void operator()(const f32x4 (&acc)[2][2][4][2], const Unit& u, int wr, int wc, int fr, int fq) const {
        const int row0 = u.pm * BM + wr * 64 + fr, col0 = u.pn * BM + wc * 32 + 8 * fq;
#pragma unroll
        for (int ai = 0; ai < 2; ++ai)
#pragma unroll
            for (int m = 0; m < 4; ++m) {
                const int row = row0 + ai * HALF + m * 16; float f = 1.f;
                if (MODE >= 1 && MODE <= 3) { const f32x4 v = *(const f32x4*)(aux_in + (size_t)row * 16 + fq * 4); float s = (v[0] + v[1]) + (v[2] + v[3]); s += __shfl_xor(s, 16); s += __shfl_xor(s, 32); f = __builtin_amdgcn_rsqf(s * (1.0f / 1024.0f) + EPS); }
                if (MODE == 4) { const f32x4 v = *(const f32x4*)(aux_in + (size_t)row * 16 + u.pn * 4); const float s = (v[0] + v[1]) + (v[2] + v[3]); f = __builtin_amdgcn_rsqf(s * (1.0f / 256.0f) + EPS); }
                if (MODE == 5) { const f32x4 v = *(const f32x4*)(aux_in + (size_t)row * 16 + u.pn * 4); const float s = (v[0] + v[1]) + (v[2] + v[3]); f = 1.0f / s; }
                bf16_t* rowp = O + (size_t)row * ldc + col0; float part = 0.f;
#pragma unroll
                for (int bj = 0; bj < 2; ++bj) { f32x4 v0 = acc[ai][bj][m][0] * f, v1 = acc[ai][bj][m][1] * f;
                    if (MODE == 2) {
#pragma unroll
                        for (int e = 0; e < 4; ++e) { const float a = v0[e] > 0.f ? v0[e] : 0.f, b = v1[e] > 0.f ? v1[e] : 0.f; v0[e] = a * a; v1[e] = b * b; } }
                    if (MODE == 4) {
#pragma unroll
                        for (int e = 0; e < 4; ++e) { v0[e] = __builtin_amdgcn_exp2f(v0[e]); v1[e] = __builtin_amdgcn_exp2f(v1[e]); } }
                    if (MODE == 3) part += (v0[0] * v0[0] + v0[1] * v0[1]) + (v0[2] * v0[2] + v0[3] * v0[3]) + (v1[0] * v1[0] + v1[1] * v1[1]) + (v1[2] * v1[2] + v1[3] * v1[3]);
                    if (MODE == 4) part += (v0[0] + v0[1]) + (v0[2] + v0[3]) + (v1[0] + v1[1]) + (v1[2] + v1[3]);
                    u32x4 w; w.x = cvt_pk_bf16(v0[0], v0[1]); w.y = cvt_pk_bf16(v0[2], v0[3]); w.z = cvt_pk_bf16(v1[0], v1[1]); w.w = cvt_pk_bf16(v1[2], v1[3]);
                    *(u32x4*)(rowp + bj * HALF) = w; }
                if (MODE == 3 || MODE == 4) { part += __shfl_xor(part, 16); part += __shfl_xor(part, 32); if (fq == 0) aux_out[(size_t)row * 16 + u.pn * 4 + wc] = part; }
            }
    }
};
struct EpiRes {
    static constexpr bool PERM = false;
    const float* xin; float* xout; bf16_t* xb; float* ss; const float* scale;
    __device__ __forceinline__ void operator()(const f32x4 (&acc)[2][2][4][2], const Unit& u, int wr, int wc, int fr, int fq) const {
        const int row0 = u.pm * BM + wr * 64 + fr, col0 = u.pn * BM + wc * 32 + 4 * fq;
#pragma unroll
        for (int ai = 0; ai < 2; ++ai)
#pragma unroll
            for (int m = 0; m < 4; ++m) {
                const int row = row0 + ai * HALF + m * 16; const size_t off = (size_t)row * 1024 + col0; float sq = 0.f;
#pragma unroll
                for (int bj = 0; bj < 2; ++bj)
#pragma unroll
                    for (int n = 0; n < 2; ++n) { const int co = bj * HALF + n * 16; f32x4 a = acc[ai][bj][m][n];
                        if (scale) a = a * *(const f32x4*)(scale + col0 + co);
                        const f32x4 x = *(const f32x4*)(xin + off + co) + a; *(f32x4*)(xout + off + co) = x;
                        sq += (x[0] * x[0] + x[1] * x[1]) + (x[2] * x[2] + x[3] * x[3]);
                        u32x2 w; w.x = cvt_pk_bf16(x[0], x[1]); w.y = cvt_pk_bf16(x[2], x[3]); *(u32x2*)(xb + off + co) = w; }
                sq += __shfl_xor(sq, 16); sq += __shfl_xor(sq, 32); if (fq == 0) ss[(size_t)row * 16 + u.pn * 4 + wc] = sq;
                asm volatile("" ::: "memory");
            }
    }
};

template <class Epi, class Sched>
__device__ __forceinline__ void gemm_phase(PG8_LAS unsigned char* lds, const Gemm g, const Sched& S, const Epi& E) {
    int tid_ = threadIdx.x; asm volatile("" : "+v"(tid_));
    const int tid = tid_, wid = __builtin_amdgcn_readfirstlane(tid >> 6), lane = tid & 63, wr = wid >> 2, wc = wid & 3, fr = lane & 15, fq = lane >> 4;
    int K_ = g.K; asm volatile("" : "+s"(K_));
    const int K = K_, nt = K / BK;
    unsigned voffA[2], voffB[2];
#pragma unroll
    for (int i = 0; i < 2; ++i) { int R, C; stage_rc(tid * 16 + i * 8192, R, C); const int Rb = Epi::PERM ? ((R & ~31) + perm32(R & 31)) : R;
        voffA[i] = (unsigned)(R * g.lda + C) * 2u; voffB[i] = (unsigned)(Rb * g.ldb + C) * 2u; }
    const size_t kstep = (size_t)(BK * 2);
    const size_t hstepA = (size_t)HALF * g.lda * 2, hstepB = (size_t)HALF * g.ldb * 2;
    const unsigned ldsw = (unsigned)wid * 1024u;
    const int aoff = lds_byte(wr * 64 + fr, fq * 8), boff = lds_byte(wc * 32 + fr, fq * 8);
#define PG8_SA(b, h) (((b) * 2 + (h)) * HTB)
#define PG8_SB(b, h) ((4 + (b) * 2 + (h)) * HTB)
#define PG8_STAGE(bufoff, gbase, voff) do { _Pragma("unroll") for (int _i = 0; _i < 2; ++_i) \
        __builtin_amdgcn_global_load_lds((const unsigned*)((const char*)(gbase) + (voff)[_i]), (PG8_LAS unsigned*)(lds + (bufoff) + ldsw + _i * 8192), 16, 0, 0); } while (0)
#define PG8_LDA(dst, b, h) do { _Pragma("unroll") for (int m = 0; m < 4; ++m) _Pragma("unroll") for (int k = 0; k < 2; ++k) dst[m][k] = *(const PG8_LAS bf16x8*)(lds + PG8_SA(b, h) + aoff + m * 2048 + k * 1024); } while (0)
#define PG8_LDB(dst, b, h) do { _Pragma("unroll") for (int n = 0; n < 2; ++n) _Pragma("unroll") for (int k = 0; k < 2; ++k) dst[n][k] = *(const PG8_LAS bf16x8*)(lds + PG8_SB(b, h) + boff + n * 2048 + k * 1024); } while (0)
#define PG8_MMA(ai, bj, At, Bt) do { __builtin_amdgcn_s_setprio(1); _Pragma("unroll") for (int m = 0; m < 4; ++m) _Pragma("unroll") for (int n = 0; n < 2; ++n) _Pragma("unroll") for (int k = 0; k < 2; ++k) \
        acc[ai][bj][m][n] = __builtin_amdgcn_mfma_f32_16x16x32_bf16(Bt[n][k], At[m][k], acc[ai][bj][m][n], 0, 0, 0); __builtin_amdgcn_s_setprio(0); } while (0)
#define PG8_WAIT_V(n) asm volatile("s_waitcnt vmcnt(" #n ")" ::: "memory")
#define PG8_WAIT_L(n) asm volatile("s_waitcnt lgkmcnt(" #n ")" ::: "memory")
#define PG8_BAR __builtin_amdgcn_s_barrier()
#define PG8_SCHED __builtin_amdgcn_sched_barrier(0)
#define PG8_APTR(u) ((const char*)g.A + ((size_t)((u).pm & g.a_pm_mask) * 256 * g.lda + (size_t)(u).pn * g.a_pn_cols) * 2)
#define PG8_BPTR(u) ((const char*)g.Bt + ((size_t)(u).pn * g.b_pn_elems + (size_t)((u).pm >> g.b_pm_shift) * g.b_batch_elems) * 2)
    Unit cur, nxt; int ui = 0;
    if (!S.next(0, cur)) return;
    f32x4 acc[2][2][4][2];
#pragma unroll
    for (int a = 0; a < 2; ++a)
#pragma unroll
        for (int b = 0; b < 2; ++b)
#pragma unroll
            for (int m = 0; m < 4; ++m)
#pragma unroll
                for (int n = 0; n < 2; ++n) acc[a][b][m][n] = (f32x4){0.f, 0.f, 0.f, 0.f};
    bf16x8 At[4][2], B0[2][2], B1[2][2];
    const char* cA = PG8_APTR(cur); const char* cB = PG8_BPTR(cur);
    PG8_STAGE(PG8_SB(0, 0), cB, voffB); PG8_STAGE(PG8_SB(0, 1), cB + hstepB, voffB); PG8_STAGE(PG8_SA(0, 0), cA, voffA); PG8_STAGE(PG8_SA(0, 1), cA + hstepA, voffA);
    if (wr == 1) PG8_BAR;
    PG8_WAIT_V(2); PG8_BAR;
    PG8_STAGE(PG8_SB(1, 0), cB + kstep, voffB); PG8_STAGE(PG8_SA(1, 0), cA + kstep, voffA); PG8_STAGE(PG8_SB(1, 1), cB + hstepB + kstep, voffB);
    PG8_WAIT_V(6); PG8_BAR;
    for (;;) {
        const bool has_next = S.next(ui + 1, nxt);
        const char* nA = has_next ? PG8_APTR(nxt) : cA; const char* nB = has_next ? PG8_BPTR(nxt) : cB;
        for (int t = 0; t < nt; t += 2) {
            const bool last = (t == nt - 2);
            const char* a1 = cA + (size_t)(t + 1) * kstep;
            const char* a2 = last ? nA : cA + (size_t)(t + 2) * kstep; const char* b2 = last ? nB : cB + (size_t)(t + 2) * kstep;
            const char* a3 = a2 + kstep; const char* b3 = b2 + kstep;
            PG8_LDB(B0, 0, 0); PG8_LDB(B1, 0, 1); PG8_SCHED; PG8_LDA(At, 0, 0); PG8_STAGE(PG8_SA(1, 1), a1 + hstepA, voffA);
            PG8_WAIT_V(8); PG8_WAIT_L(0); PG8_BAR; PG8_MMA(0, 0, At, B0); PG8_MMA(0, 1, At, B1); PG8_BAR; PG8_SCHED;
            PG8_LDA(At, 0, 1); PG8_STAGE(PG8_SB(0, 0), b2, voffB); PG8_STAGE(PG8_SB(0, 1), b2 + hstepB, voffB); PG8_STAGE(PG8_SA(0, 0), a2, voffA);
            PG8_WAIT_V(8); PG8_WAIT_L(0); PG8_BAR; PG8_MMA(1, 0, At, B0); PG8_MMA(1, 1, At, B1); PG8_BAR; PG8_SCHED;
            PG8_LDB(B0, 1, 0); PG8_LDB(B1, 1, 1); PG8_SCHED; PG8_LDA(At, 1, 0); PG8_STAGE(PG8_SA(0, 1), a2 + hstepA, voffA);
            PG8_WAIT_V(8); PG8_WAIT_L(0); PG8_BAR; PG8_MMA(0, 0, At, B0); PG8_MMA(0, 1, At, B1); PG8_BAR; PG8_SCHED;
            PG8_LDA(At, 1, 1); PG8_STAGE(PG8_SB(1, 0), b3, voffB); PG8_STAGE(PG8_SB(1, 1), b3 + hstepB, voffB); PG8_STAGE(PG8_SA(1, 0), a3, voffA);
            PG8_WAIT_V(8); PG8_WAIT_L(0); PG8_BAR; PG8_MMA(1, 0, At, B0); PG8_MMA(1, 1, At, B1); PG8_BAR; PG8_SCHED;
        }
        if (wr == 0) PG8_BAR;
        E(acc, cur, wr, wc, fr, fq);
        if (!has_next) break;
#pragma unroll
        for (int a = 0; a < 2; ++a)
#pragma unroll
            for (int b = 0; b < 2; ++b)
#pragma unroll
                for (int m = 0; m < 4; ++m)
#pragma unroll
                    for (int n = 0; n < 2; ++n) acc[a][b][m][n] = (f32x4){0.f, 0.f, 0.f, 0.f};
        cur = nxt; cA = nA; cB = nB; ++ui;
        if (wr == 1) PG8_BAR;
    }
    PG8_WAIT_V(0);
    PG8_BAR;
#undef PG8_SA
#undef PG8_SB
#undef PG8_STAGE
#undef PG8_LDA
#undef PG8_LDB
#undef PG8_MMA
#undef PG8_WAIT_V
#undef PG8_WAIT_L
#undef PG8_BAR
#undef PG8_SCHED
#undef PG8_APTR
#undef PG8_BPTR
}
}

constexpr int NWAVES = 8;
constexpr int D = 1024, BATCH = 4, SEQ = 4096, T = BATCH * SEQ, NMEM = 256, TM = BATCH * NMEM, FF = 4096, INC = 2560;
constexpr float EPS = 1e-6f;
constexpr float LOG2E = 1.4426950408889634f;

constexpr size_t MiB = 1u << 20;
constexpr size_t WS_CTL = 0, CTL_ZERO_BYTES = 64 * 1024;
constexpr size_t WS_SS = 1 * MiB, WS_QSS = 2 * MiB, WS_LSUM = 3 * MiB, WS_DEN = 4 * MiB, WS_AEND = 5 * MiB, WS_HEND = 5 * MiB + 256 * 1024;
constexpr size_t WS_GT = 6 * MiB, WS_POOLT = 7 * MiB;
constexpr size_t WS_WIN = 8 * MiB, WS_WOUT = 18 * MiB, WS_WQ = 22 * MiB, WS_WO = 30 * MiB, WS_W1 = 38 * MiB, WS_W2 = 70 * MiB, WS_WKV = 102 * MiB;
constexpr size_t WS_KN = 102 * MiB, WS_VT = 110 * MiB;
constexpr size_t WS_XB = 118 * MiB, WS_Y0 = 118 * MiB, WS_Y1 = 134 * MiB;
constexpr size_t WS_HID = 150 * MiB, WS_PROJ = 150 * MiB, WS_NUM = 230 * MiB, WS_AOUT = 150 * MiB, WS_Q = 182 * MiB, WS_P = 214 * MiB, WS_O = 246 * MiB;
constexpr size_t WS_END = 278 * MiB;
constexpr size_t DO_KVRAW = 0, DO_MEMN = 16 * MiB;

constexpr int RING_BYTES = 131072, LDSCTL_OFF = RING_BYTES, MISC_OFF = LDSCTL_OFF + 320, LDS_BYTES = 147456;

#define GAS __attribute__((address_space(1)))
#define LAS __attribute__((address_space(3)))
typedef unsigned short bf16;
typedef unsigned v4u __attribute__((ext_vector_type(4)));
typedef unsigned v2u __attribute__((ext_vector_type(2)));
typedef float f32x4 __attribute__((ext_vector_type(4)));
typedef short bf16x8 __attribute__((ext_vector_type(8)));
typedef short s16x4 __attribute__((ext_vector_type(4)));
#define LDS_WAIT() asm volatile("s_waitcnt lgkmcnt(0)" ::: "memory")
#define VM_WAIT() asm volatile("s_waitcnt vmcnt(0)" ::: "memory")
__device__ __forceinline__ unsigned pk2(float lo, float hi) { return pg8::cvt_pk_bf16(lo, hi); }
__device__ __forceinline__ float bflo(unsigned w) { return __uint_as_float(w << 16); }
__device__ __forceinline__ float bfhi(unsigned w) { return __uint_as_float(w & 0xffff0000u); }
__device__ __forceinline__ float bf1(bf16 h) { return __uint_as_float((unsigned)h << 16); }
__device__ __forceinline__ bf16 f2bf(float f) { return (bf16)(pg8::cvt_pk_bf16(f, 0.f) & 0xffffu); }

#define XB_TMO      128
#define XB_XCNT(j)  (256  + 64 * (j))
#define XB_XSUB(j)  (1280 + 64 * (j))
#define XB_XGEN(j)  (2304 + 64 * (j))
#define XB_TOP      3328
#define XB_TOPGEN   3392
#define XCD_BAR_WORDS 3456
#define XB_SPIN_CAP (1u << 22)
__device__ __forceinline__ unsigned xb_ld(unsigned* p)              { return __hip_atomic_load(p, __ATOMIC_RELAXED, __HIP_MEMORY_SCOPE_AGENT); }
__device__ __forceinline__ unsigned xb_add(unsigned* p, unsigned v) { return __hip_atomic_fetch_add(p, v, __ATOMIC_RELAXED, __HIP_MEMORY_SCOPE_AGENT); }
__device__ __forceinline__ unsigned xb_xcc_id() { return (unsigned)__builtin_amdgcn_s_getreg((3 << 11) | 20) & 0xFu; }
#define XB_SPIN(cond, bar) do { unsigned _sp = 0; while (cond) { __builtin_amdgcn_s_sleep(1); \
    if ((++_sp & 255u) == 0u) { if (xb_ld(&(bar)[XB_TMO])) break; if (_sp > XB_SPIN_CAP) { atomicAdd(&(bar)[XB_TMO], 1u); break; } } } } while (0)
struct XcdBarrier { unsigned* bar; unsigned x; volatile LAS unsigned* st; };
__device__ __forceinline__ XcdBarrier xcd_barrier_post(unsigned* bar, volatile LAS unsigned* st) {
    XcdBarrier b; b.bar = bar; b.x = xb_xcc_id(); b.st = st;
    if (threadIdx.x == 0) (void)xb_add(&bar[XB_XCNT(b.x)], 1u);
    return b;
}
__device__ __forceinline__ void xcd_barrier_complete(unsigned* bar, unsigned x, unsigned& nloc, unsigned& nx) {
    const unsigned G = gridDim.x * gridDim.y * gridDim.z;
    unsigned sum, cnt, mine, sp = 0u;
    for (;;) {
        sum = 0u; cnt = 0u; mine = 0u;
#pragma unroll
        for (unsigned j = 0; j < 16; ++j) { const unsigned c = xb_ld(&bar[XB_XCNT(j)]); sum += c; cnt += (c > 0u) ? 1u : 0u; mine = (j == x) ? c : mine; }
        if (sum == G) break;
        __builtin_amdgcn_s_sleep(1);
        if ((++sp & 255u) == 0u) { if (xb_ld(&bar[XB_TMO])) break; if (sp > XB_SPIN_CAP) { atomicAdd(&bar[XB_TMO], 1u); break; } }
    }
    nloc = mine > 0u ? mine : 1u; nx = cnt > 0u ? cnt : 1u;
}
__device__ __forceinline__ void xcd_barrier(const XcdBarrier& b) {
    asm volatile("s_waitcnt vmcnt(0)" ::: "memory");
    __syncthreads();
    if (threadIdx.x == 0) {
        unsigned* bar = b.bar;
        __builtin_amdgcn_s_waitcnt(0);
        unsigned nloc = b.st[0], nx = b.st[1];
        if (nloc == 0u) { xcd_barrier_complete(bar, b.x, nloc, nx); b.st[0] = nloc; b.st[1] = nx; }
        const unsigned old = xb_add(&bar[XB_XSUB(b.x)], 1u);
        const unsigned gen = old / nloc;
        if (old + 1u == (gen + 1u) * nloc) {
            __builtin_amdgcn_fence(__ATOMIC_RELEASE, "agent");
            asm volatile("s_waitcnt vmcnt(0)" ::: "memory");
            const unsigned og = xb_add(&bar[XB_TOP], 1u);
            const unsigned tg = og / nx;
            if (og + 1u == (tg + 1u) * nx) xb_add(&bar[XB_TOPGEN], 1u);
            else XB_SPIN(xb_ld(&bar[XB_TOPGEN]) == tg, bar);
            __builtin_amdgcn_fence(__ATOMIC_ACQUIRE, "agent");
            xb_add(&bar[XB_XGEN(b.x)], 1u);
            asm volatile("s_waitcnt vmcnt(0)" ::: "memory");
        } else {
            XB_SPIN(xb_ld(&bar[XB_XGEN(b.x)]) == gen, bar);
            __builtin_amdgcn_fence(__ATOMIC_ACQUIRE, "agent");
            asm volatile("s_waitcnt vmcnt(0)" ::: "memory");
        }
    }
    __syncthreads();
}

__device__ __forceinline__ float wave_sum(float v) {
#pragma unroll
    for (int o = 1; o < 64; o <<= 1) v += __shfl_xor(v, o);
    return v;
}

__device__ __forceinline__ void p0_transpose_item(const float* W, int K, int N, bf16* WT, const float* gain, LAS float* scr, int item, int lane) {
    const int nblk = N / 32, kb = item / nblk, nb = item % nblk, k0 = 64 * kb, n0 = 32 * nb;
    const int c = lane & 7;
    f32x4 g0 = (f32x4){1.f, 1.f, 1.f, 1.f}, g1 = g0;
    if (gain) { g0 = *(const GAS f32x4*)(gain + k0 + 8 * c); g1 = *(const GAS f32x4*)(gain + k0 + 8 * c + 4); }
#pragma unroll
    for (int i = 0; i < 32; ++i) { const int kk = 2 * i + (lane >> 5); scr[kk * 33 + (lane & 31)] = W[(size_t)(k0 + kk) * N + n0 + (lane & 31)]; }
    LDS_WAIT(); asm volatile("" ::: "memory");
#pragma unroll
    for (int j = 0; j < 4; ++j) { const int n = (lane >> 3) + 8 * j; const LAS float* s = scr + (8 * c) * 33 + n;
        v4u o; o.x = pk2(s[0 * 33] * g0[0], s[1 * 33] * g0[1]); o.y = pk2(s[2 * 33] * g0[2], s[3 * 33] * g0[3]); o.z = pk2(s[4 * 33] * g1[0], s[5 * 33] * g1[1]); o.w = pk2(s[6 * 33] * g1[2], s[7 * 33] * g1[3]);
        *(GAS v4u*)(WT + (size_t)(n0 + n) * K + k0 + 8 * c) = o; }
    LDS_WAIT(); asm volatile("" ::: "memory");
}

struct Ptrs {
    const float* in[26]; float* out; unsigned char* ws;
};

struct Args { Ptrs p; int ph_lo, ph_hi; };
__device__ __forceinline__ const float* ld_in(const Args& a, int i) { asm volatile("" : "+s"(i)); return a.p.in[i]; }
__device__ __forceinline__ float* ld_out(const Args& a) { int i = 0; asm volatile("" : "+s"(i)); return (&a.p.out)[i]; }
__device__ __forceinline__ unsigned char* ld_ws(const Args& a) { int i = 0; asm volatile("" : "+s"(i)); return (&a.p.ws)[i]; }
#define INP(i) ld_in(args, (i))
#define OUTP() ld_out(args)
__device__ __forceinline__ void p0_prologue(const Args& args, LAS unsigned char* lds, int gw, int NGW, int wave) {
    int tid_ = threadIdx.x; asm volatile("" : "+v"(tid_)); const int lane = tid_ & 63;
    LAS float* scr = (LAS float*)(lds + wave * 16384);
    unsigned char* ws = ld_ws(args);
    constexpr int I_WIN = 16 * 80, I_SQ = 16 * 32, I_G = 2 * 4, I_POOL = 4 * 8, I_KV = 16 * 64, I_W1 = 16 * 128, I_W2 = 64 * 32;
    constexpr int NITEMS = 2 * I_WIN + 2 * I_SQ + 16 * I_G + 8 * I_POOL + 4 * I_SQ + 4 * I_KV + 4 * I_SQ + 4 * I_W1 + 4 * I_W2;
    for (int it = gw; it < NITEMS; it += NGW) {
        int r = it;
        if (r < 4 * I_W1) { const int l = r / I_W1; p0_transpose_item(INP(24) + (size_t)l * D * FF, D, FF, (bf16*)(ws + WS_W1) + (size_t)l * FF * D, INP(5) + l * D, scr, r % I_W1, lane); continue; } r -= 4 * I_W1;
        if (r < 4 * I_W2) { const int l = r / I_W2; p0_transpose_item(INP(25) + (size_t)l * FF * D, FF, D, (bf16*)(ws + WS_W2) + (size_t)l * D * FF, nullptr, scr, r % I_W2, lane); continue; } r -= 4 * I_W2;
        if (r < 4 * I_KV) { const int l = r / I_KV; p0_transpose_item(INP(20) + (size_t)l * D * 2048, D, 2048, (bf16*)(ws + WS_WKV) + (size_t)l * 2048 * D, nullptr, scr, r % I_KV, lane); continue; } r -= 4 * I_KV;
        if (r < 2 * I_WIN) { const int e = r / I_WIN; p0_transpose_item(INP(6) + (size_t)e * D * INC, D, INC, (bf16*)(ws + WS_WIN) + (size_t)e * INC * D, INP(3) + (2 * e) * D, scr, r % I_WIN, lane); continue; } r -= 2 * I_WIN;
        if (r < 2 * I_SQ) { const int e = r / I_SQ; p0_transpose_item(INP(16) + (size_t)e * D * D, D, D, (bf16*)(ws + WS_WOUT) + (size_t)e * D * D, nullptr, scr, r % I_SQ, lane); continue; } r -= 2 * I_SQ;
        if (r < 4 * I_SQ) { const int l = r / I_SQ; p0_transpose_item(INP(19) + (size_t)l * D * D, D, D, (bf16*)(ws + WS_WQ) + (size_t)l * D * D, INP(4) + l * D, scr, r % I_SQ, lane); continue; } r -= 4 * I_SQ;
        if (r < 4 * I_SQ) { const int l = r / I_SQ; p0_transpose_item(INP(23) + (size_t)l * D * D, D, D, (bf16*)(ws + WS_WO) + (size_t)l * D * D, nullptr, scr, r % I_SQ, lane); continue; } r -= 4 * I_SQ;
        if (r < 8 * I_POOL) { const int mat = r / I_POOL, o = mat >> 2, g = mat & 3; p0_transpose_item(INP(17) + (size_t)mat * 65536, 256, 256, (bf16*)(ws + WS_POOLT) + (size_t)mat * 65536, INP(3) + (2 * o + 1) * D + g * 256, scr, r % I_POOL, lane); continue; } r -= 8 * I_POOL;
        { const int mat = r / I_G, kind = mat >> 3, eg = mat & 7, e = eg >> 2, g = eg & 3;
          p0_transpose_item((kind ? INP(13) : INP(11)) + (size_t)eg * 16384, 128, 128, (bf16*)(ws + WS_GT) + (size_t)((e * 2 + kind) * 4 + g) * 16384, nullptr, scr, r % I_G, lane); }
    }
    for (int m = gw; m < T; m += NGW) {
        const GAS f32x4* xr = (const GAS f32x4*)(INP(0) + (size_t)m * D) + lane; f32x4 v[4]; float s = 0.f;
#pragma unroll
        for (int j = 0; j < 4; ++j) { v[j] = xr[64 * j]; s += (v[j][0] * v[j][0] + v[j][1] * v[j][1]) + (v[j][2] * v[j][2] + v[j][3] * v[j][3]); }
        s = wave_sum(s);
        GAS v2u* o8 = (GAS v2u*)((bf16*)(ws + WS_XB) + (size_t)m * D) + lane;
#pragma unroll
        for (int j = 0; j < 4; ++j) { v2u w; w.x = pk2(v[j][0], v[j][1]); w.y = pk2(v[j][2], v[j][3]); o8[64 * j] = w; }
        if (lane < 16) ((float*)(ws + WS_SS))[(size_t)m * 16 + lane] = lane == 0 ? s : 0.f;
    }
    for (int m = gw; m < TM; m += NGW) {
        const GAS f32x4* xr = (const GAS f32x4*)(INP(1) + (size_t)m * D) + lane; const GAS f32x4* gr = (const GAS f32x4*)(INP(2)) + lane; f32x4 v[4]; float s = 0.f;
#pragma unroll
        for (int j = 0; j < 4; ++j) { v[j] = xr[64 * j]; s += (v[j][0] * v[j][0] + v[j][1] * v[j][1]) + (v[j][2] * v[j][2] + v[j][3] * v[j][3]); }
        const float rs = 1.0f / sqrtf(wave_sum(s) * (1.0f / D) + EPS);
        GAS v2u* o8 = (GAS v2u*)((bf16*)((unsigned char*)OUTP() + DO_MEMN) + (size_t)m * D) + lane;
#pragma unroll
        for (int j = 0; j < 4; ++j) { const f32x4 gg = gr[64 * j]; v2u w; w.x = pk2(v[j][0] * rs * gg[0], v[j][1] * rs * gg[1]); w.y = pk2(v[j][2] * rs * gg[2], v[j][3] * rs * gg[3]); o8[64 * j] = w; }
    }
}

__device__ __forceinline__ void kv_finalize(const Args& args, int gw, int NGW) {
    int tid_ = threadIdx.x; asm volatile("" : "+v"(tid_)); const int lane = tid_ & 63;
    const bf16* kvraw = (const bf16*)((unsigned char*)OUTP() + DO_KVRAW);
    bf16* Kn = (bf16*)(ld_ws(args) + WS_KN); bf16* Vt = (bf16*)(ld_ws(args) + WS_VT);
    for (int row = gw; row < 4 * TM * 4; row += NGW) {
        const int l = row >> 12, m = (row >> 2) & 1023, h = row & 3, b = m >> 8, key = m & 255;
        const v2u w = *(const GAS v2u*)(kvraw + ((size_t)(l * TM + m)) * 2048 + h * 256 + 4 * lane);
        const float k0 = bflo(w.x), k1 = bfhi(w.x), k2 = bflo(w.y), k3 = bfhi(w.y);
        const float ss = wave_sum((k0 * k0 + k1 * k1) + (k2 * k2 + k3 * k3));
        const float sc = (1.0f / sqrtf(ss * (1.0f / 256.0f) + EPS)) * (0.0625f * LOG2E);
        const f32x4 gk = *(const GAS f32x4*)(INP(22) + l * 256 + 4 * lane), gq = *(const GAS f32x4*)(INP(21) + l * 256 + 4 * lane);
        v2u o; o.x = pk2(k0 * sc * gk[0] * gq[0], k1 * sc * gk[1] * gq[1]); o.y = pk2(k2 * sc * gk[2] * gq[2], k3 * sc * gk[3] * gq[3]);
        *(GAS v2u*)(Kn + ((size_t)((l * 4 + b) * 4 + h) * 256 + key) * 256 + 4 * lane) = o;
    }
    for (int it = gw; it < 256; it += NGW) {
        const int l = it >> 6, b = (it >> 4) & 3, h = (it >> 2) & 3, kb = it & 3, key = 64 * kb + lane;
        const bf16* src = kvraw + ((size_t)(l * TM + b * 256 + key)) * 2048 + 1024 + h * 256;
        bf16* dst = Vt + ((size_t)((l * 4 + b) * 4 + h) * 256) * 256 + key;
        for (int dc = 0; dc < 32; ++dc) { const v4u w = *(const GAS v4u*)(src + 8 * dc);
            dst[(size_t)(8 * dc + 0) * 256] = (bf16)(w.x & 0xffffu); dst[(size_t)(8 * dc + 1) * 256] = (bf16)(w.x >> 16);
            dst[(size_t)(8 * dc + 2) * 256] = (bf16)(w.y & 0xffffu); dst[(size_t)(8 * dc + 3) * 256] = (bf16)(w.y >> 16);
            dst[(size_t)(8 * dc + 4) * 256] = (bf16)(w.z & 0xffffu); dst[(size_t)(8 * dc + 5) * 256] = (bf16)(w.z >> 16);
            dst[(size_t)(8 * dc + 6) * 256] = (bf16)(w.w & 0xffffu); dst[(size_t)(8 * dc + 7) * 256] = (bf16)(w.w >> 16); }
    }
}

__device__ __forceinline__ void attn_unit(LAS unsigned char* lds, const bf16* proj, const float* gq, const float* gk, bf16* num, float* den, int uid, int tid) {
    asm volatile("" : "+v"(tid));
    const int g = uid >> 9, rem = uid & 511, bh = rem >> 5, j = rem & 31;
    const int dsh = 2 * g, d = 1 << dsh, n = j >> dsh, r = j & (d - 1), b = bh >> 2, h = bh & 3;
    const int base = n * (128 << dsh) + r;
    const size_t rowb = (size_t)b * SEQ;
    {
        const int c = tid & 15;
        const f32x4 ga = *(const GAS f32x4*)(gk + 8 * c), gb = *(const GAS f32x4*)(gk + 8 * c + 4);
        v4u kk[8], vv[8];
#pragma unroll
        for (int i = 0; i < 8; ++i) { const int kj = (tid >> 4) + 32 * i, pos = base + (kj - 128) * d;
            if (pos >= 0) { const bf16* p = proj + (rowb + pos) * INC + 512 + h * 128 + 8 * c; kk[i] = *(const GAS v4u*)p; vv[i] = *(const GAS v4u*)(p + 512); }
            else { kk[i] = (v4u){0u, 0u, 0u, 0u}; vv[i] = (v4u){0u, 0u, 0u, 0u}; } }
#pragma unroll
        for (int i = 0; i < 8; ++i) { const int kj = (tid >> 4) + 32 * i;
            const float a0 = bflo(kk[i].x), a1 = bfhi(kk[i].x), a2 = bflo(kk[i].y), a3 = bfhi(kk[i].y), a4 = bflo(kk[i].z), a5 = bfhi(kk[i].z), a6 = bflo(kk[i].w), a7 = bfhi(kk[i].w);
            float ss = ((a0 * a0 + a1 * a1) + (a2 * a2 + a3 * a3)) + ((a4 * a4 + a5 * a5) + (a6 * a6 + a7 * a7));
            ss += __shfl_xor(ss, 1); ss += __shfl_xor(ss, 2); ss += __shfl_xor(ss, 4); ss += __shfl_xor(ss, 8);
            const float rk = __builtin_amdgcn_rsqf(ss * (1.0f / 128.0f) + EPS);
            v4u o; o.x = pk2(a0 * rk * ga[0], a1 * rk * ga[1]); o.y = pk2(a2 * rk * ga[2], a3 * rk * ga[3]); o.z = pk2(a4 * rk * gb[0], a5 * rk * gb[1]); o.w = pk2(a6 * rk * gb[2], a7 * rk * gb[3]);
            *(LAS v4u*)(lds + kj * 256 + ((c ^ (kj & 15)) << 4)) = o;
            *(LAS v4u*)(lds + 65536 + kj * 256 + ((c ^ ((kj & 7) << 1)) << 4)) = vv[i]; }
    }
    const int w = tid >> 6, lane = tid & 63, q = lane & 15, G = lane >> 4;
    const size_t qrow = rowb + base + (size_t)(16 * w + q) * d;
    bf16x8 Qf[4];
    {
        v4u qq[4]; float ss = 0.f;
#pragma unroll
        for (int ks = 0; ks < 4; ++ks) { qq[ks] = *(const GAS v4u*)(proj + qrow * INC + h * 128 + 32 * ks + 8 * G);
            const float a0 = bflo(qq[ks].x), a1 = bfhi(qq[ks].x), a2 = bflo(qq[ks].y), a3 = bfhi(qq[ks].y), a4 = bflo(qq[ks].z), a5 = bfhi(qq[ks].z), a6 = bflo(qq[ks].w), a7 = bfhi(qq[ks].w);
            ss += ((a0 * a0 + a1 * a1) + (a2 * a2 + a3 * a3)) + ((a4 * a4 + a5 * a5) + (a6 * a6 + a7 * a7)); }
        ss += __shfl_xor(ss, 16); ss += __shfl_xor(ss, 32);
        const float rq = __builtin_amdgcn_rsqf(ss * (1.0f / 128.0f) + EPS) * (0.08838834764831845f * LOG2E);
#pragma unroll
        for (int ks = 0; ks < 4; ++ks) { const f32x4 ga = *(const GAS f32x4*)(gq + 32 * ks + 8 * G), gb = *(const GAS f32x4*)(gq + 32 * ks + 8 * G + 4);
            v4u o; o.x = pk2(bflo(qq[ks].x) * rq * ga[0], bfhi(qq[ks].x) * rq * ga[1]); o.y = pk2(bflo(qq[ks].y) * rq * ga[2], bfhi(qq[ks].y) * rq * ga[3]);
            o.z = pk2(bflo(qq[ks].z) * rq * gb[0], bfhi(qq[ks].z) * rq * gb[1]); o.w = pk2(bflo(qq[ks].w) * rq * gb[2], bfhi(qq[ks].w) * rq * gb[3]);
            Qf[ks] = __builtin_bit_cast(bf16x8, o); }
    }
    __syncthreads();
    f32x4 s[9];
#pragma unroll
    for (int t = 0; t < 9; ++t) { s[t] = (f32x4){0.f, 0.f, 0.f, 0.f}; const int krow = 16 * (w + t) + q;
#pragma unroll
        for (int ks = 0; ks < 4; ++ks) { const bf16x8 Kf = *(const LAS bf16x8*)(lds + krow * 256 + (((4 * ks + G) ^ q) << 4));
            s[t] = __builtin_amdgcn_mfma_f32_16x16x32_bf16(Kf, Qf[ks], s[t], 0, 0, 0); } }
    float dsum = 0.f; const bool first = (n == 0);
#pragma unroll
    for (int t = 0; t < 9; ++t)
#pragma unroll
        for (int e = 0; e < 4; ++e) { const int kk = 4 * G + e; bool ok = true;
            if (t == 0) ok = kk >= q; if (t == 8) ok = kk <= q; if (first && (w + t) < 8) ok = false;
            const float p = ok ? __builtin_amdgcn_exp2f(s[t][e]) : 0.f; s[t][e] = p; dsum += p; }
    dsum += __shfl_xor(dsum, 16); dsum += __shfl_xor(dsum, 32);
    f32x4 o[8];
#pragma unroll
    for (int nt = 0; nt < 8; ++nt) o[nt] = (f32x4){0.f, 0.f, 0.f, 0.f};
    const int q4 = q >> 2, pp = q & 3;
#pragma unroll
    for (int si = 0; si < 5; ++si) {
        v4u pw; pw.x = pk2(s[2 * si][0], s[2 * si][1]); pw.y = pk2(s[2 * si][2], s[2 * si][3]);
        if (si < 4) { pw.z = pk2(s[2 * si + 1][0], s[2 * si + 1][1]); pw.w = pk2(s[2 * si + 1][2], s[2 * si + 1][3]); } else { pw.z = 0u; pw.w = 0u; }
        const bf16x8 Pf = __builtin_bit_cast(bf16x8, pw);
        const int key0 = 16 * (w + 2 * si) + 4 * G + q4, key1 = (si < 4) ? key0 + 16 : key0;
        const int sw0 = (key0 & 7) << 1, sw1 = (key1 & 7) << 1;
#pragma unroll
        for (int nt = 0; nt < 8; ++nt) { const int chunk = 2 * nt + (pp >> 1);
            const s16x4 v0 = __builtin_bit_cast(s16x4, __builtin_amdgcn_ds_read_tr16_b64_v4i16((LAS s16x4*)(lds + 65536 + key0 * 256 + ((chunk ^ sw0) << 4) + (pp & 1) * 8)));
            const s16x4 v1 = __builtin_bit_cast(s16x4, __builtin_amdgcn_ds_read_tr16_b64_v4i16((LAS s16x4*)(lds + 65536 + key1 * 256 + ((chunk ^ sw1) << 4) + (pp & 1) * 8)));
            const bf16x8 Vf = (bf16x8){v0[0], v0[1], v0[2], v0[3], v1[0], v1[1], v1[2], v1[3]};
            o[nt] = __builtin_amdgcn_mfma_f32_16x16x32_bf16(Vf, Pf, o[nt], 0, 0, 0); }
    }
    bf16* np = num + ((size_t)g * T + qrow) * 512 + h * 128 + 4 * G;
#pragma unroll
    for (int nt = 0; nt < 8; ++nt) { v2u wv; wv.x = pk2(o[nt][0], o[nt][1]); wv.y = pk2(o[nt][2], o[nt][3]); *(GAS v2u*)(np + 16 * nt) = wv; }
    if (G == 0) den[((size_t)g * T + qrow) * 4 + h] = dsum;
    __syncthreads();
}

__device__ __forceinline__ float rcp_(float x) { return __builtin_amdgcn_rcpf(x); }
__device__ __forceinline__ float sigmoid_fast(float x) { return rcp_(1.0f + __builtin_amdgcn_exp2f(-LOG2E * x)); }
__device__ __forceinline__ float gelu_tanh(float x) { const float u = 0.7978845608028654f * (x + 0.044715f * x * x * x); const float e = __builtin_amdgcn_exp2f((2.0f * LOG2E) * u); return x * (1.0f - rcp_(e + 1.0f)); }
__device__ __forceinline__ void r1_unit(LAS unsigned char* lds, const bf16* proj, const float* cw, const float* cb, const bf16* GaT, const bf16* GxT, const float* ba, const float* bx, const float* lam,
                                        bf16* Y0, bf16* Y1, float* Aend, float* Hend, int uid, int tid) {
    asm volatile("" : "+v"(tid));
    const int g = uid & 3, chunk = (uid >> 2) & 31, b = uid >> 7, t0 = chunk * 128;
    const size_t rowb = (size_t)b * SEQ;
    LAS unsigned char* lxc = lds; LAS unsigned char* lgt = lds + 32768; LAS unsigned char* ly0 = lds + 65536; LAS unsigned char* ly1 = lds + 98304;
    {
        const int c8 = tid & 15, ch0 = 128 * g + 8 * c8;
        float wj[4][8], bb[8];
#pragma unroll
        for (int jj = 0; jj < 4; ++jj) { const f32x4 a = *(const GAS f32x4*)(cw + jj * 512 + ch0), c = *(const GAS f32x4*)(cw + jj * 512 + ch0 + 4);
            wj[jj][0] = a[0]; wj[jj][1] = a[1]; wj[jj][2] = a[2]; wj[jj][3] = a[3]; wj[jj][4] = c[0]; wj[jj][5] = c[1]; wj[jj][6] = c[2]; wj[jj][7] = c[3]; }
        { const f32x4 a = *(const GAS f32x4*)(cb + ch0), c = *(const GAS f32x4*)(cb + ch0 + 4); bb[0] = a[0]; bb[1] = a[1]; bb[2] = a[2]; bb[3] = a[3]; bb[4] = c[0]; bb[5] = c[1]; bb[6] = c[2]; bb[7] = c[3]; }
#pragma unroll
        for (int i = 0; i < 4; ++i) { const int tt = (tid >> 4) + 32 * i, t = t0 + tt;
            float a[8];
#pragma unroll
            for (int e = 0; e < 8; ++e) a[e] = bb[e];
#pragma unroll
            for (int jj = 0; jj < 4; ++jj) { const int ts = t - 3 + jj;
                if (ts >= 0) { const v4u x = *(const GAS v4u*)(proj + (rowb + ts) * INC + 1536 + ch0);
                    a[0] += wj[jj][0] * bflo(x.x); a[1] += wj[jj][1] * bfhi(x.x); a[2] += wj[jj][2] * bflo(x.y); a[3] += wj[jj][3] * bfhi(x.y);
                    a[4] += wj[jj][4] * bflo(x.z); a[5] += wj[jj][5] * bfhi(x.z); a[6] += wj[jj][6] * bflo(x.w); a[7] += wj[jj][7] * bfhi(x.w); } }
            v4u o; o.x = pk2(a[0], a[1]); o.y = pk2(a[2], a[3]); o.z = pk2(a[4], a[5]); o.w = pk2(a[6], a[7]);
            *(LAS v4u*)(lxc + tt * 256 + ((c8 ^ (tt & 15)) << 4)) = o;
            *(LAS v4u*)(lgt + tt * 256 + ((c8 ^ (tt & 15)) << 4)) = *(const GAS v4u*)(proj + (rowb + t) * INC + 2048 + ch0); }
    }
    const int w = tid >> 6, lane = tid & 63, q = lane & 15, G = lane >> 4;
    const int dd = 16 * w + q, ch = 128 * g + dd;
    bf16x8 Wa[4], Wx[4];
#pragma unroll
    for (int ks = 0; ks < 4; ++ks) { Wa[ks] = __builtin_bit_cast(bf16x8, *(const GAS v4u*)(GaT + dd * 128 + 32 * ks + 8 * G)); Wx[ks] = __builtin_bit_cast(bf16x8, *(const GAS v4u*)(GxT + dd * 128 + 32 * ks + 8 * G)); }
    const float bav = ba[ch], bxv = bx[ch], lv = lam[ch]; const float sp8 = 8.0f * __logf(1.0f + __expf(-lv));
    __syncthreads();
    float Arun = 1.f, Hrun = 0.f;
    const int xoff = ((dd >> 3) << 4), xlo = (dd & 7) * 2;
#pragma unroll 2
    for (int tt8 = 0; tt8 < 8; ++tt8) {
        f32x4 aA = (f32x4){0.f, 0.f, 0.f, 0.f}, aX = (f32x4){0.f, 0.f, 0.f, 0.f};
#pragma unroll
        for (int ks = 0; ks < 4; ++ks) { const bf16x8 Xf = *(const LAS bf16x8*)(lxc + (16 * tt8 + q) * 256 + (((4 * ks + G) ^ q) << 4));
            aA = __builtin_amdgcn_mfma_f32_16x16x32_bf16(Xf, Wa[ks], aA, 0, 0, 0); aX = __builtin_amdgcn_mfma_f32_16x16x32_bf16(Xf, Wx[ks], aX, 0, 0, 0); }
        float Ac[4], Hc[4]; float Ar = 1.f, Hr = 0.f;
#pragma unroll
        for (int e = 0; e < 4; ++e) { const int tt = 16 * tt8 + 4 * G + e;
            const float xcv = bf1(*(const LAS bf16*)(lxc + tt * 256 + (xoff ^ ((tt & 15) << 4)) + xlo));
            const float rg = sigmoid_fast(aA[e] + bav), ig = sigmoid_fast(aX[e] + bxv), la = -sp8 * rg, a = __builtin_amdgcn_exp2f(LOG2E * la);
            const float y = 2.0f * la; float pl = 1.0f / 120.0f; pl = pl * y + (1.0f / 24.0f); pl = pl * y + (1.0f / 6.0f); pl = pl * y + 0.5f; pl = pl * y + 1.0f;
            const float u = __builtin_amdgcn_sqrtf(-y * pl) * (ig * xcv);
            Hr = a * Hr + u; Ar = a * Ar; Ac[e] = Ar; Hc[e] = Hr; }
        float Ai = Ar, Hi = Hr;
        { const float Ap = __shfl_up(Ai, 16), Hp = __shfl_up(Hi, 16); if (G >= 1) { Hi = Ai * Hp + Hi; Ai = Ai * Ap; } }
        { const float Ap = __shfl_up(Ai, 32), Hp = __shfl_up(Hi, 32); if (G >= 2) { Hi = Ai * Hp + Hi; Ai = Ai * Ap; } }
        float Ae = __shfl_up(Ai, 16), He = __shfl_up(Hi, 16); if (G == 0) { Ae = 1.f; He = 0.f; }
        const float At = __shfl(Ai, 48 + q), Ht = __shfl(Hi, 48 + q);
        const float Ap0 = Ae * Arun, Hp0 = Ae * Hrun + He;
#pragma unroll
        for (int e = 0; e < 4; ++e) { const int tt = 16 * tt8 + 4 * G + e;
            const float Pv = Ac[e] * Ap0, hl = Hc[e] + Ac[e] * Hp0;
            const int so = tt * 256 + (xoff ^ ((tt & 15) << 4)) + xlo;
            const float gg = gelu_tanh(bf1(*(const LAS bf16*)(lgt + so)));
            *(LAS bf16*)(ly0 + so) = f2bf(hl * gg); *(LAS bf16*)(ly1 + so) = f2bf(Pv * gg); }
        Hrun = At * Hrun + Ht; Arun = At * Arun;
    }
    if (G == 0) { Aend[(size_t)(b * 32 + chunk) * 512 + ch] = Arun; Hend[(size_t)(b * 32 + chunk) * 512 + ch] = Hrun; }
    __syncthreads();
    {
        const int c8 = tid & 15;
#pragma unroll
        for (int i = 0; i < 4; ++i) { const int tt = (tid >> 4) + 32 * i; const int so = tt * 256 + ((c8 ^ (tt & 15)) << 4); const size_t off = (rowb + t0 + tt) * 512 + 128 * g + 8 * c8;
            *(GAS v4u*)(Y0 + off) = *(const LAS v4u*)(ly0 + so); *(GAS v4u*)(Y1 + off) = *(const LAS v4u*)(ly1 + so); }
    }
    __syncthreads();
}

__device__ __forceinline__ void post_unit(LAS unsigned char* lds, const bf16* num, const float* den, const bf16* Y0, const bf16* Y1, const float* Aend, const float* Hend, bf16* aout, int uid, int tid) {
    asm volatile("" : "+v"(tid));
    const int row0 = uid * 64, b = row0 >> 12, chunk = (row0 & 4095) >> 7;
    LAS float* hin = (LAS float*)lds;
    { float H = 0.f; const float* ae = Aend + (size_t)(b * 32) * 512 + tid; const float* he = Hend + (size_t)(b * 32) * 512 + tid;
      for (int s = 0; s < chunk; ++s) H = ae[(size_t)s * 512] * H + he[(size_t)s * 512];
      hin[tid] = H; }
    __syncthreads();
    const int c8 = tid & 63, rsub = tid >> 6;
    float hv[8];
#pragma unroll
    for (int e = 0; e < 8; ++e) hv[e] = hin[8 * c8 + e];
#pragma unroll
    for (int i = 0; i < 8; ++i) { const size_t row = row0 + rsub + 8 * i;
        {
            const v4u a = *(const GAS v4u*)(Y0 + row * 512 + 8 * c8), p = *(const GAS v4u*)(Y1 + row * 512 + 8 * c8); v4u o;
            o.x = pk2(bflo(a.x) + bflo(p.x) * hv[0], bfhi(a.x) + bfhi(p.x) * hv[1]); o.y = pk2(bflo(a.y) + bflo(p.y) * hv[2], bfhi(a.y) + bfhi(p.y) * hv[3]);
            o.z = pk2(bflo(a.z) + bflo(p.z) * hv[4], bfhi(a.z) + bfhi(p.z) * hv[5]); o.w = pk2(bflo(a.w) + bflo(p.w) * hv[6], bfhi(a.w) + bfhi(p.w) * hv[7]);
            *(GAS v4u*)(aout + row * 1024 + 512 + 8 * c8) = o; }
        {
            const int h = c8 >> 4;
            const float dn = den[((size_t)0 * T + row) * 4 + h] + den[((size_t)1 * T + row) * 4 + h] + den[((size_t)2 * T + row) * 4 + h]; const float inv = 1.0f / dn;
            const v4u a = *(const GAS v4u*)(num + ((size_t)0 * T + row) * 512 + 8 * c8), bq = *(const GAS v4u*)(num + ((size_t)1 * T + row) * 512 + 8 * c8), c = *(const GAS v4u*)(num + ((size_t)2 * T + row) * 512 + 8 * c8); v4u o;
            o.x = pk2((bflo(a.x) + bflo(bq.x) + bflo(c.x)) * inv, (bfhi(a.x) + bfhi(bq.x) + bfhi(c.x)) * inv); o.y = pk2((bflo(a.y) + bflo(bq.y) + bflo(c.y)) * inv, (bfhi(a.y) + bfhi(bq.y) + bfhi(c.y)) * inv);
            o.z = pk2((bflo(a.z) + bflo(bq.z) + bflo(c.z)) * inv, (bfhi(a.z) + bfhi(bq.z) + bfhi(c.z)) * inv); o.w = pk2((bflo(a.w) + bflo(bq.w) + bflo(c.w)) * inv, (bfhi(a.w) + bfhi(bq.w) + bfhi(c.w)) * inv);
            *(GAS v4u*)(aout + row * 1024 + 8 * c8) = o; }
    }
    __syncthreads();
}

__device__ __forceinline__ void poolprep_unit(LAS unsigned char* lds, const float* x, const float* ss, bf16* dd, int uid, int tid) {
    asm volatile("" : "+v"(tid));
    const int row0 = uid * 64, tb = row0 & 4095;
    LAS float* rs = (LAS float*)lds;
    if (tid < 79) { const int t = tb - 15 + tid; float r = 0.f;
        if (t >= 0) { const float* p = ss + (size_t)(row0 - 15 + tid) * 16; float s = 0.f;
#pragma unroll
            for (int e = 0; e < 16; ++e) s += p[e];
            r = 1.0f / sqrtf(s * (1.0f / 1024.0f) + EPS); }
        rs[tid] = r; }
    __syncthreads();
    const int c4 = tid & 255, half = tid >> 8, c = 4 * c4, wlen = 2 << (c >> 8);
    const int ts = tb + 32 * half;
    f32x4 sum = (f32x4){0.f, 0.f, 0.f, 0.f};
    for (int i = 1; i < wlen; ++i) { const int t = ts - i; if (t >= 0) sum += *(const GAS f32x4*)(x + (size_t)(row0 + 32 * half - i) * 1024 + c) * rs[15 + 32 * half - i]; }
    for (int k = 0; k < 32; ++k) { const int t = ts + k; const size_t row = (size_t)row0 + 32 * half + k;
        const f32x4 hcur = *(const GAS f32x4*)(x + row * 1024 + c) * rs[15 + 32 * half + k];
        sum += hcur;
        const int cnt = (t + 1 < wlen) ? t + 1 : wlen; const float inv = 1.0f / (float)cnt;
        const f32x4 dv = sum * inv - hcur;
        v2u o; o.x = pk2(dv[0], dv[1]); o.y = pk2(dv[2], dv[3]); *(GAS v2u*)(dd + row * 1024 + c) = o;
        const int told = t - wlen + 1;
        if (told >= 0) sum -= *(const GAS f32x4*)(x + (row - wlen + 1) * 1024 + c) * rs[15 + 32 * half + k - wlen + 1]; }
    __syncthreads();
}

#ifndef MK_TEST
constexpr int N_PHASES = 41;
__global__ void __launch_bounds__(NWAVES * 64, 2) mk_fwd(Args args) {
    extern __shared__ __attribute__((aligned(16))) unsigned char lds_raw[];
    LAS unsigned char* lds = (LAS unsigned char*)lds_raw;
    volatile LAS unsigned* MISC = (volatile LAS unsigned*)(lds + MISC_OFF);
#define ws ld_ws(args)
    const int tid = threadIdx.x, wave = __builtin_amdgcn_readfirstlane(tid >> 6);
    const int G = gridDim.x, bid = blockIdx.x;
    const int vcu = (G % 8 == 0) ? (bid % 8) * (G / 8) + bid / 8 : bid;
    const int gw = vcu * NWAVES + wave, NGW = G * NWAVES;
    for (int u = tid; u < (LDS_BYTES - LDSCTL_OFF) / 4; u += NWAVES * 64) ((LAS unsigned*)(lds + LDSCTL_OFF))[u] = 0u;
    __syncthreads();
    unsigned* ctl = (unsigned*)(ws + WS_CTL);
    XcdBarrier bar; bar.bar = ctl + 1024; bar.x = 0; bar.st = nullptr;
    if (MK_N_LAUNCHES == 1) bar = xcd_barrier_post(ctl + 1024, MISC + 8);
#if MK_N_LAUNCHES != 1
    const int lo = args.ph_lo, hi = args.ph_hi;
#endif
#if MK_N_LAUNCHES == 1
#define IN(k) true
#else
#define IN(k) (lo <= (k) && (k) < hi)
#endif
#define SEAM(k) do { if (MK_N_LAUNCHES == 1 && (k) + 1 < N_PHASES) { for (int b_ = 0; b_ < REP_BAR; ++b_) xcd_barrier(bar); } } while (0)
#define ZEROS ((const float*)(ws + WS_CTL + 32768))

#define SS ((float*)(ws + WS_SS))
#define QSS ((float*)(ws + WS_QSS))
#define LSUM ((float*)(ws + WS_LSUM))
#define DEN ((float*)(ws + WS_DEN))
#define AEND ((float*)(ws + WS_AEND))
#define HEND ((float*)(ws + WS_HEND))
#define XB ((bf16*)(ws + WS_XB))
#define PROJ ((bf16*)(ws + WS_PROJ))
#define NUM ((bf16*)(ws + WS_NUM))
#define AOUT ((bf16*)(ws + WS_AOUT))
#define QB ((bf16*)(ws + WS_Q))
#define PB ((bf16*)(ws + WS_P))
#define OB ((bf16*)(ws + WS_O))
#define HID ((bf16*)(ws + WS_HID))
#define Y0 ((bf16*)(ws + WS_Y0))
#define Y1 ((bf16*)(ws + WS_Y1))
#define KVRAW ((bf16*)((unsigned char*)OUTP() + DO_KVRAW))
#define MEMN ((bf16*)((unsigned char*)OUTP() + DO_MEMN))
#ifndef NO_PRO
    if (IN(0)) { REPEAT(REP_P0) { p0_prologue(args, lds, gw, NGW, wave); REP_SEAM(REP_P0); } SEAM(0); }
#endif

    for (int l = 0; l < 4; ++l) {
        const int pb = 1 + 10 * l;
        const float* xin = (l == 0) ? INP(0) : OUTP();
        if ((l & 1) == 0) {
            const int e = l >> 1;
            if (IN(pb + 0)) { REPEAT(REP_A1) {
                { pg8::Gemm g{XB, (const bf16*)(ws + WS_WIN) + (size_t)e * INC * D, D, D, D, ~0, 0, (long)256 * D, 30, 0};
                  pg8::StaticOrder S; S.init(T / 256, INC / 256, G, bid);
                  pg8::EpiBf16<1> E{PROJ, INC, SS, nullptr};
                  pg8::gemm_phase(lds, g, S, E); }
                if (l == 0) { pg8::Gemm g{MEMN, (const bf16*)(ws + WS_WKV), D, D, D, 3, 0, (long)256 * D, 2, (long)2048 * D};
                  pg8::StaticOrder S; S.init(16, 8, G - 128, bid >= 128 ? bid - 128 : (1 << 20));
                  pg8::EpiBf16<0> E{KVRAW, 2048, nullptr, nullptr};
                  pg8::gemm_phase(lds, g, S, E); }
                REP_SEAM(REP_A1); }
                SEAM(pb + 0); }
            if (IN(pb + 1)) { REPEAT(REP_A2) {
#ifndef NO_KVF
                if (l == 0) for (int r2_ = 0; r2_ < REP_KVF; ++r2_) kv_finalize(args, gw, NGW);
#endif
                for (int u = bid; u < 2048; u += G) {
#ifndef NO_ATTN
                    if (u < 1536) for (int r2_ = 0; r2_ < REP_ATTN; ++r2_) attn_unit(lds, PROJ, INP(7) + e * 128, INP(8) + e * 128, NUM, DEN, u, tid);
#endif
#ifndef NO_R1
                    if (u >= 1536) for (int r2_ = 0; r2_ < REP_R1; ++r2_) r1_unit(lds, PROJ, INP(9) + e * 2048, INP(10) + e * 512, (const bf16*)(ws + WS_GT) + (size_t)((e * 2 + 0) * 4 + ((u - 1536) & 3)) * 16384, (const bf16*)(ws + WS_GT) + (size_t)((e * 2 + 1) * 4 + ((u - 1536) & 3)) * 16384,
                                 INP(12) + e * 512, INP(14) + e * 512, INP(15) + e * 512, Y0, Y1, AEND, HEND, u - 1536, tid);
#endif
                }
                REP_SEAM(REP_A2); }
                SEAM(pb + 1); }
            if (IN(pb + 2)) { REPEAT(REP_A3) {
#ifndef NO_POST
                for (int u = bid; u < 256; u += G) post_unit(lds, NUM, DEN, Y0, Y1, AEND, HEND, AOUT, u, tid);
#endif
                REP_SEAM(REP_A3); }
                SEAM(pb + 2); }
            if (IN(pb + 3)) { REPEAT(REP_A4) {
                pg8::Gemm g{AOUT, (const bf16*)(ws + WS_WOUT) + (size_t)e * D * D, D, D, D, ~0, 0, (long)256 * D, 30, 0};
                pg8::StaticOrder S; S.init(T / 256, 4, G, bid);
                pg8::EpiRes E{rep_ ? OUTP() : xin, OUTP(), XB, SS, rep_ ? ZEROS : nullptr};
                pg8::gemm_phase(lds, g, S, E);
                REP_SEAM(REP_A4); }
                SEAM(pb + 3); }
        } else {
            const int o = l >> 1;
            if (IN(pb + 0)) { REPEAT(REP_B1) {
#ifndef NO_POOL
                for (int u = bid; u < 256; u += G) poolprep_unit(lds, OUTP(), SS, AOUT, u, tid);
#endif
                REP_SEAM(REP_B1); }
                SEAM(pb + 0); }
            if (IN(pb + 1)) { REPEAT(REP_B2) {
                pg8::Gemm g{AOUT, (const bf16*)(ws + WS_POOLT) + (size_t)o * 4 * 65536, D, 256, 256, ~0, 256, (long)65536, 30, 0};
                pg8::StaticOrder S; S.init(T / 256, 4, G, bid);
                pg8::EpiRes E{OUTP(), OUTP(), XB, SS, rep_ ? ZEROS : INP(18) + o * D};
                pg8::gemm_phase(lds, g, S, E);
                REP_SEAM(REP_B2); }
                SEAM(pb + 3); }
        }
        if (IN(pb + 4)) { REPEAT(REP_X1) {
            pg8::Gemm g{XB, (const bf16*)(ws + WS_WQ) + (size_t)l * D * D, D, D, D, ~0, 0, (long)256 * D, 30, 0};
            pg8::StaticOrder S; S.init(T / 256, 4, G, bid);
            pg8::EpiBf16<3> E{QB, D, SS, QSS};
            pg8::gemm_phase(lds, g, S, E);
            REP_SEAM(REP_X1); }
            SEAM(pb + 4); }
        if (IN(pb + 5)) { REPEAT(REP_X2) {
            pg8::Gemm g{QB, (const bf16*)(ws + WS_KN) + (size_t)l * 16 * 65536, D, 256, 256, ~0, 256, (long)65536, 4, (long)4 * 65536};
            pg8::StaticOrder S; S.init(T / 256, 4, G, bid);
            pg8::EpiBf16<4> E{PB, D, QSS, LSUM};
            pg8::gemm_phase(lds, g, S, E);
            REP_SEAM(REP_X2); }
            SEAM(pb + 5); }
        if (IN(pb + 6)) { REPEAT(REP_X3) {
            pg8::Gemm g{PB, (const bf16*)(ws + WS_VT) + (size_t)l * 16 * 65536, D, 256, 256, ~0, 256, (long)65536, 4, (long)4 * 65536};
            pg8::StaticOrder S; S.init(T / 256, 4, G, bid);
            pg8::EpiBf16<5> E{OB, D, LSUM, nullptr};
            pg8::gemm_phase(lds, g, S, E);
            REP_SEAM(REP_X3); }
            SEAM(pb + 6); }
        if (IN(pb + 7)) { REPEAT(REP_X4) {
            pg8::Gemm g{OB, (const bf16*)(ws + WS_WO) + (size_t)l * D * D, D, D, D, ~0, 0, (long)256 * D, 30, 0};
            pg8::StaticOrder S; S.init(T / 256, 4, G, bid);
            pg8::EpiRes E{OUTP(), OUTP(), XB, SS, rep_ ? ZEROS : nullptr};
            pg8::gemm_phase(lds, g, S, E);
            REP_SEAM(REP_X4); }
            SEAM(pb + 7); }
        if (IN(pb + 8)) { REPEAT(REP_M1) {
            pg8::Gemm g{XB, (const bf16*)(ws + WS_W1) + (size_t)l * FF * D, D, D, D, ~0, 0, (long)256 * D, 30, 0};
            pg8::StaticOrder S; S.init(T / 256, FF / 256, G, bid);
            pg8::EpiBf16<2> E{HID, FF, SS, nullptr};
            pg8::gemm_phase(lds, g, S, E);
            REP_SEAM(REP_M1); }
            SEAM(pb + 8); }
        if (IN(pb + 9)) { REPEAT(REP_M2) {
            pg8::Gemm g{HID, (const bf16*)(ws + WS_W2) + (size_t)l * D * FF, FF, FF, FF, ~0, 0, (long)256 * FF, 30, 0};
            pg8::StaticOrder S; S.init(T / 256, 4, G, bid);
            pg8::EpiRes E{OUTP(), OUTP(), XB, SS, rep_ ? ZEROS : nullptr};
            pg8::gemm_phase(lds, g, S, E);
            REP_SEAM(REP_M2); }
            SEAM(pb + 9); }
    }
#undef IN
#undef SEAM
#undef ws
}

extern "C" void kernel_launch(void* const* d_in, const int* in_sizes, int n_in, void* d_out, int out_size, void* d_ws, size_t ws_size, hipStream_t stream) {
    static int grid = 0;
    if (grid == 0) {
        if (n_in != 26 || in_sizes[0] != T * D || out_size != T * D || ws_size < WS_END) { fprintf(stderr, "kernel_launch: unexpected shapes: n_in %d in0 %d out %d ws %zu (need %zu); nothing launched\n", n_in, n_in > 0 ? in_sizes[0] : -1, out_size, ws_size, (size_t)WS_END); grid = -1; return; }
        int dev = 0, cus = 0, per_cu = 0;
        if (hipGetDevice(&dev) != hipSuccess || hipDeviceGetAttribute(&cus, hipDeviceAttributeMultiprocessorCount, dev) != hipSuccess) { grid = -1; return; }
        if (hipFuncSetAttribute((const void*)mk_fwd, hipFuncAttributeMaxDynamicSharedMemorySize, LDS_BYTES) != hipSuccess) { fprintf(stderr, "kernel_launch: hipFuncSetAttribute failed\n"); grid = -1; return; }
        if (hipOccupancyMaxActiveBlocksPerMultiprocessor(&per_cu, (const void*)mk_fwd, NWAVES * 64, LDS_BYTES) != hipSuccess || per_cu < 1) fprintf(stderr, "kernel_launch: occupancy query reports %d\n", per_cu);
        (void)hipGetLastError();
        grid = cus;
        if (grid != 256) fprintf(stderr, "kernel_launch: %d CUs (built for 256)\n", grid);
    }
    if (grid < 0) return;
    (void)hipMemsetAsync((char*)d_ws + WS_CTL, 0, CTL_ZERO_BYTES, stream);
    Args a{};
    for (int i = 0; i < 26; ++i) a.p.in[i] = (const float*)d_in[i];
    a.p.out = (float*)d_out; a.p.ws = (unsigned char*)d_ws;
    if (MK_N_LAUNCHES == 1) { a.ph_lo = 0; a.ph_hi = N_PHASES; hipLaunchKernelGGL(mk_fwd, dim3(grid), dim3(NWAVES * 64), LDS_BYTES, stream, a); }
    else {
        for (int k = 0; k < N_PHASES; ++k) {
            const int l = (k - 1) / 10, s = (k - 1) % 10;
            if (k > 0 && (l & 1) == 1 && (s == 2 || s == 3)) continue;
            a.ph_lo = k; a.ph_hi = k + 1; hipLaunchKernelGGL(mk_fwd, dim3(grid), dim3(NWAVES * 64), LDS_BYTES, stream, a);
        }
    }
}
#endif
```

```cpp
#include <hip/hip_runtime.h>
#include <cstdio>
#include <cstdint>

#ifndef ATT_PREFETCH
#define ATT_NOPF 1
#endif
#ifndef MK_N_LAUNCHES
#define MK_N_LAUNCHES 1
#endif

#ifndef REP_P0
#define REP_P0 1
#endif
#ifndef REP_A1
#define REP_A1 1
#endif
#ifndef REP_A2
#define REP_A2 1
#endif
#ifndef REP_A3
#define REP_A3 1
#endif
#ifndef REP_A4
#define REP_A4 1
#endif
#ifndef REP_B1
#define REP_B1 1
#endif
#ifndef REP_B2
#define REP_B2 1
#endif
#ifndef REP_X1
#define REP_X1 1
#endif
#ifndef REP_X2
#define REP_X2 1
#endif
#ifndef REP_X3
#define REP_X3 1
#endif
#ifndef REP_X4
#define REP_X4 1
#endif
#ifndef REP_M1
#define REP_M1 1
#endif
#ifndef REP_M2
#define REP_M2 1
#endif
#ifndef REP_BAR
#define REP_BAR 1
#endif
#ifndef REP_ATTN
#define REP_ATTN 1
#endif
#ifndef REP_R1
#define REP_R1 1
#endif
#ifndef REP_KVF
#define REP_KVF 1
#endif
#define REPEAT(n) for (int rep_ = 0; rep_ < (n); ++rep_)
#define REP_SEAM(n) do { if (rep_ + 1 < (n)) xcd_barrier(bar); } while (0)
namespace pg8 {
#define PG8_LAS __attribute__((address_space(3)))
typedef unsigned short bf16_t;
typedef short bf16x8 __attribute__((ext_vector_type(8)));
typedef float f32x4 __attribute__((ext_vector_type(4)));
typedef float f32x2 __attribute__((ext_vector_type(2)));
typedef unsigned u32x4 __attribute__((ext_vector_type(4)));
typedef unsigned u32x2 __attribute__((ext_vector_type(2)));
constexpr int BM = 256, BK = 64, HALF = 128, HTB = HALF * BK * 2, STAGE_BYTES = 8 * HTB, NXCD = 8, WGM = 8;

__host__ __device__ __forceinline__ int lds_byte(int r, int c) { const int st = (r >> 4) * 2 + (c >> 5), rr = r & 15, cc = c & 31, ob = rr * 64 + cc * 2; return st * 1024 + (ob ^ (((ob >> 9) & 1) << 5)); }
__host__ __device__ __forceinline__ void stage_rc(int b, int& R, int& C) { const int st = b / 1024, sb = b % 1024, swz = sb ^ (((sb >> 9) & 1) << 5); R = (st >> 1) * 16 + swz / 64; C = (st & 1) * 32 + (swz % 64) / 2; }
__host__ __device__ __forceinline__ int perm32(int rho) { const int n = rho >> 4, i = rho & 15; return 8 * (i >> 2) + 4 * n + (i & 3); }

struct Unit { int pm, pn; };
struct Gemm { const bf16_t* A; const bf16_t* Bt; int lda, ldb, K; int a_pm_mask, a_pn_cols; long b_pn_elems; int b_pm_shift; long b_batch_elems; };

struct StaticOrder {
    int nM, nN, nwg, G, c;
    __host__ __device__ void init(int nM_, int nN_, int G_, int c_) { nM = nM_; nN = nN_; nwg = nM * nN; G = G_; c = c_; }
    __host__ __device__ bool next(int i, Unit& u) const {
        const long L = (long)i * G + c; if (L >= nwg) return false;
        int wgid = (int)L; { const int q = nwg / NXCD, r = nwg % NXCD, xcd = wgid % NXCD, off = wgid / NXCD; wgid = (xcd < r ? xcd * (q + 1) : r * (q + 1) + (xcd - r) * q) + off; }
        const int nig = WGM * nN, gid = wgid / nig, fm = gid * WGM, gsz = (nM - fm) < WGM ? (nM - fm) : WGM;
        u.pm = fm + ((wgid % nig) % gsz); u.pn = (wgid % nig) / gsz; return true;
    }
};

__device__ __forceinline__ unsigned cvt_pk_bf16(float lo, float hi) { unsigned r; asm volatile("v_cvt_pk_bf16_f32 %0, %1, %2" : "=v"(r) : "v"(lo), "v"(hi)); return r; }

constexpr float EPS = 1e-6f;
template <int MODE> struct EpiBf16 {
    static constexpr bool PERM = true;
    bf16_t* O; int ldc; const float* aux_in; float* aux_out;
    __device__ __forceinline__ void operator()(const f32x4 (&acc)[2][2][4][2], const Unit& u, int wr, int wc, int fr, int fq) const {
        const int row0 = u.pm * BM + wr * 64 + fr, col0 = u.pn * BM + wc * 32 + 8 * fq;
#pragma unroll
        for (int ai = 0; ai < 2; ++ai)
#pragma unroll
            for (int m = 0; m < 4; ++m) {
                const int row = row0 + ai * HALF + m * 16; float f = 1.f;
                if (MODE >= 1 && MODE <= 3) { const f32x4 v = *(const f32x4*)(aux_in + (size_t)row * 16 + fq * 4); float s = (v[0] + v[1]) + (v[2] + v[3]); s += __shfl_xor(s, 16); s += __shfl_xor(s, 32); f = __builtin_amdgcn_rsqf(s * (1.0f / 1024.0f) + EPS); }
                if (MODE == 4) { const f32x4 v = *(const f32x4*)(aux_in + (size_t)row * 16 + u.pn * 4); const float s = (v[0] + v[1]) + (v[2] + v[3]); f = __builtin_amdgcn_rsqf(s * (1.0f / 256.0f) + EPS); }
                if (MODE == 5) { const f32x4 v = *(const f32x4*)(aux_in + (size_t)row * 16 + u.pn * 4); const float s = (v[0] + v[1]) + (v[2] + v[3]); f = 1.0f / s; }
                bf16_t* rowp = O + (size_t)row * ldc + col0; float part = 0.f;
#pragma unroll
                for (int bj = 0; bj < 2; ++bj) { f32x4 v0 = acc[ai][bj][m][0] * f, v1 = acc[ai][bj][m][1] * f;
                    if (MODE == 2) {
#pragma unroll
                        for (int e = 0; e < 4; ++e) { const float a = v0[e] > 0.f ? v0[e] : 0.f, b = v1[e] > 0.f ? v1[e] : 0.f; v0[e] = a * a; v1[e] = b * b; } }
                    if (MODE == 4) {
#pragma unroll
                        for (int e = 0; e < 4; ++e) { v0[e] = __builtin_amdgcn_exp2f(v0[e]); v1[e] = __builtin_amdgcn_exp2f(v1[e]); } }
                    if (MODE == 3) part += (v0[0] * v0[0] + v0[1] * v0[1]) + (v0[2] * v0[2] + v0[3] * v0[3]) + (v1[0] * v1[0] + v1[1] * v1[1]) + (v1[2] * v1[2] + v1[3] * v1[3]);
                    if (MODE == 4) part += (v0[0] + v0[1]) + (v0[2] + v0[3]) + (v1[0] + v1[1]) + (v1[2] + v1[3]);
                    u32x4 w; w.x = cvt_pk_bf16(v0[0], v0[1]); w.y = cvt_pk_bf16(v0[2], v0[3]); w.z = cvt_pk_bf16(v1[0], v1[1]); w.w = cvt_pk_bf16(v1[2], v1[3]);
                    *(u32x4*)(rowp + bj * HALF) = w; }
                if (MODE == 3 || MODE == 4) { part += __shfl_xor(part, 16); part += __shfl_xor(part, 32); if (fq == 0) aux_out[(size_t)row * 16 + u.pn * 4 + wc] = part; }
            }
    }
};
struct EpiRes {
    static constexpr bool PERM = false;
    const float* xin; float* xout; bf16_t* xb; float* ss; const float* scale;
    __device__ __forceinline__ void operator()(const f32x4 (&acc)[2][2][4][2], const Unit& u, int wr, int wc, int fr, int fq) const {
        const int row0 = u.pm * BM + wr * 64 + fr, col0 = u.pn * BM + wc * 32 + 4 * fq;
#pragma unroll
        for (int ai = 0; ai < 2; ++ai)
#pragma unroll
            for (int m = 0; m < 4; ++m) {
                const int row = row0 + ai * HALF + m * 16; const size_t off = (size_t)row * 1024 + col0; float sq = 0.f;
#pragma unroll
                for (int bj = 0; bj < 2; ++bj)
#pragma unroll
                    for (int n = 0; n < 2; ++n) { const int co = bj * HALF + n * 16; f32x4 a = acc[ai][bj][m][n];
                        if (scale) a = a * *(const f32x4*)(scale + col0 + co);
                        const f32x4 x = *(const f32x4*)(xin + off + co) + a; *(f32x4*)(xout + off + co) = x;
                        sq += (x[0] * x[0] + x[1] * x[1]) + (x[2] * x[2] + x[3] * x[3]);
                        u32x2 w; w.x = cvt_pk_bf16(x[0], x[1]); w.y = cvt_pk_bf16(x[2], x[3]); *(u32x2*)(xb + off + co) = w; }
                sq += __shfl_xor(sq, 16); sq += __shfl_xor(sq, 32); if (fq == 0) ss[(size_t)row * 16 + u.pn * 4 + wc] = sq;
                asm volatile("" ::: "memory");
            }
    }
};

template <class Epi, class Sched>
__device__ __forceinline__ void gemm_phase(PG8_LAS unsigned char* lds, const Gemm g, const Sched& S, const Epi& E) {
    int tid_ = threadIdx.x; asm volatile("" : "+v"(tid_));
    const int tid = tid_, wid = __builtin_amdgcn_readfirstlane(tid >> 6), lane = tid & 63, wr = wid >> 2, wc = wid & 3, fr = lane & 15, fq = lane >> 4;
    int K_ = g.K; asm volatile("" : "+s"(K_));
    const int K = K_, nt = K / BK;
    unsigned voffA[2], voffB[2];
#pragma unroll
    for (int i = 0; i < 2; ++i) { int R, C; stage_rc(tid * 16 + i * 8192, R, C); const int Rb = Epi::PERM ? ((R & ~31) + perm32(R & 31)) : R;
        voffA[i] = (unsigned)(R * g.lda + C) * 2u; voffB[i] = (unsigned)(Rb * g.ldb + C) * 2u; }
    const size_t kstep = (size_t)(BK * 2);
    const size_t hstepA = (size_t)HALF * g.lda * 2, hstepB = (size_t)HALF * g.ldb * 2;
    const unsigned ldsw = (unsigned)wid * 1024u;
    const int aoff = lds_byte(wr * 64 + fr, fq * 8), boff = lds_byte(wc * 32 + fr, fq * 8);
#define PG8_SA(b, h) (((b) * 2 + (h)) * HTB)
#define PG8_SB(b, h) ((4 + (b) * 2 + (h)) * HTB)
#define PG8_STAGE(bufoff, gbase, voff) do { _Pragma("unroll") for (int _i = 0; _i < 2; ++_i) \
        __builtin_amdgcn_global_load_lds((const unsigned*)((const char*)(gbase) + (voff)[_i]), (PG8_LAS unsigned*)(lds + (bufoff) + ldsw + _i * 8192), 16, 0, 0); } while (0)
#define PG8_LDA(dst, b, h) do { _Pragma("unroll") for (int m = 0; m < 4; ++m) _Pragma("unroll") for (int k = 0; k < 2; ++k) dst[m][k] = *(const PG8_LAS bf16x8*)(lds + PG8_SA(b, h) + aoff + m * 2048 + k * 1024); } while (0)
#define PG8_LDB(dst, b, h) do { _Pragma("unroll") for (int n = 0; n < 2; ++n) _Pragma("unroll") for (int k = 0; k < 2; ++k) dst[n][k] = *(const PG8_LAS bf16x8*)(lds + PG8_SB(b, h) + boff + n * 2048 + k * 1024); } while (0)
#define PG8_MMA(ai, bj, At, Bt) do { __builtin_amdgcn_s_setprio(1); _Pragma("unroll") for (int m = 0; m < 4; ++m) _Pragma("unroll") for (int n = 0; n < 2; ++n) _Pragma("unroll") for (int k = 0; k < 2; ++k) \
        acc[ai][bj][m][n] = __builtin_amdgcn_mfma_f32_16x16x32_bf16(Bt[n][k], At[m][k], acc[ai][bj][m][n], 0, 0, 0); __builtin_amdgcn_s_setprio(0); } while (0)
#define PG8_WAIT_V(n) asm volatile("s_waitcnt vmcnt(" #n ")" ::: "memory")
#define PG8_WAIT_L(n) asm volatile("s_waitcnt lgkmcnt(" #n ")" ::: "memory")
#define PG8_BAR __builtin_amdgcn_s_barrier()
#define PG8_SCHED __builtin_amdgcn_sched_barrier(0)
#define PG8_APTR(u) ((const char*)g.A + ((size_t)((u).pm & g.a_pm_mask) * 256 * g.lda + (size_t)(u).pn * g.a_pn_cols) * 2)
#define PG8_BPTR(u) ((const char*)g.Bt + ((size_t)(u).pn * g.b_pn_elems + (size_t)((u).pm >> g.b_pm_shift) * g.b_batch_elems) * 2)
    Unit cur, nxt; int ui = 0;
    if (!S.next(0, cur)) return;
    f32x4 acc[2][2][4][2];
#pragma unroll
    for (int a = 0; a < 2; ++a)
#pragma unroll
        for (int b = 0; b < 2; ++b)
#pragma unroll
            for (int m = 0; m < 4; ++m)
#pragma unroll
                for (int n = 0; n < 2; ++n) acc[a][b][m][n] = (f32x4){0.f, 0.f, 0.f, 0.f};
    bf16x8 At[4][2], B0[2][2], B1[2][2];
    const char* cA = PG8_APTR(cur); const char* cB = PG8_BPTR(cur);
    PG8_STAGE(PG8_SB(0, 0), cB, voffB); PG8_STAGE(PG8_SB(0, 1), cB + hstepB, voffB); PG8_STAGE(PG8_SA(0, 0), cA, voffA); PG8_STAGE(PG8_SA(0, 1), cA + hstepA, voffA);
    if (wr == 1) PG8_BAR;
    PG8_WAIT_V(2); PG8_BAR;
    PG8_STAGE(PG8_SB(1, 0), cB + kstep, voffB); PG8_STAGE(PG8_SA(1, 0), cA + kstep, voffA); PG8_STAGE(PG8_SB(1, 1), cB + hstepB + kstep, voffB);
    PG8_WAIT_V(6); PG8_BAR;
    for (;;) {
        const bool has_next = S.next(ui + 1, nxt);
        const char* nA = has_next ? PG8_APTR(nxt) : cA; const char* nB = has_next ? PG8_BPTR(nxt) : cB;
        for (int t = 0; t < nt; t += 2) {
            const bool last = (t == nt - 2);
            const char* a1 = cA + (size_t)(t + 1) * kstep;
            const char* a2 = last ? nA : cA + (size_t)(t + 2) * kstep; const char* b2 = last ? nB : cB + (size_t)(t + 2) * kstep;
            const char* a3 = a2 + kstep; const char* b3 = b2 + kstep;
            PG8_LDB(B0, 0, 0); PG8_LDB(B1, 0, 1); PG8_SCHED; PG8_LDA(At, 0, 0); PG8_STAGE(PG8_SA(1, 1), a1 + hstepA, voffA);
            PG8_WAIT_V(8); PG8_WAIT_L(0); PG8_BAR; PG8_MMA(0, 0, At, B0); PG8_MMA(0, 1, At, B1); PG8_BAR; PG8_SCHED;
            PG8_LDA(At, 0, 1); PG8_STAGE(PG8_SB(0, 0), b2, voffB); PG8_STAGE(PG8_SB(0, 1), b2 + hstepB, voffB); PG8_STAGE(PG8_SA(0, 0), a2, voffA);
            PG8_WAIT_V(8); PG8_WAIT_L(0); PG8_BAR; PG8_MMA(1, 0, At, B0); PG8_MMA(1, 1, At, B1); PG8_BAR; PG8_SCHED;
            PG8_LDB(B0, 1, 0); PG8_LDB(B1, 1, 1); PG8_SCHED; PG8_LDA(At, 1, 0); PG8_STAGE(PG8_SA(0, 1), a2 + hstepA, voffA);
            PG8_WAIT_V(8); PG8_WAIT_L(0); PG8_BAR; PG8_MMA(0, 0, At, B0); PG8_MMA(0, 1, At, B1); PG8_BAR; PG8_SCHED;
            PG8_LDA(At, 1, 1); PG8_STAGE(PG8_SB(1, 0), b3, voffB); PG8_STAGE(PG8_SB(1, 1), b3 + hstepB, voffB); PG8_STAGE(PG8_SA(1, 0), a3, voffA);
            PG8_WAIT_V(8); PG8_WAIT_L(0); PG8_BAR; PG8_MMA(1, 0, At, B0); PG8_MMA(1, 1, At, B1); PG8_BAR; PG8_SCHED;
        }
        if (wr == 0) PG8_BAR;
        E(acc, cur, wr, wc, fr, fq);
        if (!has_next) break;
#pragma unroll
        for (int a = 0; a < 2; ++a)
#pragma unroll
            for (int b = 0; b < 2; ++b)
#pragma unroll
                for (int m = 0; m < 4; ++m)
#pragma unroll
                    for (int n = 0; n < 2; ++n) acc[a][b][m][n] = (f32x4){0.f, 0.f, 0.f, 0.f};
        cur = nxt; cA = nA; cB = nB; ++ui;
        if (wr == 1) PG8_BAR;
    }
    PG8_WAIT_V(0);
    PG8_BAR;
#undef PG8_SA
#undef PG8_SB
#undef PG8_STAGE
#undef PG8_LDA
#undef PG8_LDB
#undef PG8_MMA
#undef PG8_WAIT_V
#undef PG8_WAIT_L
#undef PG8_BAR
#undef PG8_SCHED
#undef PG8_APTR
#undef PG8_BPTR
}
}

constexpr int NWAVES = 8;
constexpr int D = 1024, BATCH = 4, SEQ = 4096, T = BATCH * SEQ, NMEM = 256, TM = BATCH * NMEM, FF = 4096, INC = 2560;
constexpr float EPS = 1e-6f;
constexpr float LOG2E = 1.4426950408889634f;

constexpr size_t MiB = 1u << 20;
constexpr size_t WS_CTL = 0, CTL_ZERO_BYTES = 64 * 1024;
constexpr size_t WS_SS = 1 * MiB, WS_QSS = 2 * MiB, WS_LSUM = 3 * MiB, WS_DEN = 4 * MiB, WS_AEND = 5 * MiB, WS_HEND = 5 * MiB + 256 * 1024;
constexpr size_t WS_GT = 6 * MiB, WS_POOLT = 7 * MiB;
constexpr size_t WS_WIN = 8 * MiB, WS_WOUT = 18 * MiB, WS_WQ = 22 * MiB, WS_WO = 30 * MiB, WS_W1 = 38 * MiB, WS_W2 = 70 * MiB, WS_WKV = 102 * MiB;
constexpr size_t WS_KN = 102 * MiB, WS_VT = 110 * MiB;
constexpr size_t WS_XB = 118 * MiB, WS_Y0 = 118 * MiB, WS_Y1 = 134 * MiB;
constexpr size_t WS_HID = 150 * MiB, WS_PROJ = 150 * MiB, WS_NUM = 230 * MiB, WS_AOUT = 150 * MiB, WS_Q = 182 * MiB, WS_P = 214 * MiB, WS_O = 246 * MiB;
constexpr size_t WS_END = 278 * MiB;
constexpr size_t DO_KVRAW = 0, DO_MEMN = 16 * MiB;

constexpr int RING_BYTES = 131072, LDSCTL_OFF = RING_BYTES, MISC_OFF = LDSCTL_OFF + 320, LDS_BYTES = 147456;

#define GAS __attribute__((address_space(1)))
#define LAS __attribute__((address_space(3)))
typedef unsigned short bf16;
typedef unsigned v4u __attribute__((ext_vector_type(4)));
typedef unsigned v2u __attribute__((ext_vector_type(2)));
typedef float f32x4 __attribute__((ext_vector_type(4)));
typedef short bf16x8 __attribute__((ext_vector_type(8)));
typedef short s16x4 __attribute__((ext_vector_type(4)));
#define LDS_WAIT() asm volatile("s_waitcnt lgkmcnt(0)" ::: "memory")
#define VM_WAIT() asm volatile("s_waitcnt vmcnt(0)" ::: "memory")
__device__ __forceinline__ unsigned pk2(float lo, float hi) { return pg8::cvt_pk_bf16(lo, hi); }
__device__ __forceinline__ float bflo(unsigned w) { return __uint_as_float(w << 16); }
__device__ __forceinline__ float bfhi(unsigned w) { return __uint_as_float(w & 0xffff0000u); }
__device__ __forceinline__ float bf1(bf16 h) { return __uint_as_float((unsigned)h << 16); }
__device__ __forceinline__ bf16 f2bf(float f) { return (bf16)(pg8::cvt_pk_bf16(f, 0.f) & 0xffffu); }

#define XB_TMO      128
#define XB_XCNT(j)  (256  + 64 * (j))
#define XB_XSUB(j)  (1280 + 64 * (j))
#define XB_XGEN(j)  (2304 + 64 * (j))
#define XB_TOP      3328
#define XB_TOPGEN   3392
#define XCD_BAR_WORDS 3456
#define XB_SPIN_CAP (1u << 22)
__device__ __forceinline__ unsigned xb_ld(unsigned* p)              { return __hip_atomic_load(p, __ATOMIC_RELAXED, __HIP_MEMORY_SCOPE_AGENT); }
__device__ __forceinline__ unsigned xb_add(unsigned* p, unsigned v) { return __hip_atomic_fetch_add(p, v, __ATOMIC_RELAXED, __HIP_MEMORY_SCOPE_AGENT); }
__device__ __forceinline__ unsigned xb_xcc_id() { return (unsigned)__builtin_amdgcn_s_getreg((3 << 11) | 20) & 0xFu; }
#define XB_SPIN(cond, bar) do { unsigned _sp = 0; while (cond) { __builtin_amdgcn_s_sleep(1); \
    if ((++_sp & 255u) == 0u) { if (xb_ld(&(bar)[XB_TMO])) break; if (_sp > XB_SPIN_CAP) { atomicAdd(&(bar)[XB_TMO], 1u); break; } } } } while (0)
struct XcdBarrier { unsigned* bar; unsigned x; volatile LAS unsigned* st; };
__device__ __forceinline__ XcdBarrier xcd_barrier_post(unsigned* bar, volatile LAS unsigned* st) {
    XcdBarrier b; b.bar = bar; b.x = xb_xcc_id(); b.st = st;
    if (threadIdx.x == 0) (void)xb_add(&bar[XB_XCNT(b.x)], 1u);
    return b;
}
__device__ __forceinline__ void xcd_barrier_complete(unsigned* bar, unsigned x, unsigned& nloc, unsigned& nx) {
    const unsigned G = gridDim.x * gridDim.y * gridDim.z;
    unsigned sum, cnt, mine, sp = 0u;
    for (;;) {
        sum = 0u; cnt = 0u; mine = 0u;
#pragma unroll
        for (unsigned j = 0; j < 16; ++j) { const unsigned c = xb_ld(&bar[XB_XCNT(j)]); sum += c; cnt += (c > 0u) ? 1u : 0u; mine = (j == x) ? c : mine; }
        if (sum == G) break;
        __builtin_amdgcn_s_sleep(1);
        if ((++sp & 255u) == 0u) { if (xb_ld(&bar[XB_TMO])) break; if (sp > XB_SPIN_CAP) { atomicAdd(&bar[XB_TMO], 1u); break; } }
    }
    nloc = mine > 0u ? mine : 1u; nx = cnt > 0u ? cnt : 1u;
}
__device__ __forceinline__ void xcd_barrier(const XcdBarrier& b) {
    asm volatile("s_waitcnt vmcnt(0)" ::: "memory");
    __syncthreads();
    if (threadIdx.x == 0) {
        unsigned* bar = b.bar;
        __builtin_amdgcn_s_waitcnt(0);
        unsigned nloc = b.st[0], nx = b.st[1];
        if (nloc == 0u) { xcd_barrier_complete(bar, b.x, nloc, nx); b.st[0] = nloc; b.st[1] = nx; }
        const unsigned old = xb_add(&bar[XB_XSUB(b.x)], 1u);
        const unsigned gen = old / nloc;
        if (old + 1u == (gen + 1u) * nloc) {
            __builtin_amdgcn_fence(__ATOMIC_RELEASE, "agent");
            asm volatile("s_waitcnt vmcnt(0)" ::: "memory");
            const unsigned og = xb_add(&bar[XB_TOP], 1u);
            const unsigned tg = og / nx;
            if (og + 1u == (tg + 1u) * nx) xb_add(&bar[XB_TOPGEN], 1u);
            else XB_SPIN(xb_ld(&bar[XB_TOPGEN]) == tg, bar);
            __builtin_amdgcn_fence(__ATOMIC_ACQUIRE, "agent");
            xb_add(&bar[XB_XGEN(b.x)], 1u);
            asm volatile("s_waitcnt vmcnt(0)" ::: "memory");
        } else {
            XB_SPIN(xb_ld(&bar[XB_XGEN(b.x)]) == gen, bar);
            __builtin_amdgcn_fence(__ATOMIC_ACQUIRE, "agent");
            asm volatile("s_waitcnt vmcnt(0)" ::: "memory");
        }
    }
    __syncthreads();
}

__device__ __forceinline__ float wave_sum(float v) {
#pragma unroll
    for (int o = 1; o < 64; o <<= 1) v += __shfl_xor(v, o);
    return v;
}

__device__ __forceinline__ void p0_transpose_item(const float* W, int K, int N, bf16* WT, const float* gain, LAS float* scr, int item, int lane) {
    const int nblk = N / 32, kb = item / nblk, nb = item % nblk, k0 = 64 * kb, n0 = 32 * nb;
    const int c = lane & 7;
    f32x4 g0 = (f32x4){1.f, 1.f, 1.f, 1.f}, g1 = g0;
    if (gain) { g0 = *(const GAS f32x4*)(gain + k0 + 8 * c); g1 = *(const GAS f32x4*)(gain + k0 + 8 * c + 4); }
#pragma unroll
    for (int i = 0; i < 32; ++i) { const int kk = 2 * i + (lane >> 5); scr[kk * 33 + (lane & 31)] = W[(size_t)(k0 + kk) * N + n0 + (lane & 31)]; }
    LDS_WAIT(); asm volatile("" ::: "memory");
#pragma unroll
    for (int j = 0; j < 4; ++j) { const int n = (lane >> 3) + 8 * j; const LAS float* s = scr + (8 * c) * 33 + n;
        v4u o; o.x = pk2(s[0 * 33] * g0[0], s[1 * 33] * g0[1]); o.y = pk2(s[2 * 33] * g0[2], s[3 * 33] * g0[3]); o.z = pk2(s[4 * 33] * g1[0], s[5 * 33] * g1[1]); o.w = pk2(s[6 * 33] * g1[2], s[7 * 33] * g1[3]);
        *(GAS v4u*)(WT + (size_t)(n0 + n) * K + k0 + 8 * c) = o; }
    LDS_WAIT(); asm volatile("" ::: "memory");
}

struct Ptrs {
    const float* in[26]; float* out; unsigned char* ws;
};

struct Args { Ptrs p; int ph_lo, ph_hi; };
__device__ __forceinline__ const float* ld_in(const Args& a, int i) { asm volatile("" : "+s"(i)); return a.p.in[i]; }
__device__ __forceinline__ float* ld_out(const Args& a) { int i = 0; asm volatile("" : "+s"(i)); return (&a.p.out)[i]; }
__device__ __forceinline__ unsigned char* ld_ws(const Args& a) { int i = 0; asm volatile("" : "+s"(i)); return (&a.p.ws)[i]; }
#define INP(i) ld_in(args, (i))
#define OUTP() ld_out(args)
__device__ __forceinline__ void p0_prologue(const Args& args, LAS unsigned char* lds, int gw, int NGW, int wave) {
    int tid_ = threadIdx.x; asm volatile("" : "+v"(tid_)); const int lane = tid_ & 63;
    LAS float* scr = (LAS float*)(lds + wave * 16384);
    unsigned char* ws = ld_ws(args);
    constexpr int I_WIN = 16 * 80, I_SQ = 16 * 32, I_G = 2 * 4, I_POOL = 4 * 8, I_KV = 16 * 64, I_W1 = 16 * 128, I_W2 = 64 * 32;
    constexpr int NITEMS = 2 * I_WIN + 2 * I_SQ + 16 * I_G + 8 * I_POOL + 4 * I_SQ + 4 * I_KV + 4 * I_SQ + 4 * I_W1 + 4 * I_W2;
    for (int it = gw; it < NITEMS; it += NGW) {
        int r = it;
        if (r < 4 * I_W1) { const int l = r / I_W1; p0_transpose_item(INP(24) + (size_t)l * D * FF, D, FF, (bf16*)(ws + WS_W1) + (size_t)l * FF * D, INP(5) + l * D, scr, r % I_W1, lane); continue; } r -= 4 * I_W1;
        if (r < 4 * I_W2) { const int l = r / I_W2; p0_transpose_item(INP(25) + (size_t)l * FF * D, FF, D, (bf16*)(ws + WS_W2) + (size_t)l * D * FF, nullptr, scr, r % I_W2, lane); continue; } r -= 4 * I_W2;
        if (r < 4 * I_KV) { const int l = r / I_KV; p0_transpose_item(INP(20) + (size_t)l * D * 2048, D, 2048, (bf16*)(ws + WS_WKV) + (size_t)l * 2048 * D, nullptr, scr, r % I_KV, lane); continue; } r -= 4 * I_KV;
        if (r < 2 * I_WIN) { const int e = r / I_WIN; p0_transpose_item(INP(6) + (size_t)e * D * INC, D, INC, (bf16*)(ws + WS_WIN) + (size_t)e * INC * D, INP(3) + (2 * e) * D, scr, r % I_WIN, lane); continue; } r -= 2 * I_WIN;
        if (r < 2 * I_SQ) { const int e = r / I_SQ; p0_transpose_item(INP(16) + (size_t)e * D * D, D, D, (bf16*)(ws + WS_WOUT) + (size_t)e * D * D, nullptr, scr, r % I_SQ, lane); continue; } r -= 2 * I_SQ;
        if (r < 4 * I_SQ) { const int l = r / I_SQ; p0_transpose_item(INP(19) + (size_t)l * D * D, D, D, (bf16*)(ws + WS_WQ) + (size_t)l * D * D, INP(4) + l * D, scr, r % I_SQ, lane); continue; } r -= 4 * I_SQ;
        if (r < 4 * I_SQ) { const int l = r / I_SQ; p0_transpose_item(INP(23) + (size_t)l * D * D, D, D, (bf16*)(ws + WS_WO) + (size_t)l * D * D, nullptr, scr, r % I_SQ, lane); continue; } r -= 4 * I_SQ;
        if (r < 8 * I_POOL) { const int mat = r / I_POOL, o = mat >> 2, g = mat & 3; p0_transpose_item(INP(17) + (size_t)mat * 65536, 256, 256, (bf16*)(ws + WS_POOLT) + (size_t)mat * 65536, INP(3) + (2 * o + 1) * D + g * 256, scr, r % I_POOL, lane); continue; } r -= 8 * I_POOL;
        { const int mat = r / I_G, kind = mat >> 3, eg = mat & 7, e = eg >> 2, g = eg & 3;
          p0_transpose_item((kind ? INP(13) : INP(11)) + (size_t)eg * 16384, 128, 128, (bf16*)(ws + WS_GT) + (size_t)((e * 2 + kind) * 4 + g) * 16384, nullptr, scr, r % I_G, lane); }
    }
    for (int m = gw; m < T; m += NGW) {
        const GAS f32x4* xr = (const GAS f32x4*)(INP(0) + (size_t)m * D) + lane; f32x4 v[4]; float s = 0.f;
#pragma unroll
        for (int j = 0; j < 4; ++j) { v[j] = xr[64 * j]; s += (v[j][0] * v[j][0] + v[j][1] * v[j][1]) + (v[j][2] * v[j][2] + v[j][3] * v[j][3]); }
        s = wave_sum(s);
        GAS v2u* o8 = (GAS v2u*)((bf16*)(ws + WS_XB) + (size_t)m * D) + lane;
#pragma unroll
        for (int j = 0; j < 4; ++j) { v2u w; w.x = pk2(v[j][0], v[j][1]); w.y = pk2(v[j][2], v[j][3]); o8[64 * j] = w; }
        if (lane < 16) ((float*)(ws + WS_SS))[(size_t)m * 16 + lane] = lane == 0 ? s : 0.f;
    }
    for (int m = gw; m < TM; m += NGW) {
        const GAS f32x4* xr = (const GAS f32x4*)(INP(1) + (size_t)m * D) + lane; const GAS f32x4* gr = (const GAS f32x4*)(INP(2)) + lane; f32x4 v[4]; float s = 0.f;
#pragma unroll
        for (int j = 0; j < 4; ++j) { v[j] = xr[64 * j]; s += (v[j][0] * v[j][0] + v[j][1] * v[j][1]) + (v[j][2] * v[j][2] + v[j][3] * v[j][3]); }
        const float rs = 1.0f / sqrtf(wave_sum(s) * (1.0f / D) + EPS);
        GAS v2u* o8 = (GAS v2u*)((bf16*)((unsigned char*)OUTP() + DO_MEMN) + (size_t)m * D) + lane;
#pragma unroll
        for (int j = 0; j < 4; ++j) { const f32x4 gg = gr[64 * j]; v2u w; w.x = pk2(v[j][0] * rs * gg[0], v[j][1] * rs * gg[1]); w.y = pk2(v[j][2] * rs * gg[2], v[j][3] * rs * gg[3]); o8[64 * j] = w; }
    }
}

__device__ __forceinline__ void kv_finalize(const Args& args, int gw, int NGW) {
    int tid_ = threadIdx.x; asm volatile("" : "+v"(tid_)); const int lane = tid_ & 63;
    const bf16* kvraw = (const bf16*)((unsigned char*)OUTP() + DO_KVRAW);
    bf16* Kn = (bf16*)(ld_ws(args) + WS_KN); bf16* Vt = (bf16*)(ld_ws(args) + WS_VT);
    for (int row = gw; row < 4 * TM * 4; row += NGW) {
        const int l = row >> 12, m = (row >> 2) & 1023, h = row & 3, b = m >> 8, key = m & 255;
        const v2u w = *(const GAS v2u*)(kvraw + ((size_t)(l * TM + m)) * 2048 + h * 256 + 4 * lane);
        const float k0 = bflo(w.x), k1 = bfhi(w.x), k2 = bflo(w.y), k3 = bfhi(w.y);
        const float ss = wave_sum((k0 * k0 + k1 * k1) + (k2 * k2 + k3 * k3));
        const float sc = (1.0f / sqrtf(ss * (1.0f / 256.0f) + EPS)) * (0.0625f * LOG2E);
        const f32x4 gk = *(const GAS f32x4*)(INP(22) + l * 256 + 4 * lane), gq = *(const GAS f32x4*)(INP(21) + l * 256 + 4 * lane);
        v2u o; o.x = pk2(k0 * sc * gk[0] * gq[0], k1 * sc * gk[1] * gq[1]); o.y = pk2(k2 * sc * gk[2] * gq[2], k3 * sc * gk[3] * gq[3]);
        *(GAS v2u*)(Kn + ((size_t)((l * 4 + b) * 4 + h) * 256 + key) * 256 + 4 * lane) = o;
    }
    for (int it = gw; it < 256; it += NGW) {
        const int l = it >> 6, b = (it >> 4) & 3, h = (it >> 2) & 3, kb = it & 3, key = 64 * kb + lane;
        const bf16* src = kvraw + ((size_t)(l * TM + b * 256 + key)) * 2048 + 1024 + h * 256;
        bf16* dst = Vt + ((size_t)((l * 4 + b) * 4 + h) * 256) * 256 + key;
        for (int dc = 0; dc < 32; ++dc) { const v4u w = *(const GAS v4u*)(src + 8 * dc);
            dst[(size_t)(8 * dc + 0) * 256] = (bf16)(w.x & 0xffffu); dst[(size_t)(8 * dc + 1) * 256] = (bf16)(w.x >> 16);
            dst[(size_t)(8 * dc + 2) * 256] = (bf16)(w.y & 0xffffu); dst[(size_t)(8 * dc + 3) * 256] = (bf16)(w.y >> 16);
            dst[(size_t)(8 * dc + 4) * 256] = (bf16)(w.z & 0xffffu); dst[(size_t)(8 * dc + 5) * 256] = (bf16)(w.z >> 16);
            dst[(size_t)(8 * dc + 6) * 256] = (bf16)(w.w & 0xffffu); dst[(size_t)(8 * dc + 7) * 256] = (bf16)(w.w >> 16); }
    }
}

struct AttnPre { v4u kk[4], vv[4], qq[4]; };
__device__ __forceinline__ void attn_load(AttnPre& R, const bf16* proj, size_t rowb, int h, int base, int d, int tid, bool valid) {
    const int c = tid & 15, w = tid >> 6, lane = tid & 63, q = lane & 15, G = lane >> 4;
#pragma unroll
    for (int i = 0; i < 4; ++i) { const int kr = (tid >> 4) + 32 * i;
        if (valid) { const bf16* p = proj + (rowb + base + (size_t)kr * d) * INC + 512 + h * 128 + 8 * c; R.kk[i] = *(const GAS v4u*)p; R.vv[i] = *(const GAS v4u*)(p + 512); }
        else { R.kk[i] = (v4u){0u, 0u, 0u, 0u}; R.vv[i] = (v4u){0u, 0u, 0u, 0u}; } }
    if (valid) {
        const size_t qrow = rowb + base + (size_t)(16 * w + q) * d;
#pragma unroll
        for (int ks = 0; ks < 4; ++ks) R.qq[ks] = *(const GAS v4u*)(proj + qrow * INC + h * 128 + 32 * ks + 8 * G); }
}
__device__ __forceinline__ void attn_store_kv(const AttnPre& R, LAS unsigned char* lds, int slot, const float* gk, int tid) {
    const int c = tid & 15;
    const f32x4 ga = *(const GAS f32x4*)(gk + 8 * c), gb = *(const GAS f32x4*)(gk + 8 * c + 4);
#pragma unroll
    for (int i = 0; i < 4; ++i) { const int kr = (tid >> 4) + 32 * i, lr = slot * 128 + kr;
        const float a0 = bflo(R.kk[i].x), a1 = bfhi(R.kk[i].x), a2 = bflo(R.kk[i].y), a3 = bfhi(R.kk[i].y), a4 = bflo(R.kk[i].z), a5 = bfhi(R.kk[i].z), a6 = bflo(R.kk[i].w), a7 = bfhi(R.kk[i].w);
        float ss = ((a0 * a0 + a1 * a1) + (a2 * a2 + a3 * a3)) + ((a4 * a4 + a5 * a5) + (a6 * a6 + a7 * a7));
        ss += __shfl_xor(ss, 1); ss += __shfl_xor(ss, 2); ss += __shfl_xor(ss, 4); ss += __shfl_xor(ss, 8);
        const float rk = __builtin_amdgcn_rsqf(ss * (1.0f / 128.0f) + EPS);
        v4u o; o.x = pk2(a0 * rk * ga[0], a1 * rk * ga[1]); o.y = pk2(a2 * rk * ga[2], a3 * rk * ga[3]); o.z = pk2(a4 * rk * gb[0], a5 * rk * gb[1]); o.w = pk2(a6 * rk * gb[2], a7 * rk * gb[3]);
        *(LAS v4u*)(lds + lr * 256 + ((c ^ (lr & 15)) << 4)) = o;
        *(LAS v4u*)(lds + 65536 + lr * 256 + ((c ^ ((lr & 7) << 1)) << 4)) = R.vv[i]; }
}
__device__ __forceinline__ void attn_segment(LAS unsigned char* lds, const bf16* proj, const float* gq, const float* gk, bf16* num, float* den, int g, int bh, int r, int n0, int L, int tid) {
    asm volatile("" : "+v"(tid));
    const int dsh = 2 * g, d = 1 << dsh, b = bh >> 2, h = bh & 3, wlen = 128 << dsh;
    const size_t rowb = (size_t)b * SEQ;
    const int w = tid >> 6, lane = tid & 63, q = lane & 15, G = lane >> 4;
    AttnPre R;
    attn_load(R, proj, rowb, h, (n0 - 1) * wlen + r, d, tid, n0 > 0);
    attn_store_kv(R, lds, (n0 - 1) & 1, gk, tid);
    attn_load(R, proj, rowb, h, n0 * wlen + r, d, tid, true);
    attn_store_kv(R, lds, n0 & 1, gk, tid);
    for (int n = n0; n < n0 + L; ++n) {
        const int base = n * wlen + r;
        const size_t qrow = rowb + base + (size_t)(16 * w + q) * d;
        bf16x8 Qf[4];
        {
            float ss = 0.f;
#pragma unroll
            for (int ks = 0; ks < 4; ++ks) { const float a0 = bflo(R.qq[ks].x), a1 = bfhi(R.qq[ks].x), a2 = bflo(R.qq[ks].y), a3 = bfhi(R.qq[ks].y), a4 = bflo(R.qq[ks].z), a5 = bfhi(R.qq[ks].z), a6 = bflo(R.qq[ks].w), a7 = bfhi(R.qq[ks].w);
                ss += ((a0 * a0 + a1 * a1) + (a2 * a2 + a3 * a3)) + ((a4 * a4 + a5 * a5) + (a6 * a6 + a7 * a7)); }
            ss += __shfl_xor(ss, 16); ss += __shfl_xor(ss, 32);
            const float rq = __builtin_amdgcn_rsqf(ss * (1.0f / 128.0f) + EPS) * (0.08838834764831845f * LOG2E);
#pragma unroll
            for (int ks = 0; ks < 4; ++ks) { const f32x4 ga = *(const GAS f32x4*)(gq + 32 * ks + 8 * G), gb = *(const GAS f32x4*)(gq + 32 * ks + 8 * G + 4);
                v4u o; o.x = pk2(bflo(R.qq[ks].x) * rq * ga[0], bfhi(R.qq[ks].x) * rq * ga[1]); o.y = pk2(bflo(R.qq[ks].y) * rq * ga[2], bfhi(R.qq[ks].y) * rq * ga[3]);
                o.z = pk2(bflo(R.qq[ks].z) * rq * gb[0], bfhi(R.qq[ks].z) * rq * gb[1]); o.w = pk2(bflo(R.qq[ks].w) * rq * gb[2], bfhi(R.qq[ks].w) * rq * gb[3]);
                Qf[ks] = __builtin_bit_cast(bf16x8, o); }
        }
        __syncthreads();
        const bool more = (n + 1 < n0 + L);
#ifndef ATT_NOPF
        if (more) attn_load(R, proj, rowb, h, base + wlen, d, tid, true);
#endif
        f32x4 s[9];
#pragma unroll
        for (int t = 0; t < 9; ++t) { s[t] = (f32x4){0.f, 0.f, 0.f, 0.f}; const int kt = w + t, lr = ((((n - 1) + (kt >> 3)) & 1) << 7) + ((kt & 7) << 4) + q;
#pragma unroll
            for (int ks = 0; ks < 4; ++ks) { const bf16x8 Kf = *(const LAS bf16x8*)(lds + lr * 256 + (((4 * ks + G) ^ q) << 4));
                s[t] = __builtin_amdgcn_mfma_f32_16x16x32_bf16(Kf, Qf[ks], s[t], 0, 0, 0); } }
        float dsum = 0.f; const bool first = (n == 0);
#pragma unroll
        for (int t = 0; t < 9; ++t)
#pragma unroll
            for (int e = 0; e < 4; ++e) { const int kk = 4 * G + e; bool ok = true;
                if (t == 0) ok = kk >= q; if (t == 8) ok = kk <= q; if (first && (w + t) < 8) ok = false;
                const float p = ok ? __builtin_amdgcn_exp2f(s[t][e]) : 0.f; s[t][e] = p; dsum += p; }
        dsum += __shfl_xor(dsum, 16); dsum += __shfl_xor(dsum, 32);
        f32x4 o[8];
#pragma unroll
        for (int nt = 0; nt < 8; ++nt) o[nt] = (f32x4){0.f, 0.f, 0.f, 0.f};
        const int q4 = q >> 2, pp = q & 3;
#pragma unroll
        for (int si = 0; si < 5; ++si) {
            v4u pw; pw.x = pk2(s[2 * si][0], s[2 * si][1]); pw.y = pk2(s[2 * si][2], s[2 * si][3]);
            if (si < 4) { pw.z = pk2(s[2 * si + 1][0], s[2 * si + 1][1]); pw.w = pk2(s[2 * si + 1][2], s[2 * si + 1][3]); } else { pw.z = 0u; pw.w = 0u; }
            const bf16x8 Pf = __builtin_bit_cast(bf16x8, pw);
            const int kt0 = w + 2 * si, kt1 = (si < 4) ? kt0 + 1 : kt0;
            const int key0 = ((((n - 1) + (kt0 >> 3)) & 1) << 7) + ((kt0 & 7) << 4) + 4 * G + q4, key1 = ((((n - 1) + (kt1 >> 3)) & 1) << 7) + ((kt1 & 7) << 4) + 4 * G + q4;
            const int sw0 = (key0 & 7) << 1, sw1 = (key1 & 7) << 1;
#pragma unroll
            for (int nt = 0; nt < 8; ++nt) { const int chunk = 2 * nt + (pp >> 1);
                const s16x4 v0 = __builtin_bit_cast(s16x4, __builtin_amdgcn_ds_read_tr16_b64_v4i16((LAS s16x4*)(lds + 65536 + key0 * 256 + ((chunk ^ sw0) << 4) + (pp & 1) * 8)));
                const s16x4 v1 = __builtin_bit_cast(s16x4, __builtin_amdgcn_ds_read_tr16_b64_v4i16((LAS s16x4*)(lds + 65536 + key1 * 256 + ((chunk ^ sw1) << 4) + (pp & 1) * 8)));
                const bf16x8 Vf = (bf16x8){v0[0], v0[1], v0[2], v0[3], v1[0], v1[1], v1[2], v1[3]};
                o[nt] = __builtin_amdgcn_mfma_f32_16x16x32_bf16(Vf, Pf, o[nt], 0, 0, 0); }
        }
        bf16* np = num + ((size_t)g * T + qrow) * 512 + h * 128 + 4 * G;
#pragma unroll
        for (int nt = 0; nt < 8; ++nt) { v2u wv; wv.x = pk2(o[nt][0], o[nt][1]); wv.y = pk2(o[nt][2], o[nt][3]); *(GAS v2u*)(np + 16 * nt) = wv; }
        if (G == 0) den[((size_t)g * T + qrow) * 4 + h] = dsum;
        __syncthreads();
#ifdef ATT_NOPF
        if (more) attn_load(R, proj, rowb, h, base + wlen, d, tid, true);
#endif
#ifdef ATT_VMW
        asm volatile("s_waitcnt vmcnt(0)" ::: "memory");
#endif
        if (more) attn_store_kv(R, lds, (n + 1) & 1, gk, tid);
    }
    __syncthreads();
}

__device__ __forceinline__ float rcp_(float x) { return __builtin_amdgcn_rcpf(x); }
__device__ __forceinline__ float sigmoid_fast(float x) { return rcp_(1.0f + __builtin_amdgcn_exp2f(-LOG2E * x)); }
__device__ __forceinline__ float gelu_tanh(float x) { const float u = 0.7978845608028654f * (x + 0.044715f * x * x * x); const float e = __builtin_amdgcn_exp2f((2.0f * LOG2E) * u); return x * (1.0f - rcp_(e + 1.0f)); }
__device__ __forceinline__ void r1_unit(LAS unsigned char* lds, const bf16* proj, const float* cw, const float* cb, const bf16* GaT, const bf16* GxT, const float* ba, const float* bx, const float* lam,
                                        bf16* Y0, bf16* Y1, float* Aend, float* Hend, int uid, int tid) {
    asm volatile("" : "+v"(tid));
    const int g = uid & 3, chunk = (uid >> 2) & 31, b = uid >> 7, t0 = chunk * 128;
    const size_t rowb = (size_t)b * SEQ;
    LAS unsigned char* lxc = lds; LAS unsigned char* lgt = lds + 32768; LAS unsigned char* ly0 = lds + 65536; LAS unsigned char* ly1 = lds + 98304;
    {
        const int c8 = tid & 15, ch0 = 128 * g + 8 * c8;
        float wj[4][8], bb[8];
#pragma unroll
        for (int jj = 0; jj < 4; ++jj) { const f32x4 a = *(const GAS f32x4*)(cw + jj * 512 + ch0), c = *(const GAS f32x4*)(cw + jj * 512 + ch0 + 4);
            wj[jj][0] = a[0]; wj[jj][1] = a[1]; wj[jj][2] = a[2]; wj[jj][3] = a[3]; wj[jj][4] = c[0]; wj[jj][5] = c[1]; wj[jj][6] = c[2]; wj[jj][7] = c[3]; }
        { const f32x4 a = *(const GAS f32x4*)(cb + ch0), c = *(const GAS f32x4*)(cb + ch0 + 4); bb[0] = a[0]; bb[1] = a[1]; bb[2] = a[2]; bb[3] = a[3]; bb[4] = c[0]; bb[5] = c[1]; bb[6] = c[2]; bb[7] = c[3]; }
#pragma unroll
        for (int i = 0; i < 4; ++i) { const int tt = (tid >> 4) + 32 * i, t = t0 + tt;
            float a[8];
#pragma unroll
            for (int e = 0; e < 8; ++e) a[e] = bb[e];
#pragma unroll
            for (int jj = 0; jj < 4; ++jj) { const int ts = t - 3 + jj;
                if (ts >= 0) { const v4u x = *(const GAS v4u*)(proj + (rowb + ts) * INC + 1536 + ch0);
                    a[0] += wj[jj][0] * bflo(x.x); a[1] += wj[jj][1] * bfhi(x.x); a[2] += wj[jj][2] * bflo(x.y); a[3] += wj[jj][3] * bfhi(x.y);
                    a[4] += wj[jj][4] * bflo(x.z); a[5] += wj[jj][5] * bfhi(x.z); a[6] += wj[jj][6] * bflo(x.w); a[7] += wj[jj][7] * bfhi(x.w); } }
            v4u o; o.x = pk2(a[0], a[1]); o.y = pk2(a[2], a[3]); o.z = pk2(a[4], a[5]); o.w = pk2(a[6], a[7]);
            *(LAS v4u*)(lxc + tt * 256 + ((c8 ^ (tt & 15)) << 4)) = o;
            *(LAS v4u*)(lgt + tt * 256 + ((c8 ^ (tt & 15)) << 4)) = *(const GAS v4u*)(proj + (rowb + t) * INC + 2048 + ch0); }
    }
    const int w = tid >> 6, lane = tid & 63, q = lane & 15, G = lane >> 4;
    const int dd = 16 * w + q, ch = 128 * g + dd;
    bf16x8 Wa[4], Wx[4];
#pragma unroll
    for (int ks = 0; ks < 4; ++ks) { Wa[ks] = __builtin_bit_cast(bf16x8, *(const GAS v4u*)(GaT + dd * 128 + 32 * ks + 8 * G)); Wx[ks] = __builtin_bit_cast(bf16x8, *(const GAS v4u*)(GxT + dd * 128 + 32 * ks + 8 * G)); }
    const float bav = ba[ch], bxv = bx[ch], lv = lam[ch]; const float sp8 = 8.0f * __logf(1.0f + __expf(-lv));
    __syncthreads();
    float Arun = 1.f, Hrun = 0.f;
    const int xoff = ((dd >> 3) << 4), xlo = (dd & 7) * 2;
#pragma unroll 2
    for (int tt8 = 0; tt8 < 8; ++tt8) {
        f32x4 aA = (f32x4){0.f, 0.f, 0.f, 0.f}, aX = (f32x4){0.f, 0.f, 0.f, 0.f};
#pragma unroll
        for (int ks = 0; ks < 4; ++ks) { const bf16x8 Xf = *(const LAS bf16x8*)(lxc + (16 * tt8 + q) * 256 + (((4 * ks + G) ^ q) << 4));
            aA = __builtin_amdgcn_mfma_f32_16x16x32_bf16(Xf, Wa[ks], aA, 0, 0, 0); aX = __builtin_amdgcn_mfma_f32_16x16x32_bf16(Xf, Wx[ks], aX, 0, 0, 0); }
        float Ac[4], Hc[4]; float Ar = 1.f, Hr = 0.f;
#pragma unroll
        for (int e = 0; e < 4; ++e) { const int tt = 16 * tt8 + 4 * G + e;
            const float xcv = bf1(*(const LAS bf16*)(lxc + tt * 256 + (xoff ^ ((tt & 15) << 4)) + xlo));
            const float rg = sigmoid_fast(aA[e] + bav), ig = sigmoid_fast(aX[e] + bxv), la = -sp8 * rg, a = __builtin_amdgcn_exp2f(LOG2E * la);
            const float y = 2.0f * la; float pl = 1.0f / 120.0f; pl = pl * y + (1.0f / 24.0f); pl = pl * y + (1.0f / 6.0f); pl = pl * y + 0.5f; pl = pl * y + 1.0f;
            const float u = __builtin_amdgcn_sqrtf(-y * pl) * (ig * xcv);
            Hr = a * Hr + u; Ar = a * Ar; Ac[e] = Ar; Hc[e] = Hr; }
        float Ai = Ar, Hi = Hr;
        { const float Ap = __shfl_up(Ai, 16), Hp = __shfl_up(Hi, 16); if (G >= 1) { Hi = Ai * Hp + Hi; Ai = Ai * Ap; } }
        { const float Ap = __shfl_up(Ai, 32), Hp = __shfl_up(Hi, 32); if (G >= 2) { Hi = Ai * Hp + Hi; Ai = Ai * Ap; } }
        float Ae = __shfl_up(Ai, 16), He = __shfl_up(Hi, 16); if (G == 0) { Ae = 1.f; He = 0.f; }
        const float At = __shfl(Ai, 48 + q), Ht = __shfl(Hi, 48 + q);
        const float Ap0 = Ae * Arun, Hp0 = Ae * Hrun + He;
#pragma unroll
        for (int e = 0; e < 4; ++e) { const int tt = 16 * tt8 + 4 * G + e;
            const float Pv = Ac[e] * Ap0, hl = Hc[e] + Ac[e] * Hp0;
            const int so = tt * 256 + (xoff ^ ((tt & 15) << 4)) + xlo;
            const float gg = gelu_tanh(bf1(*(const LAS bf16*)(lgt + so)));
            *(LAS bf16*)(ly0 + so) = f2bf(hl * gg); *(LAS bf16*)(ly1 + so) = f2bf(Pv * gg); }
        Hrun = At * Hrun + Ht; Arun = At * Arun;
    }
    if (G == 0) { Aend[(size_t)(b * 32 + chunk) * 512 + ch] = Arun; Hend[(size_t)(b * 32 + chunk) * 512 + ch] = Hrun; }
    __syncthreads();
    {
        const int c8 = tid & 15;
#pragma unroll
        for (int i = 0; i < 4; ++i) { const int tt = (tid >> 4) + 32 * i; const int so = tt * 256 + ((c8 ^ (tt & 15)) << 4); const size_t off = (rowb + t0 + tt) * 512 + 128 * g + 8 * c8;
            *(GAS v4u*)(Y0 + off) = *(const LAS v4u*)(ly0 + so); *(GAS v4u*)(Y1 + off) = *(const LAS v4u*)(ly1 + so); }
    }
    __syncthreads();
}

__device__ __forceinline__ void post_unit(LAS unsigned char* lds, const bf16* num, const float* den, const bf16* Y0, const bf16* Y1, const float* Aend, const float* Hend, bf16* aout, int uid, int tid) {
    asm volatile("" : "+v"(tid));
    const int row0 = uid * 64, b = row0 >> 12, chunk = (row0 & 4095) >> 7;
    LAS float* hin = (LAS float*)lds;
    { float H = 0.f; const float* ae = Aend + (size_t)(b * 32) * 512 + tid; const float* he = Hend + (size_t)(b * 32) * 512 + tid;
      for (int s = 0; s < chunk; ++s) H = ae[(size_t)s * 512] * H + he[(size_t)s * 512];
      hin[tid] = H; }
    __syncthreads();
    const int c8 = tid & 63, rsub = tid >> 6;
    float hv[8];
#pragma unroll
    for (int e = 0; e < 8; ++e) hv[e] = hin[8 * c8 + e];
#pragma unroll
    for (int i = 0; i < 8; ++i) { const size_t row = row0 + rsub + 8 * i;
        {
            const v4u a = *(const GAS v4u*)(Y0 + row * 512 + 8 * c8), p = *(const GAS v4u*)(Y1 + row * 512 + 8 * c8); v4u o;
            o.x = pk2(bflo(a.x) + bflo(p.x) * hv[0], bfhi(a.x) + bfhi(p.x) * hv[1]); o.y = pk2(bflo(a.y) + bflo(p.y) * hv[2], bfhi(a.y) + bfhi(p.y) * hv[3]);
            o.z = pk2(bflo(a.z) + bflo(p.z) * hv[4], bfhi(a.z) + bfhi(p.z) * hv[5]); o.w = pk2(bflo(a.w) + bflo(p.w) * hv[6], bfhi(a.w) + bfhi(p.w) * hv[7]);
            *(GAS v4u*)(aout + row * 1024 + 512 + 8 * c8) = o; }
        {
            const int h = c8 >> 4;
            const float dn = den[((size_t)0 * T + row) * 4 + h] + den[((size_t)1 * T + row) * 4 + h] + den[((size_t)2 * T + row) * 4 + h]; const float inv = 1.0f / dn;
            const v4u a = *(const GAS v4u*)(num + ((size_t)0 * T + row) * 512 + 8 * c8), bq = *(const GAS v4u*)(num + ((size_t)1 * T + row) * 512 + 8 * c8), c = *(const GAS v4u*)(num + ((size_t)2 * T + row) * 512 + 8 * c8); v4u o;
            o.x = pk2((bflo(a.x) + bflo(bq.x) + bflo(c.x)) * inv, (bfhi(a.x) + bfhi(bq.x) + bfhi(c.x)) * inv); o.y = pk2((bflo(a.y) + bflo(bq.y) + bflo(c.y)) * inv, (bfhi(a.y) + bfhi(bq.y) + bfhi(c.y)) * inv);
            o.z = pk2((bflo(a.z) + bflo(bq.z) + bflo(c.z)) * inv, (bfhi(a.z) + bfhi(bq.z) + bfhi(c.z)) * inv); o.w = pk2((bflo(a.w) + bflo(bq.w) + bflo(c.w)) * inv, (bfhi(a.w) + bfhi(bq.w) + bfhi(c.w)) * inv);
            *(GAS v4u*)(aout + row * 1024 + 8 * c8) = o; }
    }
    __syncthreads();
}

__device__ __forceinline__ void poolprep_unit(LAS unsigned char* lds, const float* x, const float* ss, bf16* dd, int uid, int tid) {
    asm volatile("" : "+v"(tid));
    const int row0 = uid * 64, tb = row0 & 4095;
    LAS float* rs = (LAS float*)lds;
    if (tid < 79) { const int t = tb - 15 + tid; float r = 0.f;
        if (t >= 0) { const float* p = ss + (size_t)(row0 - 15 + tid) * 16; float s = 0.f;
#pragma unroll
            for (int e = 0; e < 16; ++e) s += p[e];
            r = 1.0f / sqrtf(s * (1.0f / 1024.0f) + EPS); }
        rs[tid] = r; }
    __syncthreads();
    const int c4 = tid & 255, half = tid >> 8, c = 4 * c4, wlen = 2 << (c >> 8);
    const int ts = tb + 32 * half;
    f32x4 sum = (f32x4){0.f, 0.f, 0.f, 0.f};
    for (int i = 1; i < wlen; ++i) { const int t = ts - i; if (t >= 0) sum += *(const GAS f32x4*)(x + (size_t)(row0 + 32 * half - i) * 1024 + c) * rs[15 + 32 * half - i]; }
    for (int k = 0; k < 32; ++k) { const int t = ts + k; const size_t row = (size_t)row0 + 32 * half + k;
        const f32x4 hcur = *(const GAS f32x4*)(x + row * 1024 + c) * rs[15 + 32 * half + k];
        sum += hcur;
        const int cnt = (t + 1 < wlen) ? t + 1 : wlen; const float inv = 1.0f / (float)cnt;
        const f32x4 dv = sum * inv - hcur;
        v2u o; o.x = pk2(dv[0], dv[1]); o.y = pk2(dv[2], dv[3]); *(GAS v2u*)(dd + row * 1024 + c) = o;
        const int told = t - wlen + 1;
        if (told >= 0) sum -= *(const GAS f32x4*)(x + (row - wlen + 1) * 1024 + c) * rs[15 + 32 * half + k - wlen + 1]; }
    __syncthreads();
}

#ifndef MK_TEST
constexpr int N_PHASES = 41;
__global__ void __launch_bounds__(NWAVES * 64, 2) mk_fwd(Args args) {
    extern __shared__ __attribute__((aligned(16))) unsigned char lds_raw[];
    LAS unsigned char* lds = (LAS unsigned char*)lds_raw;
    volatile LAS unsigned* MISC = (volatile LAS unsigned*)(lds + MISC_OFF);
#define ws ld_ws(args)
    const int tid = threadIdx.x, wave = __builtin_amdgcn_readfirstlane(tid >> 6);
    const int G = gridDim.x, bid = blockIdx.x;
    const int vcu = (G % 8 == 0) ? (bid % 8) * (G / 8) + bid / 8 : bid;
    const int gw = vcu * NWAVES + wave, NGW = G * NWAVES;
    for (int u = tid; u < (LDS_BYTES - LDSCTL_OFF) / 4; u += NWAVES * 64) ((LAS unsigned*)(lds + LDSCTL_OFF))[u] = 0u;
    __syncthreads();
    unsigned* ctl = (unsigned*)(ws + WS_CTL);
    XcdBarrier bar; bar.bar = ctl + 1024; bar.x = 0; bar.st = nullptr;
    if (MK_N_LAUNCHES == 1) bar = xcd_barrier_post(ctl + 1024, MISC + 8);
#if MK_N_LAUNCHES != 1
    const int lo = args.ph_lo, hi = args.ph_hi;
#endif
#if MK_N_LAUNCHES == 1
#define IN(k) true
#else
#define IN(k) (lo <= (k) && (k) < hi)
#endif
#define SEAM(k) do { if (MK_N_LAUNCHES == 1 && (k) + 1 < N_PHASES) { for (int b_ = 0; b_ < REP_BAR; ++b_) xcd_barrier(bar); } } while (0)
#define ZEROS ((const float*)(ws + WS_CTL + 32768))

#define SS ((float*)(ws + WS_SS))
#define QSS ((float*)(ws + WS_QSS))
#define LSUM ((float*)(ws + WS_LSUM))
#define DEN ((float*)(ws + WS_DEN))
#define AEND ((float*)(ws + WS_AEND))
#define HEND ((float*)(ws + WS_HEND))
#define XB ((bf16*)(ws + WS_XB))
#define PROJ ((bf16*)(ws + WS_PROJ))
#define NUM ((bf16*)(ws + WS_NUM))
#define AOUT ((bf16*)(ws + WS_AOUT))
#define QB ((bf16*)(ws + WS_Q))
#define PB ((bf16*)(ws + WS_P))
#define OB ((bf16*)(ws + WS_O))
#define HID ((bf16*)(ws + WS_HID))
#define Y0 ((bf16*)(ws + WS_Y0))
#define Y1 ((bf16*)(ws + WS_Y1))
#define KVRAW ((bf16*)((unsigned char*)OUTP() + DO_KVRAW))
#define MEMN ((bf16*)((unsigned char*)OUTP() + DO_MEMN))
#ifndef NO_PRO
    if (IN(0)) { REPEAT(REP_P0) { p0_prologue(args, lds, gw, NGW, wave); REP_SEAM(REP_P0); } SEAM(0); }
#endif

    for (int l = 0; l < 4; ++l) {
        const int pb = 1 + 10 * l;
        const float* xin = (l == 0) ? INP(0) : OUTP();
        if ((l & 1) == 0) {
            const int e = l >> 1;
            if (IN(pb + 0)) { REPEAT(REP_A1) {
                { pg8::Gemm g{XB, (const bf16*)(ws + WS_WIN) + (size_t)e * INC * D, D, D, D, ~0, 0, (long)256 * D, 30, 0};
                  pg8::StaticOrder S; S.init(T / 256, INC / 256, G, bid);
                  pg8::EpiBf16<1> E{PROJ, INC, SS, nullptr};
                  pg8::gemm_phase(lds, g, S, E); }
                if (l == 0) { pg8::Gemm g{MEMN, (const bf16*)(ws + WS_WKV), D, D, D, 3, 0, (long)256 * D, 2, (long)2048 * D};
                  pg8::StaticOrder S; S.init(16, 8, G - 128, bid >= 128 ? bid - 128 : (1 << 20));
                  pg8::EpiBf16<0> E{KVRAW, 2048, nullptr, nullptr};
                  pg8::gemm_phase(lds, g, S, E); }
                REP_SEAM(REP_A1); }
                SEAM(pb + 0); }
            if (IN(pb + 1)) { REPEAT(REP_A2) {
#ifndef NO_KVF
                if (l == 0) for (int r2_ = 0; r2_ < REP_KVF; ++r2_) kv_finalize(args, gw, NGW);
#endif
#ifndef NO_ATTN
                for (int r2_ = 0; r2_ < REP_ATTN; ++r2_) {
                    for (int sgi = 0; sgi < 2; ++sgi) {
                        int g_, bh_, r_, n0_, L_;
                        if (sgi == 1) { g_ = 2; bh_ = bid >> 4; r_ = bid & 15; n0_ = 0; L_ = 2; }
                        else if (bid < 128) { g_ = 0; bh_ = bid >> 3; r_ = 0; n0_ = 4 * (bid & 7); L_ = 4; }
                        else { const int id = bid - 128, chain = id >> 1; g_ = 1; bh_ = chain >> 2; r_ = chain & 3; n0_ = 4 * (id & 1); L_ = 4; }
#ifdef ATT_L1
                        for (int nn = n0_; nn < n0_ + L_; ++nn) attn_segment(lds, PROJ, INP(7) + e * 128, INP(8) + e * 128, NUM, DEN, g_, bh_, r_, nn, 1, tid);
#else
                        attn_segment(lds, PROJ, INP(7) + e * 128, INP(8) + e * 128, NUM, DEN, g_, bh_, r_, n0_, L_, tid);
#endif
                    }
                }
#endif
#ifndef NO_R1
                for (int u = bid; u < 512; u += G) for (int r2_ = 0; r2_ < REP_R1; ++r2_)
                    r1_unit(lds, PROJ, INP(9) + e * 2048, INP(10) + e * 512, (const bf16*)(ws + WS_GT) + (size_t)((e * 2 + 0) * 4 + (u & 3)) * 16384, (const bf16*)(ws + WS_GT) + (size_t)((e * 2 + 1) * 4 + (u & 3)) * 16384,
                            INP(12) + e * 512, INP(14) + e * 512, INP(15) + e * 512, Y0, Y1, AEND, HEND, u, tid);
#endif
                REP_SEAM(REP_A2); }
                SEAM(pb + 1); }
            if (IN(pb + 2)) { REPEAT(REP_A3) {
#ifndef NO_POST
                for (int u = bid; u < 256; u += G) post_unit(lds, NUM, DEN, Y0, Y1, AEND, HEND, AOUT, u, tid);
#endif
                REP_SEAM(REP_A3); }
                SEAM(pb + 2); }
            if (IN(pb + 3)) { REPEAT(REP_A4) {
                pg8::Gemm g{AOUT, (const bf16*)(ws + WS_WOUT) + (size_t)e * D * D, D, D, D, ~0, 0, (long)256 * D, 30, 0};
                pg8::StaticOrder S; S.init(T / 256, 4, G, bid);
                pg8::EpiRes E{rep_ ? OUTP() : xin, OUTP(), XB, SS, rep_ ? ZEROS : nullptr};
                pg8::gemm_phase(lds, g, S, E);
                REP_SEAM(REP_A4); }
                SEAM(pb + 3); }
        } else {
            const int o = l >> 1;
            if (IN(pb + 0)) { REPEAT(REP_B1) {
#ifndef NO_POOL
                for (int u = bid; u < 256; u += G) poolprep_unit(lds, OUTP(), SS, AOUT, u, tid);
#endif
                REP_SEAM(REP_B1); }
                SEAM(pb + 0); }
            if (IN(pb + 1)) { REPEAT(REP_B2) {
                pg8::Gemm g{AOUT, (const bf16*)(ws + WS_POOLT) + (size_t)o * 4 * 65536, D, 256, 256, ~0, 256, (long)65536, 30, 0};
                pg8::StaticOrder S; S.init(T / 256, 4, G, bid);
                pg8::EpiRes E{OUTP(), OUTP(), XB, SS, rep_ ? ZEROS : INP(18) + o * D};
                pg8::gemm_phase(lds, g, S, E);
                REP_SEAM(REP_B2); }
                SEAM(pb + 3); }
        }
        if (IN(pb + 4)) { REPEAT(REP_X1) {
            pg8::Gemm g{XB, (const bf16*)(ws + WS_WQ) + (size_t)l * D * D, D, D, D, ~0, 0, (long)256 * D, 30, 0};
            pg8::StaticOrder S; S.init(T / 256, 4, G, bid);
            pg8::EpiBf16<3> E{QB, D, SS, QSS};
            pg8::gemm_phase(lds, g, S, E);
            REP_SEAM(REP_X1); }
            SEAM(pb + 4); }
        if (IN(pb + 5)) { REPEAT(REP_X2) {
            pg8::Gemm g{QB, (const bf16*)(ws + WS_KN) + (size_t)l * 16 * 65536, D, 256, 256, ~0, 256, (long)65536, 4, (long)4 * 65536};
            pg8::StaticOrder S; S.init(T / 256, 4, G, bid);
            pg8::EpiBf16<4> E{PB, D, QSS, LSUM};
            pg8::gemm_phase(lds, g, S, E);
            REP_SEAM(REP_X2); }
            SEAM(pb + 5); }
        if (IN(pb + 6)) { REPEAT(REP_X3) {
            pg8::Gemm g{PB, (const bf16*)(ws + WS_VT) + (size_t)l * 16 * 65536, D, 256, 256, ~0, 256, (long)65536, 4, (long)4 * 65536};
            pg8::StaticOrder S; S.init(T / 256, 4, G, bid);
            pg8::EpiBf16<5> E{OB, D, LSUM, nullptr};
            pg8::gemm_phase(lds, g, S, E);
            REP_SEAM(REP_X3); }
            SEAM(pb + 6); }
        if (IN(pb + 7)) { REPEAT(REP_X4) {
            pg8::Gemm g{OB, (const bf16*)(ws + WS_WO) + (size_t)l * D * D, D, D, D, ~0, 0, (long)256 * D, 30, 0};
            pg8::StaticOrder S; S.init(T / 256, 4, G, bid);
            pg8::EpiRes E{OUTP(), OUTP(), XB, SS, rep_ ? ZEROS : nullptr};
            pg8::gemm_phase(lds, g, S, E);
            REP_SEAM(REP_X4); }
            SEAM(pb + 7); }
        if (IN(pb + 8)) { REPEAT(REP_M1) {
            pg8::Gemm g{XB, (const bf16*)(ws + WS_W1) + (size_t)l * FF * D, D, D, D, ~0, 0, (long)256 * D, 30, 0};
            pg8::StaticOrder S; S.init(T / 256, FF / 256, G, bid);
            pg8::EpiBf16<2> E{HID, FF, SS, nullptr};
            pg8::gemm_phase(lds, g, S, E);
            REP_SEAM(REP_M1); }
            SEAM(pb + 8); }
        if (IN(pb + 9)) { REPEAT(REP_M2) {
            pg8::Gemm g{HID, (const bf16*)(ws + WS_W2) + (size_t)l * D * FF, FF, FF, FF, ~0, 0, (long)256 * FF, 30, 0};
            pg8::StaticOrder S; S.init(T / 256, 4, G, bid);
            pg8::EpiRes E{OUTP(), OUTP(), XB, SS, rep_ ? ZEROS : nullptr};
            pg8::gemm_phase(lds, g, S, E);
            REP_SEAM(REP_M2); }
            SEAM(pb + 9); }
    }
#undef IN
#undef SEAM
#undef ws
}

extern "C" void kernel_launch(void* const* d_in, const int* in_sizes, int n_in, void* d_out, int out_size, void* d_ws, size_t ws_size, hipStream_t stream) {
    static int grid = 0;
    if (grid == 0) {
        if (n_in != 26 || in_sizes[0] != T * D || out_size != T * D || ws_size < WS_END) { fprintf(stderr, "kernel_launch: unexpected shapes: n_in %d in0 %d out %d ws %zu (need %zu); nothing launched\n", n_in, n_in > 0 ? in_sizes[0] : -1, out_size, ws_size, (size_t)WS_END); grid = -1; return; }
        int dev = 0, cus = 0, per_cu = 0;
        if (hipGetDevice(&dev) != hipSuccess || hipDeviceGetAttribute(&cus, hipDeviceAttributeMultiprocessorCount, dev) != hipSuccess) { grid = -1; return; }
        if (hipFuncSetAttribute((const void*)mk_fwd, hipFuncAttributeMaxDynamicSharedMemorySize, LDS_BYTES) != hipSuccess) { fprintf(stderr, "kernel_launch: hipFuncSetAttribute failed\n"); grid = -1; return; }
        if (hipOccupancyMaxActiveBlocksPerMultiprocessor(&per_cu, (const void*)mk_fwd, NWAVES * 64, LDS_BYTES) != hipSuccess || per_cu < 1) fprintf(stderr, "kernel_launch: occupancy query reports %d\n", per_cu);
        (void)hipGetLastError();
        grid = cus;
        if (grid != 256) fprintf(stderr, "kernel_launch: %d CUs (built for 256)\n", grid);
    }
    if (grid < 0) return;
    (void)hipMemsetAsync((char*)d_ws + WS_CTL, 0, CTL_ZERO_BYTES, stream);
    Args a{};
    for (int i = 0; i < 26; ++i) a.p.in[i] = (const float*)d_in[i];
    a.p.out = (float*)d_out; a.p.ws = (unsigned char*)d_ws;
    if (MK_N_LAUNCHES == 1) { a.ph_lo = 0; a.ph_hi = N_PHASES; hipLaunchKernelGGL(mk_fwd, dim3(grid), dim3(NWAVES * 64), LDS_BYTES, stream, a); }
    else {
        for (int k = 0; k < N_PHASES; ++k) {
            const int l = (k - 1) / 10, s = (k - 1) % 10;
            if (k > 0 && (l & 1) == 1 && (s == 2 || s == 3)) continue;
            a.ph_lo = k; a.ph_hi = k + 1; hipLaunchKernelGGL(mk_fwd, dim3(grid), dim3(NWAVES * 64), LDS_BYTES, stream, a);
        }
    }
}
#endif
```

```cpp
#include <hip/hip_runtime.h>
#include <cstdio>
#include <cstdint>

#ifdef P0_NT_STORE
#define P0_NTS(set) ((set) >= (2 - P0_NT_STORE))
#else
#define P0_NTS(set) false
#endif
#ifndef NO_STREAM_NT
#define ATT_NT_STORE 1
#define POST_NT 1
#endif
#ifndef P0_NO_NT
#define P0_NT 1
#endif

#ifndef ATT_PREFETCH
#define ATT_NOPF 1
#ifndef ATT_NO_PF_MID
#define ATT_PF_MID 1
#endif
#endif
#ifndef MK_N_LAUNCHES
#define MK_N_LAUNCHES 1
#endif

#ifndef REP_P0
#define REP_P0 1
#endif
#ifndef REP_A1
#define REP_A1 1
#endif
#ifndef REP_A2
#define REP_A2 1
#endif
#ifndef REP_A3
#define REP_A3 1
#endif
#ifndef REP_A4
#define REP_A4 1
#endif
#ifndef REP_B1
#define REP_B1 1
#endif
#ifndef REP_B2
#define REP_B2 1
#endif
#ifndef REP_X1
#define REP_X1 1
#endif
#ifndef REP_X2
#define REP_X2 1
#endif
#ifndef REP_X3
#define REP_X3 1
#endif
#ifndef REP_X4
#define REP_X4 1
#endif
#ifndef REP_M1
#define REP_M1 1
#endif
#ifndef REP_M2
#define REP_M2 1
#endif
#ifndef REP_BAR
#define REP_BAR 1
#endif
#ifndef REP_ATTN
#define REP_ATTN 1
#endif
#ifndef REP_R1
#define REP_R1 1
#endif
#ifndef REP_KVF
#define REP_KVF 1
#endif
#define REPEAT(n) for (int rep_ = 0; rep_ < (n); ++rep_)
#define REP_SEAM(n) do { if (rep_ + 1 < (n)) xcd_barrier(bar); } while (0)
namespace pg8 {
#define PG8_LAS __attribute__((address_space(3)))
typedef unsigned short bf16_t;
typedef short bf16x8 __attribute__((ext_vector_type(8)));
typedef float f32x4 __attribute__((ext_vector_type(4)));
typedef float f32x2 __attribute__((ext_vector_type(2)));
typedef unsigned u32x4 __attribute__((ext_vector_type(4)));
typedef unsigned u32x2 __attribute__((ext_vector_type(2)));
#ifdef PG8_COLS_SPLIT
constexpr int WCS = 32, BJS = 128;
#else
constexpr int WCS = 64, BJS = 32;
#endif
constexpr int BM = 256, BK = 64, HALF = 128, HTB = HALF * BK * 2, STAGE_BYTES = 8 * HTB, NXCD = 8, WGM = 8;

__host__ __device__ __forceinline__ int lds_byte(int r, int c) { const int st = (r >> 4) * 2 + (c >> 5), rr = r & 15, cc = c & 31, ob = rr * 64 + cc * 2; return st * 1024 + (ob ^ (((ob >> 9) & 1) << 5)); }
__host__ __device__ __forceinline__ void stage_rc(int b, int& R, int& C) { const int st = b / 1024, sb = b % 1024, swz = sb ^ (((sb >> 9) & 1) << 5); R = (st >> 1) * 16 + swz / 64; C = (st & 1) * 32 + (swz % 64) / 2; }
__host__ __device__ __forceinline__ int perm32(int rho) { const int n = rho >> 4, i = rho & 15; return 8 * (i >> 2) + 4 * n + (i & 3); }

struct Unit { int pm, pn; };
struct Gemm { const bf16_t* A; const bf16_t* Bt; int lda, ldb, K; int a_pm_mask, a_pn_cols; long b_pn_elems; int b_pm_shift; long b_batch_elems; long a_kstep = BK; long a_pm_elems = 0  ; };

struct StaticOrder {
    int nM, nN, nwg, G, c;
    __host__ __device__ __forceinline__ void init(int nM_, int nN_, int G_, int c_) { nM = nM_; nN = nN_; nwg = nM * nN; G = G_; c = c_; }
    __host__ __device__ __forceinline__ bool next(int i, Unit& u) const {
        const long L = (long)i * G + c; if (L >= nwg) return false;
        int wgid = (int)L; { const int q = nwg / NXCD, r = nwg % NXCD, xcd = wgid % NXCD, off = wgid / NXCD; wgid = (xcd < r ? xcd * (q + 1) : r * (q + 1) + (xcd - r) * q) + off; }
        const int nig = WGM * nN, gid = wgid / nig, fm = gid * WGM, gsz = (nM - fm) < WGM ? (nM - fm) : WGM;
        u.pm = fm + ((wgid % nig) % gsz); u.pn = (wgid % nig) / gsz; return true;
    }
};

struct XcdOrder {
    int nMx, nN, J, x, j;
    __host__ __device__ __forceinline__ void init(int nM, int nN_, int G, int c) { nMx = nM / 8; nN = nN_; J = G / 8; x = c & 7; j = c >> 3; }
    __host__ __device__ __forceinline__ bool next(int i, Unit& u) const {
#ifdef XCD_ORDER_KEEPROW
        if (nMx == 2 && J == 8 && (nN & 3) == 0) { if (4 * i >= nN) return false; u.pm = x * 2 + ((j >> 2) & 1); u.pn = (j & 3) + 4 * i; return true; }
#endif
        const int q = j + J * i; if (q >= nMx * nN) return false; u.pm = x * nMx + q / nN; u.pn = q % nN; return true; }
};

__device__ __forceinline__ unsigned cvt_pk_bf16(float lo, float hi) { unsigned r; asm volatile("v_cvt_pk_bf16_f32 %0, %1, %2" : "=v"(r) : "v"(lo), "v"(hi)); return r; }

constexpr float EPS = 1e-6f;
template <int MODE, bool SLAB = false> struct EpiBf16 {
    static constexpr bool PERM = true;
    bf16_t* O; int ldc; const float* aux_in; float* aux_out;
    mutable int cpm = -1; mutable float cf[8] = {0.f, 0.f, 0.f, 0.f, 0.f, 0.f, 0.f, 0.f};
    __device__ __forceinline__ void operator()(const f32x4 (&acc)[2][2][4][2], const Unit& u, int wr, int wc, int fr, int fq) const {
        const int row0 = u.pm * BM + wr * 64 + fr, col0 = u.pn * BM + wc * WCS + 8 * fq;
        if ((MODE == 1 || MODE == 2) && u.pm != cpm) {
            f32x4 v[8];
#pragma unroll
            for (int i = 0; i < 8; ++i) v[i] = *(const f32x4*)(aux_in + (size_t)(row0 + (i >> 2) * HALF + (i & 3) * 16) * 16 + fq * 4);
#pragma unroll
            for (int i = 0; i < 8; ++i) { float s = (v[i][0] + v[i][1]) + (v[i][2] + v[i][3]); s += __shfl_xor(s, 16); s += __shfl_xor(s, 32); cf[i] = __builtin_amdgcn_rsqf(s * (1.0f / 1024.0f) + EPS); }
            cpm = u.pm; }
#pragma unroll
        for (int ai = 0; ai < 2; ++ai)
#pragma unroll
            for (int m = 0; m < 4; ++m) {
                const int row = row0 + ai * HALF + m * 16; float f = 1.f;
                if (MODE == 1 || MODE == 2) f = cf[ai * 4 + m];
                if (MODE == 3) { const f32x4 v = *(const f32x4*)(aux_in + (size_t)row * 16 + fq * 4); float s = (v[0] + v[1]) + (v[2] + v[3]); s += __shfl_xor(s, 16); s += __shfl_xor(s, 32); f = __builtin_amdgcn_rsqf(s * (1.0f / 1024.0f) + EPS); }
                if (MODE == 4) { const f32x4 v = *(const f32x4*)(aux_in + (size_t)row * 16 + u.pn * 4); const float s = (v[0] + v[1]) + (v[2] + v[3]); f = __builtin_amdgcn_rsqf(s * (1.0f / 256.0f) + EPS); }
                if (MODE == 5) { const f32x4 v = *(const f32x4*)(aux_in + (size_t)row * 16 + u.pn * 4); const float s = (v[0] + v[1]) + (v[2] + v[3]); f = 1.0f / s; }
                bf16_t* rowp = SLAB ? O + ((size_t)(u.pm * (ldc >> 6) + u.pn * 4 + wc) * 256 + (row & 255)) * 64 + 8 * fq : O + (size_t)row * ldc + col0; float part = 0.f;
#pragma unroll
                for (int bj = 0; bj < 2; ++bj) { f32x4 v0 = acc[ai][bj][m][0] * f, v1 = acc[ai][bj][m][1] * f;
                    if (MODE == 2) {
#pragma unroll
                        for (int e = 0; e < 4; ++e) { const float a = v0[e] > 0.f ? v0[e] : 0.f, b = v1[e] > 0.f ? v1[e] : 0.f; v0[e] = a * a; v1[e] = b * b; } }
                    if (MODE == 4) {
#pragma unroll
                        for (int e = 0; e < 4; ++e) { v0[e] = __builtin_amdgcn_exp2f(v0[e]); v1[e] = __builtin_amdgcn_exp2f(v1[e]); } }
                    if (MODE == 3) part += (v0[0] * v0[0] + v0[1] * v0[1]) + (v0[2] * v0[2] + v0[3] * v0[3]) + (v1[0] * v1[0] + v1[1] * v1[1]) + (v1[2] * v1[2] + v1[3] * v1[3]);
                    if (MODE == 4) part += (v0[0] + v0[1]) + (v0[2] + v0[3]) + (v1[0] + v1[1]) + (v1[2] + v1[3]);
                    u32x4 w; w.x = cvt_pk_bf16(v0[0], v0[1]); w.y = cvt_pk_bf16(v0[2], v0[3]); w.z = cvt_pk_bf16(v1[0], v1[1]); w.w = cvt_pk_bf16(v1[2], v1[3]);
                    *(u32x4*)(rowp + bj * BJS) = w; }
                if (MODE == 3 || MODE == 4) { part += __shfl_xor(part, 16); part += __shfl_xor(part, 32); if (fq == 0) aux_out[(size_t)row * 16 + u.pn * 4 + wc] = part; }
            }
    }
};
struct EpiRes {
    static constexpr bool PERM = true;
    float* out32; bf16_t* xb; float* ss; const float* scale;
    __device__ __forceinline__ void operator()(const f32x4 (&acc)[2][2][4][2], const Unit& u, int wr, int wc, int fr, int fq) const {
        const int row0 = u.pm * BM + wr * 64 + fr, col0 = u.pn * BM + wc * WCS + 8 * fq;
#pragma unroll
        for (int ai = 0; ai < 2; ++ai) {
            u32x4 xw[4][2];
#pragma unroll
            for (int m = 0; m < 4; ++m)
#pragma unroll
                for (int bj = 0; bj < 2; ++bj) xw[m][bj] = *(const u32x4*)(xb + (size_t)(row0 + ai * HALF + m * 16) * 1024 + col0 + bj * BJS);
#pragma unroll
            for (int m = 0; m < 4; ++m) {
                const int row = row0 + ai * HALF + m * 16; const size_t off = (size_t)row * 1024 + col0; float sq = 0.f;
#pragma unroll
                for (int bj = 0; bj < 2; ++bj) { const int co = bj * BJS; f32x4 a0 = acc[ai][bj][m][0], a1 = acc[ai][bj][m][1];
                    if (scale) { a0 = a0 * *(const f32x4*)(scale + col0 + co); a1 = a1 * *(const f32x4*)(scale + col0 + co + 4); }
                    const u32x4 w = xw[m][bj];
                    f32x4 x0 = (f32x4){__uint_as_float(w.x << 16), __uint_as_float(w.x & 0xffff0000u), __uint_as_float(w.y << 16), __uint_as_float(w.y & 0xffff0000u)};
                    f32x4 x1 = (f32x4){__uint_as_float(w.z << 16), __uint_as_float(w.z & 0xffff0000u), __uint_as_float(w.w << 16), __uint_as_float(w.w & 0xffff0000u)};
                    x0 = x0 + a0; x1 = x1 + a1;
                    if (out32) { *(f32x4*)(out32 + off + co) = x0; *(f32x4*)(out32 + off + co + 4) = x1; }
                    else { sq += ((x0[0] * x0[0] + x0[1] * x0[1]) + (x0[2] * x0[2] + x0[3] * x0[3])) + ((x1[0] * x1[0] + x1[1] * x1[1]) + (x1[2] * x1[2] + x1[3] * x1[3]));
                           u32x4 o; o.x = cvt_pk_bf16(x0[0], x0[1]); o.y = cvt_pk_bf16(x0[2], x0[3]); o.z = cvt_pk_bf16(x1[0], x1[1]); o.w = cvt_pk_bf16(x1[2], x1[3]); *(u32x4*)(xb + off + co) = o; } }
                if (!out32) { sq += __shfl_xor(sq, 16); sq += __shfl_xor(sq, 32); if (fq == 0) ss[(size_t)row * 16 + u.pn * 4 + wc] = sq; }
            }
            asm volatile("" ::: "memory");
        }
    }
};

template <class Epi, class Sched>
__device__ __forceinline__ void gemm_phase(PG8_LAS unsigned char* lds, const Gemm g, const Sched& S, const Epi& E) {
    int tid_ = threadIdx.x; asm volatile("" : "+v"(tid_));
    const int tid = tid_, wid = __builtin_amdgcn_readfirstlane(tid >> 6), lane = tid & 63, wr = wid >> 2, wc = wid & 3, fr = lane & 15, fq = lane >> 4;
    int K_ = g.K; asm volatile("" : "+s"(K_));
    const int K = K_, nt = K / BK;
    unsigned voffA[2], voffB[2];
#pragma unroll
    for (int i = 0; i < 2; ++i) { int R, C; stage_rc(tid * 16 + i * 8192, R, C); const int Rb = Epi::PERM ? ((R >> 5) * WCS + perm32(R & 31)) : R;
        voffA[i] = (unsigned)(R * g.lda + C) * 2u; voffB[i] = (unsigned)(Rb * g.ldb + C) * 2u; }
    const size_t kstep = (size_t)(BK * 2), kstepA = (size_t)g.a_kstep * 2;
    const size_t hstepA = (size_t)HALF * g.lda * 2, hstepB = (size_t)(Epi::PERM ? BJS : HALF) * g.ldb * 2;
    const unsigned ldsw = (unsigned)wid * 1024u;
    const int aoff = lds_byte(wr * 64 + fr, fq * 8), boff = lds_byte(wc * 32 + fr, fq * 8);
#define PG8_SA(b, h) (((b) * 2 + (h)) * HTB)
#define PG8_SB(b, h) ((4 + (b) * 2 + (h)) * HTB)
#define PG8_STAGE(bufoff, gbase, voff) do { _Pragma("unroll") for (int _i = 0; _i < 2; ++_i) \
        __builtin_amdgcn_global_load_lds((const unsigned*)((const char*)(gbase) + (voff)[_i]), (PG8_LAS unsigned*)(lds + (bufoff) + ldsw + _i * 8192), 16, 0, 0); } while (0)
#define PG8_LDA(dst, b, h) do { _Pragma("unroll") for (int m = 0; m < 4; ++m) _Pragma("unroll") for (int k = 0; k < 2; ++k) dst[m][k] = *(const PG8_LAS bf16x8*)(lds + PG8_SA(b, h) + aoff + m * 2048 + k * 1024); } while (0)
#define PG8_LDB(dst, b, h) do { _Pragma("unroll") for (int n = 0; n < 2; ++n) _Pragma("unroll") for (int k = 0; k < 2; ++k) dst[n][k] = *(const PG8_LAS bf16x8*)(lds + PG8_SB(b, h) + boff + n * 2048 + k * 1024); } while (0)
#ifdef PG8_NO_SETPRIO
#define PG8_SETPRIO(x)
#else
#ifndef PG8_PRIO_HI
#define PG8_PRIO_HI 1
#endif
#ifdef PG8_PRIO_STATIC
#define PG8_SETPRIO(x)
#elif defined(PG8_PRIO_INV)
#define PG8_SETPRIO(x) __builtin_amdgcn_s_setprio((x) ? 0 : 2)
#else
#define PG8_SETPRIO(x) __builtin_amdgcn_s_setprio((x) ? PG8_PRIO_HI : 0)
#endif
#endif
#define PG8_MMA(ai, bj, At, Bt) do { PG8_SETPRIO(1); _Pragma("unroll") for (int m = 0; m < 4; ++m) _Pragma("unroll") for (int n = 0; n < 2; ++n) _Pragma("unroll") for (int k = 0; k < 2; ++k) \
        acc[ai][bj][m][n] = __builtin_amdgcn_mfma_f32_16x16x32_bf16(Bt[n][k], At[m][k], acc[ai][bj][m][n], 0, 0, 0); PG8_SETPRIO(0); } while (0)
#define PG8_MMA_ST(ai, bj, At, Bt, so0, g0, so1, g1) do { PG8_SETPRIO(1); _Pragma("unroll") for (int m = 0; m < 4; ++m) { _Pragma("unroll") for (int n = 0; n < 2; ++n) _Pragma("unroll") for (int k = 0; k < 2; ++k) \
        acc[ai][bj][m][n] = __builtin_amdgcn_mfma_f32_16x16x32_bf16(Bt[n][k], At[m][k], acc[ai][bj][m][n], 0, 0, 0); \
        if (m == 0) { PG8_SCHED; PG8_STAGE(so0, g0, voffB); PG8_SCHED; } if (m == 2) { PG8_SCHED; PG8_STAGE(so1, g1, voffB); PG8_SCHED; } } PG8_SETPRIO(0); } while (0)
#define PG8_WAIT_V(n) asm volatile("s_waitcnt vmcnt(" #n ")" ::: "memory")
#define PG8_WAIT_L(n) asm volatile("s_waitcnt lgkmcnt(" #n ")" ::: "memory")
#define PG8_BAR __builtin_amdgcn_s_barrier()
#define PG8_SCHED __builtin_amdgcn_sched_barrier(0)
#define PG8_APTR(u) ((const char*)g.A + ((size_t)((u).pm & g.a_pm_mask) * (g.a_pm_elems ? (size_t)g.a_pm_elems : (size_t)256 * g.lda) + (size_t)(u).pn * g.a_pn_cols) * 2)
#define PG8_BPTR(u) ((const char*)g.Bt + ((size_t)(u).pn * g.b_pn_elems + (size_t)((u).pm >> g.b_pm_shift) * g.b_batch_elems) * 2)
    Unit cur, nxt; int ui = 0;
    if (!S.next(0, cur)) return;
#ifdef PG8_PRIO_STATIC
    if (wid >= 4) __builtin_amdgcn_s_setprio(1);
#endif
#ifdef CLK_ACC
    unsigned long long tp0_ = wall_clock64();
#endif
    f32x4 acc[2][2][4][2];
#pragma unroll
    for (int a = 0; a < 2; ++a)
#pragma unroll
        for (int b = 0; b < 2; ++b)
#pragma unroll
            for (int m = 0; m < 4; ++m)
#pragma unroll
                for (int n = 0; n < 2; ++n) acc[a][b][m][n] = (f32x4){0.f, 0.f, 0.f, 0.f};
    bf16x8 At[4][2], B0[2][2], B1[2][2];
    const char* cA = PG8_APTR(cur); const char* cB = PG8_BPTR(cur);
#ifdef PG8_FOURPHASE
    PG8_STAGE(PG8_SB(0, 0), cB, voffB); PG8_STAGE(PG8_SA(0, 0), cA, voffA); PG8_STAGE(PG8_SB(0, 1), cB + hstepB, voffB); PG8_STAGE(PG8_SA(0, 1), cA + hstepA, voffA);
    if (wr == 1) PG8_BAR;
    PG8_WAIT_V(4); PG8_BAR;
#else
    PG8_STAGE(PG8_SB(0, 0), cB, voffB); PG8_STAGE(PG8_SB(0, 1), cB + hstepB, voffB); PG8_STAGE(PG8_SA(0, 0), cA, voffA); PG8_STAGE(PG8_SA(0, 1), cA + hstepA, voffA);
    if (wr == 1) PG8_BAR;
    PG8_WAIT_V(2); PG8_BAR;
#endif
    PG8_STAGE(PG8_SB(1, 0), cB + kstep, voffB); PG8_STAGE(PG8_SA(1, 0), cA + kstepA, voffA); PG8_STAGE(PG8_SB(1, 1), cB + hstepB + kstep, voffB);
    PG8_WAIT_V(6); PG8_BAR;
#ifdef CLK_ACC
    if (tid == 0) { PG8_LAS unsigned* mm = (PG8_LAS unsigned*)(lds + 131072 + 320) + 16; if (mm[14]) { mm[2] += (unsigned)(wall_clock64() - tp0_); mm[3] += 1u; } }
#endif
    for (;;) {
        const bool has_next = S.next(ui + 1, nxt);
        const char* nA = has_next ? PG8_APTR(nxt) : cA; const char* nB = has_next ? PG8_BPTR(nxt) : cB;
        for (int t = 0; t < nt; t += 2) {
            const bool last = (t == nt - 2);
            const char* a1 = cA + (size_t)(t + 1) * kstepA;
            const char* a2 = last ? nA : cA + (size_t)(t + 2) * kstepA; const char* b2 = last ? nB : cB + (size_t)(t + 2) * kstep;
            const char* a3 = a2 + kstepA; const char* b3 = b2 + kstep;
#ifdef PG8_FOURPHASE
            PG8_LDB(B0, 0, 0); PG8_SCHED; PG8_LDA(At, 0, 0); PG8_STAGE(PG8_SA(1, 1), a1 + hstepA, voffA);
            PG8_WAIT_L(8); PG8_BAR; PG8_WAIT_L(0); PG8_MMA(0, 0, At, B0); PG8_BAR; PG8_SCHED;
            PG8_LDB(B1, 0, 1); PG8_STAGE(PG8_SB(0, 0), b2, voffB);
            PG8_BAR; PG8_WAIT_L(0); PG8_MMA(0, 1, At, B1); PG8_BAR;
            PG8_LDA(At, 0, 1); PG8_STAGE(PG8_SA(0, 0), a2, voffA);
            PG8_BAR; PG8_WAIT_L(0); PG8_MMA(1, 0, At, B0); PG8_BAR; PG8_SCHED;
            PG8_STAGE(PG8_SB(0, 1), b2 + hstepB, voffB);
            PG8_WAIT_V(6); PG8_BAR; PG8_MMA(1, 1, At, B1); PG8_BAR;
            PG8_LDB(B0, 1, 0); PG8_SCHED; PG8_LDA(At, 1, 0); PG8_STAGE(PG8_SA(0, 1), a2 + hstepA, voffA);
            PG8_WAIT_L(8); PG8_BAR; PG8_WAIT_L(0); PG8_MMA(0, 0, At, B0); PG8_BAR; PG8_SCHED;
            PG8_LDB(B1, 1, 1); PG8_STAGE(PG8_SB(1, 0), b3, voffB);
            PG8_BAR; PG8_WAIT_L(0); PG8_MMA(0, 1, At, B1); PG8_BAR;
            PG8_LDA(At, 1, 1); PG8_STAGE(PG8_SA(1, 0), a3, voffA);
            PG8_BAR; PG8_WAIT_L(0); PG8_MMA(1, 0, At, B0); PG8_BAR; PG8_SCHED;
            PG8_STAGE(PG8_SB(1, 1), b3 + hstepB, voffB);
            PG8_WAIT_V(6); PG8_BAR; PG8_MMA(1, 1, At, B1); PG8_BAR;
#else
#ifdef PG8_STAGE_FIRST
            PG8_STAGE(PG8_SA(1, 1), a1 + hstepA, voffA); PG8_SCHED; PG8_LDB(B0, 0, 0); PG8_LDB(B1, 0, 1); PG8_SCHED; PG8_LDA(At, 0, 0);
            PG8_WAIT_V(8); PG8_WAIT_L(0); PG8_BAR; PG8_MMA(0, 0, At, B0); PG8_MMA(0, 1, At, B1); PG8_BAR; PG8_SCHED;
            PG8_STAGE(PG8_SB(0, 0), b2, voffB); PG8_STAGE(PG8_SB(0, 1), b2 + hstepB, voffB); PG8_STAGE(PG8_SA(0, 0), a2, voffA); PG8_SCHED; PG8_LDA(At, 0, 1);
            PG8_WAIT_V(8); PG8_WAIT_L(0); PG8_BAR; PG8_MMA(1, 0, At, B0); PG8_MMA(1, 1, At, B1); PG8_BAR; PG8_SCHED;
            PG8_STAGE(PG8_SA(0, 1), a2 + hstepA, voffA); PG8_SCHED; PG8_LDB(B0, 1, 0); PG8_LDB(B1, 1, 1); PG8_SCHED; PG8_LDA(At, 1, 0);
            PG8_WAIT_V(8); PG8_WAIT_L(0); PG8_BAR; PG8_MMA(0, 0, At, B0); PG8_MMA(0, 1, At, B1); PG8_BAR; PG8_SCHED;
            PG8_STAGE(PG8_SB(1, 0), b3, voffB); PG8_STAGE(PG8_SB(1, 1), b3 + hstepB, voffB); PG8_STAGE(PG8_SA(1, 0), a3, voffA); PG8_SCHED; PG8_LDA(At, 1, 1);
            PG8_WAIT_V(8); PG8_WAIT_L(0); PG8_BAR; PG8_MMA(1, 0, At, B0); PG8_MMA(1, 1, At, B1); PG8_BAR; PG8_SCHED;
#else
            PG8_LDB(B0, 0, 0); PG8_LDB(B1, 0, 1); PG8_SCHED; PG8_LDA(At, 0, 0); PG8_STAGE(PG8_SA(1, 1), a1 + hstepA, voffA);
            PG8_WAIT_V(8); PG8_WAIT_L(0); PG8_BAR; PG8_MMA(0, 0, At, B0); PG8_MMA(0, 1, At, B1); PG8_BAR; PG8_SCHED;
#ifndef PG8_NEW_SP2
            PG8_LDA(At, 0, 1); PG8_STAGE(PG8_SB(0, 0), b2, voffB); PG8_STAGE(PG8_SB(0, 1), b2 + hstepB, voffB); PG8_STAGE(PG8_SA(0, 0), a2, voffA);
            PG8_WAIT_V(8); PG8_WAIT_L(0); PG8_BAR; PG8_MMA(1, 0, At, B0); PG8_MMA(1, 1, At, B1); PG8_BAR; PG8_SCHED;
#else
            PG8_LDA(At, 0, 1); PG8_STAGE(PG8_SA(0, 0), a2, voffA);
            PG8_WAIT_V(4); PG8_WAIT_L(0); PG8_BAR; PG8_MMA_ST(1, 0, At, B0, PG8_SB(0, 0), b2, PG8_SB(0, 1), b2 + hstepB); PG8_MMA(1, 1, At, B1); PG8_BAR; PG8_SCHED;
#endif
            PG8_LDB(B0, 1, 0); PG8_LDB(B1, 1, 1); PG8_SCHED; PG8_LDA(At, 1, 0); PG8_STAGE(PG8_SA(0, 1), a2 + hstepA, voffA);
            PG8_WAIT_V(8); PG8_WAIT_L(0); PG8_BAR; PG8_MMA(0, 0, At, B0); PG8_MMA(0, 1, At, B1); PG8_BAR; PG8_SCHED;
#ifndef PG8_NEW_SP2
            PG8_LDA(At, 1, 1); PG8_STAGE(PG8_SB(1, 0), b3, voffB); PG8_STAGE(PG8_SB(1, 1), b3 + hstepB, voffB); PG8_STAGE(PG8_SA(1, 0), a3, voffA);
            PG8_WAIT_V(8); PG8_WAIT_L(0); PG8_BAR; PG8_MMA(1, 0, At, B0); PG8_MMA(1, 1, At, B1); PG8_BAR; PG8_SCHED;
#else
            PG8_LDA(At, 1, 1); PG8_STAGE(PG8_SA(1, 0), a3, voffA);
            PG8_WAIT_V(4); PG8_WAIT_L(0); PG8_BAR; PG8_MMA_ST(1, 0, At, B0, PG8_SB(1, 0), b3, PG8_SB(1, 1), b3 + hstepB); PG8_MMA(1, 1, At, B1); PG8_BAR; PG8_SCHED;
#endif
#endif
#endif
        }
        if (wr == 0) PG8_BAR;
#ifdef CLK_ACC
        unsigned long long te0_ = wall_clock64();
#endif
        E(acc, cur, wr, wc, fr, fq);
#ifdef CLK_ACC
        asm volatile("s_waitcnt vmcnt(0)" ::: "memory"); if (tid == 0) { PG8_LAS unsigned* mm = (PG8_LAS unsigned*)(lds + 131072 + 320) + 16; if (mm[14]) { mm[0] += (unsigned)(wall_clock64() - te0_); mm[1] += 1u; } }
#endif
        if (!has_next) break;
#pragma unroll
        for (int a = 0; a < 2; ++a)
#pragma unroll
            for (int b = 0; b < 2; ++b)
#pragma unroll
                for (int m = 0; m < 4; ++m)
#pragma unroll
                    for (int n = 0; n < 2; ++n) acc[a][b][m][n] = (f32x4){0.f, 0.f, 0.f, 0.f};
        cur = nxt; cA = nA; cB = nB; ++ui;
        if (wr == 1) PG8_BAR;
    }
    PG8_WAIT_V(0);
    PG8_BAR;
#ifdef PG8_PRIO_STATIC
    __builtin_amdgcn_s_setprio(0);
#endif
#ifdef CLK_ACC
    if (tid == 0) { PG8_LAS unsigned* mm = (PG8_LAS unsigned*)(lds + 131072 + 320) + 16; if (mm[14]) mm[4] += (unsigned)(wall_clock64() - tp0_); }
#endif
#undef PG8_SA
#undef PG8_SB
#undef PG8_STAGE
#undef PG8_LDA
#undef PG8_LDB
#undef PG8_MMA
#undef PG8_MMA_ST
#undef PG8_WAIT_V
#undef PG8_WAIT_L
#undef PG8_BAR
#undef PG8_SCHED
#undef PG8_APTR
#undef PG8_BPTR
}
}

constexpr int NWAVES = 8;
constexpr int D = 1024, BATCH = 4, SEQ = 4096, T = BATCH * SEQ, NMEM = 256, TM = BATCH * NMEM, FF = 4096, INC = 2560;
constexpr float EPS = 1e-6f;
constexpr float LOG2E = 1.4426950408889634f;
constexpr int NUM_GS = SEQ;

constexpr size_t MiB = 1u << 20;
constexpr size_t WS_CTL = 0, CTL_ZERO_BYTES = 128 * 1024;
constexpr size_t WS_SS = 1 * MiB, WS_QSS = 2 * MiB, WS_LSUM = 3 * MiB, WS_DEN = 4 * MiB, WS_AEND = 5 * MiB, WS_HEND = 5 * MiB + 256 * 1024;
constexpr size_t WS_GT = 6 * MiB, WS_POOLT = 7 * MiB;
constexpr size_t WS_WIN = 8 * MiB, WS_WOUT = 18 * MiB, WS_WQ = 22 * MiB, WS_WO = 30 * MiB, WS_W1 = 38 * MiB, WS_W2 = 70 * MiB, WS_WKV = 102 * MiB;
constexpr size_t WS_KN = 102 * MiB, WS_VT = 110 * MiB;
constexpr size_t WS_XB = 118 * MiB;
constexpr size_t WS_HID = 150 * MiB, WS_PROJ = 150 * MiB, WS_NUM = 230 * MiB, WS_AOUT = 150 * MiB, WS_Q = 182 * MiB, WS_P = 214 * MiB, WS_O = 246 * MiB;
constexpr size_t WS_END = 278 * MiB;
constexpr size_t DO_PIPE = 16 * MiB, DO_Y0 = 0, DO_Y1 = 4 * MiB, DO_KVRAW = 8 * MiB, DO_KN = 12 * MiB, DO_VT = 14 * MiB, DO_MEMN = 0;

constexpr int RING_BYTES = 131072, LDSCTL_OFF = RING_BYTES, MISC_OFF = LDSCTL_OFF + 320, LDS_BYTES = 147456;

#define GAS __attribute__((address_space(1)))
#define LAS __attribute__((address_space(3)))
typedef unsigned short bf16;
typedef unsigned v4u __attribute__((ext_vector_type(4)));
typedef unsigned v2u __attribute__((ext_vector_type(2)));
typedef float f32x4 __attribute__((ext_vector_type(4)));
typedef short bf16x8 __attribute__((ext_vector_type(8)));
typedef short s16x4 __attribute__((ext_vector_type(4)));
#define LDS_WAIT() asm volatile("s_waitcnt lgkmcnt(0)" ::: "memory")
#define VM_WAIT() asm volatile("s_waitcnt vmcnt(0)" ::: "memory")
__device__ __forceinline__ unsigned pk2(float lo, float hi) { return pg8::cvt_pk_bf16(lo, hi); }
__device__ __forceinline__ float bflo(unsigned w) { return __uint_as_float(w << 16); }
__device__ __forceinline__ float bfhi(unsigned w) { return __uint_as_float(w & 0xffff0000u); }
__device__ __forceinline__ float bf1(bf16 h) { return __uint_as_float((unsigned)h << 16); }
__device__ __forceinline__ bf16 f2bf(float f) { return (bf16)(pg8::cvt_pk_bf16(f, 0.f) & 0xffffu); }

#define XB_TMO      128
#define XB_XCNT(j)  (256  + 64 * (j))
#define XB_XSUB(j)  (1280 + 64 * (j))
#define XB_XGEN(j)  (2304 + 64 * (j))
#define XB_TOP      3328
#define XB_TOPGEN   3392
#define XCD_BAR_WORDS 3456
#define XB_SPIN_CAP (1u << 22)
__device__ __forceinline__ unsigned xb_ld(unsigned* p)              { return __hip_atomic_load(p, __ATOMIC_RELAXED, __HIP_MEMORY_SCOPE_AGENT); }
__device__ __forceinline__ unsigned xb_add(unsigned* p, unsigned v) { return __hip_atomic_fetch_add(p, v, __ATOMIC_RELAXED, __HIP_MEMORY_SCOPE_AGENT); }
__device__ __forceinline__ unsigned xb_xcc_id() { return (unsigned)__builtin_amdgcn_s_getreg((3 << 11) | 20) & 0xFu; }
#define XB_SPIN(cond, bar) do { unsigned _sp = 0; while (cond) { __builtin_amdgcn_s_sleep(1); \
    if ((++_sp & 255u) == 0u) { if (xb_ld(&(bar)[XB_TMO])) break; if (_sp > XB_SPIN_CAP) { atomicAdd(&(bar)[XB_TMO], 1u); break; } } } } while (0)
struct XcdBarrier { unsigned* bar; unsigned x; volatile LAS unsigned* st; unsigned G; };
__device__ __forceinline__ XcdBarrier xcd_barrier_post(unsigned* bar, volatile LAS unsigned* st, unsigned G) {
    XcdBarrier b; b.bar = bar; b.x = xb_xcc_id(); b.st = st; b.G = G;
    if (threadIdx.x == 0) (void)xb_add(&bar[XB_XCNT(b.x)], 1u);
    return b;
}
__device__ __forceinline__ void xcd_barrier_complete(unsigned* bar, unsigned x, unsigned G, unsigned& nloc, unsigned& nx) {
    unsigned sum, cnt, mine, sp = 0u;
    for (;;) {
        sum = 0u; cnt = 0u; mine = 0u;
#pragma unroll
        for (unsigned j = 0; j < 16; ++j) { const unsigned c = xb_ld(&bar[XB_XCNT(j)]); sum += c; cnt += (c > 0u) ? 1u : 0u; mine = (j == x) ? c : mine; }
        if (sum == G) break;
        __builtin_amdgcn_s_sleep(1);
        if ((++sp & 255u) == 0u) { if (xb_ld(&bar[XB_TMO])) break; if (sp > XB_SPIN_CAP) { atomicAdd(&bar[XB_TMO], 1u); break; } }
    }
    nloc = mine > 0u ? mine : 1u; nx = cnt > 0u ? cnt : 1u;
}
__device__ __forceinline__ void xcd_barrier(const XcdBarrier& b) {
    asm volatile("s_waitcnt vmcnt(0)" ::: "memory");
    __syncthreads();
    if (threadIdx.x == 0) {
#ifdef CLK_ACC
        const unsigned long long tb0_ = wall_clock64();
#endif
        unsigned* bar = b.bar;
        __builtin_amdgcn_s_waitcnt(0);
        unsigned nloc = b.st[0], nx = b.st[1];
        if (nloc == 0u) { xcd_barrier_complete(bar, b.x, b.G, nloc, nx); b.st[0] = nloc; b.st[1] = nx; }
        const unsigned old = xb_add(&bar[XB_XSUB(b.x)], 1u);
        const unsigned gen = old / nloc;
        if (old + 1u == (gen + 1u) * nloc) {
            __builtin_amdgcn_fence(__ATOMIC_RELEASE, "agent");
            asm volatile("s_waitcnt vmcnt(0)" ::: "memory");
            const unsigned og = xb_add(&bar[XB_TOP], 1u);
            const unsigned tg = og / nx;
            if (og + 1u == (tg + 1u) * nx) xb_add(&bar[XB_TOPGEN], 1u);
            else XB_SPIN(xb_ld(&bar[XB_TOPGEN]) == tg, bar);
            __builtin_amdgcn_fence(__ATOMIC_ACQUIRE, "agent");
            xb_add(&bar[XB_XGEN(b.x)], 1u);
            asm volatile("s_waitcnt vmcnt(0)" ::: "memory");
        } else {
            XB_SPIN(xb_ld(&bar[XB_XGEN(b.x)]) == gen, bar);
            __builtin_amdgcn_fence(__ATOMIC_ACQUIRE, "agent");
            asm volatile("s_waitcnt vmcnt(0)" ::: "memory");
        }
#ifdef CLK_ACC
        b.st[8 + 5 - (b.G == 64 ? 2 : 0)] += (unsigned)(wall_clock64() - tb0_);
#endif
    }
    __syncthreads();
}

__device__ __forceinline__ float wave_sum(float v) {
#pragma unroll
    for (int o = 1; o < 64; o <<= 1) v += __shfl_xor(v, o);
    return v;
}

struct P0Item { const float* W; bf16* WT; const float* gain; int K, N, item; };
__device__ __forceinline__ void p0_load(const P0Item& I, float (&v)[32], int lane) {
    const int nblk = I.N / 32, kb = I.item / nblk, nb = I.item % nblk, k0 = 64 * kb, n0 = 32 * nb;
#pragma unroll
    for (int i = 0; i < 32; ++i) { const int kk = 2 * i + (lane >> 5);
#ifdef P0_NT
        v[i] = __builtin_nontemporal_load(I.W + (size_t)(k0 + kk) * I.N + n0 + (lane & 31));
#else
        v[i] = I.W[(size_t)(k0 + kk) * I.N + n0 + (lane & 31)];
#endif
    }
}
template <bool NTS = false> __device__ __forceinline__ void p0_finish(const P0Item& I, const float (&v)[32], LAS float* scr, int lane) {
    const int nblk = I.N / 32, kb = I.item / nblk, nb = I.item % nblk, k0 = 64 * kb, n0 = 32 * nb;
    const int c = lane & 7;
    f32x4 g0 = (f32x4){1.f, 1.f, 1.f, 1.f}, g1 = g0;
    if (I.gain) { g0 = *(const GAS f32x4*)(I.gain + k0 + 8 * c); g1 = *(const GAS f32x4*)(I.gain + k0 + 8 * c + 4); }
#pragma unroll
    for (int i = 0; i < 32; ++i) { const int kk = 2 * i + (lane >> 5); scr[kk * 33 + (lane & 31)] = v[i]; }
    LDS_WAIT(); asm volatile("" ::: "memory");
#pragma unroll
    for (int j = 0; j < 4; ++j) { const int n = (lane >> 3) + 8 * j; const LAS float* s = scr + (8 * c) * 33 + n;
        v4u o; o.x = pk2(s[0 * 33] * g0[0], s[1 * 33] * g0[1]); o.y = pk2(s[2 * 33] * g0[2], s[3 * 33] * g0[3]); o.z = pk2(s[4 * 33] * g1[0], s[5 * 33] * g1[1]); o.w = pk2(s[6 * 33] * g1[2], s[7 * 33] * g1[3]);
        if (NTS) __builtin_nontemporal_store(o, (GAS v4u*)(I.WT + (size_t)(n0 + n) * I.K + k0 + 8 * c)); else *(GAS v4u*)(I.WT + (size_t)(n0 + n) * I.K + k0 + 8 * c) = o; }
    LDS_WAIT(); asm volatile("" ::: "memory");
}

struct Ptrs {
    const float* in[26]; float* out; unsigned char* ws;
};

struct Args { Ptrs p; int ph_lo, ph_hi; };
__device__ __forceinline__ const float* ld_in(const Args& a, int i) { asm volatile("" : "+s"(i)); return a.p.in[i]; }
__device__ __forceinline__ float* ld_out(const Args& a) { int i = 0; asm volatile("" : "+s"(i)); return (&a.p.out)[i]; }
__device__ __forceinline__ unsigned char* ld_ws(const Args& a) { int i = 0; asm volatile("" : "+s"(i)); return (&a.p.ws)[i]; }
#define INP(i) ld_in(args, (i))
#define OUTP() ld_out(args)
constexpr int P0_I_WIN = 16 * 80, P0_I_SQ = 16 * 32, P0_I_G = 2 * 4, P0_I_POOL = 4 * 8, P0_I_KV = 16 * 64, P0_I_W1 = 16 * 128, P0_I_W2 = 64 * 32;
constexpr int P0_NA = P0_I_W1 + P0_I_W2 + 4 * P0_I_KV + P0_I_WIN + 3 * P0_I_SQ + 8 * P0_I_G;
constexpr int P0_NB = 3 * P0_I_W1 + 3 * P0_I_W2 + P0_I_WIN + P0_I_SQ + 6 * P0_I_SQ + 8 * P0_I_POOL + 8 * P0_I_G;
static_assert(P0_NA == 11072 && P0_NB == 17472 && P0_NB % 6 == 0, "item counts");
template <int SET> __device__ __forceinline__ P0Item p0_decode(const Args& args, unsigned char* ws, int it) {
    constexpr int l0 = SET ? 1 : 0, nl = SET ? 3 : 1, e0 = SET ? 1 : 0;
    P0Item I; int r = it;
    if (r < nl * P0_I_W1) { const int l = l0 + r / P0_I_W1; I = P0Item{INP(24) + (size_t)l * D * FF, (bf16*)(ws + WS_W1) + (size_t)l * FF * D, INP(5) + l * D, D, FF, r % P0_I_W1}; return I; } r -= nl * P0_I_W1;
    if (r < nl * P0_I_W2) { const int l = l0 + r / P0_I_W2; I = P0Item{INP(25) + (size_t)l * FF * D, (bf16*)(ws + WS_W2) + (size_t)l * D * FF, nullptr, FF, D, r % P0_I_W2}; return I; } r -= nl * P0_I_W2;
    if (!SET) { if (r < 4 * P0_I_KV) { const int l = r / P0_I_KV; I = P0Item{INP(20) + (size_t)l * D * 2048, (bf16*)(ws + WS_WKV) + (size_t)l * 2048 * D, nullptr, D, 2048, r % P0_I_KV}; return I; } r -= 4 * P0_I_KV; }
    if (r < P0_I_WIN) { I = P0Item{INP(6) + (size_t)e0 * D * INC, (bf16*)(ws + WS_WIN) + (size_t)e0 * INC * D, INP(3) + (2 * e0) * D, D, INC, r}; return I; } r -= P0_I_WIN;
    if (r < P0_I_SQ) { I = P0Item{INP(16) + (size_t)e0 * D * D, (bf16*)(ws + WS_WOUT) + (size_t)e0 * D * D, nullptr, D, D, r}; return I; } r -= P0_I_SQ;
    if (r < nl * P0_I_SQ) { const int l = l0 + r / P0_I_SQ; I = P0Item{INP(19) + (size_t)l * D * D, (bf16*)(ws + WS_WQ) + (size_t)l * D * D, INP(4) + l * D, D, D, r % P0_I_SQ}; return I; } r -= nl * P0_I_SQ;
    if (r < nl * P0_I_SQ) { const int l = l0 + r / P0_I_SQ; I = P0Item{INP(23) + (size_t)l * D * D, (bf16*)(ws + WS_WO) + (size_t)l * D * D, nullptr, D, D, r % P0_I_SQ}; return I; } r -= nl * P0_I_SQ;
    if (SET) { if (r < 8 * P0_I_POOL) { const int mat = r / P0_I_POOL, o = mat >> 2, g = mat & 3; I = P0Item{INP(17) + (size_t)mat * 65536, (bf16*)(ws + WS_POOLT) + (size_t)mat * 65536, INP(3) + (2 * o + 1) * D + g * 256, 256, 256, r % P0_I_POOL}; return I; } r -= 8 * P0_I_POOL; }
    { const int mat = r / P0_I_G, kind = mat >> 2, g = mat & 3, eg = e0 * 4 + g;
      I = P0Item{(kind ? INP(13) : INP(11)) + (size_t)eg * 16384, (bf16*)(ws + WS_GT) + (size_t)((e0 * 2 + kind) * 4 + g) * 16384, nullptr, 128, 128, r % P0_I_G}; }
    return I;
}
template <int SET> __device__ __forceinline__ void p0_items(const Args& args, LAS unsigned char* lds, int first, int last, int w, int NW, int wave) {
    int tid_ = threadIdx.x; asm volatile("" : "+v"(tid_)); const int lane = tid_ & 63;
    LAS float* scr = (LAS float*)(lds + wave * 16384);
    unsigned char* ws = ld_ws(args);
#if P0_INFLIGHT == 4
    for (int it = first + w; it < last; it += 4 * NW) {
        float va[32], vb[32], vc[32], vd[32];
        const bool hb = (it + NW < last), hc = (it + 2 * NW < last), hd = (it + 3 * NW < last);
        const P0Item A = p0_decode<SET>(args, ws, it); p0_load(A, va, lane);
        P0Item B = A, C = A, Dd = A;
        if (hb) { B = p0_decode<SET>(args, ws, it + NW); p0_load(B, vb, lane); }
        if (hc) { C = p0_decode<SET>(args, ws, it + 2 * NW); p0_load(C, vc, lane); }
        if (hd) { Dd = p0_decode<SET>(args, ws, it + 3 * NW); p0_load(Dd, vd, lane); }
        p0_finish<P0_NTS(SET)>(A, va, scr, lane);
        if (hb) p0_finish<P0_NTS(SET)>(B, vb, scr, lane);
        if (hc) p0_finish<P0_NTS(SET)>(C, vc, scr, lane);
        if (hd) p0_finish<P0_NTS(SET)>(Dd, vd, scr, lane);
    }
#else
    for (int it = first + w; it < last; it += 2 * NW) {
        float va[32], vb[32];
        const P0Item A = p0_decode<SET>(args, ws, it); p0_load(A, va, lane);
        const bool two = (it + NW < last);
        P0Item B = A; if (two) { B = p0_decode<SET>(args, ws, it + NW); p0_load(B, vb, lane); }
        p0_finish<P0_NTS(SET)>(A, va, scr, lane);
        if (two) p0_finish<P0_NTS(SET)>(B, vb, scr, lane);
    }
#endif
}
__device__ __forceinline__ void p0_prologue(const Args& args, LAS unsigned char* lds, int gw, int NGW, int wave) {
    int tid_ = threadIdx.x; asm volatile("" : "+v"(tid_)); const int lane = tid_ & 63;
    unsigned char* ws = ld_ws(args);
    p0_items<0>(args, lds, 0, P0_NA, gw, NGW, wave);
    if (MK_N_LAUNCHES != 1) p0_items<1>(args, lds, 0, P0_NB, gw, NGW, wave);
    for (int m = gw; m < T; m += 2 * NGW) {
        f32x4 v[2][4];
#pragma unroll
        for (int r = 0; r < 2; ++r) { const GAS f32x4* xr = (const GAS f32x4*)(INP(0) + (size_t)(m + r * NGW) * D) + lane;
#pragma unroll
            for (int j = 0; j < 4; ++j) {
#ifdef P0_NT
                v[r][j] = __builtin_nontemporal_load((const f32x4*)(INP(0) + (size_t)(m + r * NGW) * D) + lane + 64 * j);
#else
                v[r][j] = xr[64 * j];
#endif
            } }
#pragma unroll
        for (int r = 0; r < 2; ++r) { const int mm = m + r * NGW; float s = 0.f;
#pragma unroll
            for (int j = 0; j < 4; ++j) s += (v[r][j][0] * v[r][j][0] + v[r][j][1] * v[r][j][1]) + (v[r][j][2] * v[r][j][2] + v[r][j][3] * v[r][j][3]);
            s = wave_sum(s);
            GAS v2u* o8 = (GAS v2u*)((bf16*)(ws + WS_XB) + (size_t)mm * D) + lane;
#pragma unroll
            for (int j = 0; j < 4; ++j) { v2u w; w.x = pk2(v[r][j][0], v[r][j][1]); w.y = pk2(v[r][j][2], v[r][j][3]); o8[64 * j] = w; }
            if (lane < 16) ((float*)(ws + WS_SS))[(size_t)mm * 16 + lane] = lane == 0 ? s : 0.f; }
    }
    for (int m = gw; m < TM; m += NGW) {
        const GAS f32x4* xr = (const GAS f32x4*)(INP(1) + (size_t)m * D) + lane; const GAS f32x4* gr = (const GAS f32x4*)(INP(2)) + lane; f32x4 v[4]; float s = 0.f;
#pragma unroll
        for (int j = 0; j < 4; ++j) { v[j] = xr[64 * j]; s += (v[j][0] * v[j][0] + v[j][1] * v[j][1]) + (v[j][2] * v[j][2] + v[j][3] * v[j][3]); }
        const float rs = 1.0f / sqrtf(wave_sum(s) * (1.0f / D) + EPS);
        GAS v2u* o8 = (GAS v2u*)((bf16*)((unsigned char*)OUTP() + (size_t)(m >> 8) * DO_PIPE + DO_MEMN) + (size_t)(m & 255) * D) + lane;
#pragma unroll
        for (int j = 0; j < 4; ++j) { const f32x4 gg = gr[64 * j]; v2u w; w.x = pk2(v[j][0] * rs * gg[0], v[j][1] * rs * gg[1]); w.y = pk2(v[j][2] * rs * gg[2], v[j][3] * rs * gg[3]); o8[64 * j] = w; }
    }
}

__device__ __forceinline__ void kv_finalize(const Args& args, const bf16* __restrict__ kvraw  , bf16* __restrict__ Kn  , bf16* __restrict__ Vt, int gw, int NGW) {
    int tid_ = threadIdx.x; asm volatile("" : "+v"(tid_)); const int lane = tid_ & 63;
    for (int row0 = gw; row0 < 4 * 256 * 4; row0 += 4 * NGW) {
        v2u w[4];
#pragma unroll
        for (int r = 0; r < 4; ++r) { const int row = row0 + r * NGW, l = row >> 10, m = (row >> 2) & 255, h = row & 3;
            w[r] = *(const GAS v2u*)(kvraw + ((size_t)(l * 256 + m)) * 2048 + h * 256 + 4 * lane); }
#pragma unroll
        for (int r = 0; r < 4; ++r) { const int row = row0 + r * NGW, l = row >> 10, m = (row >> 2) & 255, h = row & 3;
            const float k0 = bflo(w[r].x), k1 = bfhi(w[r].x), k2 = bflo(w[r].y), k3 = bfhi(w[r].y);
            const float ss = wave_sum((k0 * k0 + k1 * k1) + (k2 * k2 + k3 * k3));
            const float sc = (1.0f / sqrtf(ss * (1.0f / 256.0f) + EPS)) * (0.0625f * LOG2E);
            const f32x4 gk = *(const GAS f32x4*)(INP(22) + l * 256 + 4 * lane), gq = *(const GAS f32x4*)(INP(21) + l * 256 + 4 * lane);
            v2u o; o.x = pk2(k0 * sc * gk[0] * gq[0], k1 * sc * gk[1] * gq[1]); o.y = pk2(k2 * sc * gk[2] * gq[2], k3 * sc * gk[3] * gq[3]);
            *(GAS v2u*)(Kn + ((size_t)(l * 4 + h) * 256 + m) * 256 + 4 * lane) = o; }
    }
    for (int it0 = gw; it0 < 2048; it0 += 4 * NGW) {
        v4u w[4];
#pragma unroll
        for (int r = 0; r < 4; ++r) { const int it = it0 + r * NGW, l = it >> 9, h = (it >> 7) & 3, kb = (it >> 5) & 3, dc = it & 31, key = 64 * kb + lane;
            w[r] = *(const GAS v4u*)(kvraw + ((size_t)(l * 256 + key)) * 2048 + 1024 + h * 256 + 8 * dc); }
#pragma unroll
        for (int r = 0; r < 4; ++r) { const int it = it0 + r * NGW, l = it >> 9, h = (it >> 7) & 3, kb = (it >> 5) & 3, dc = it & 31, key = 64 * kb + lane;
            bf16* dst = Vt + ((size_t)(l * 4 + h) * 256 + 8 * dc) * 256 + key;
            dst[0 * 256] = (bf16)(w[r].x & 0xffffu); dst[1 * 256] = (bf16)(w[r].x >> 16); dst[2 * 256] = (bf16)(w[r].y & 0xffffu); dst[3 * 256] = (bf16)(w[r].y >> 16);
            dst[4 * 256] = (bf16)(w[r].z & 0xffffu); dst[5 * 256] = (bf16)(w[r].z >> 16); dst[6 * 256] = (bf16)(w[r].w & 0xffffu); dst[7 * 256] = (bf16)(w[r].w >> 16); }
    }
}

struct AttnPre { v4u kk[4], vv[4], qq[4]; };
__device__ __forceinline__ void attn_load(AttnPre& R, const bf16* proj, size_t rowb, int h, int base, int d, int tid, bool valid) {
    const int c = tid & 15, w = tid >> 6, lane = tid & 63, q = lane & 15, G = lane >> 4;
    const int bs = valid ? base : 0;
#pragma unroll
    for (int i = 0; i < 4; ++i) { const int kr = (tid >> 4) + 32 * i;
        const bf16* p = proj + (rowb + bs + (size_t)kr * d) * INC + 512 + h * 128 + 8 * c; R.kk[i] = *(const GAS v4u*)p; R.vv[i] = *(const GAS v4u*)(p + 512);
        if (!valid) { R.kk[i] = (v4u){0u, 0u, 0u, 0u}; R.vv[i] = (v4u){0u, 0u, 0u, 0u}; } }
    {
        const size_t qrow = rowb + bs + (size_t)(16 * w + q) * d;
#pragma unroll
        for (int ks = 0; ks < 4; ++ks) R.qq[ks] = *(const GAS v4u*)(proj + qrow * INC + h * 128 + 32 * ks + 8 * G); }
}
__device__ __forceinline__ void attn_store_kv(const AttnPre& R, LAS unsigned char* lds, int slot, const f32x4 ga, const f32x4 gb, int tid) {
    const int c = tid & 15;
#pragma unroll
    for (int i = 0; i < 4; ++i) { const int kr = (tid >> 4) + 32 * i, lr = slot * 128 + kr;
        const float a0 = bflo(R.kk[i].x), a1 = bfhi(R.kk[i].x), a2 = bflo(R.kk[i].y), a3 = bfhi(R.kk[i].y), a4 = bflo(R.kk[i].z), a5 = bfhi(R.kk[i].z), a6 = bflo(R.kk[i].w), a7 = bfhi(R.kk[i].w);
        float ss = ((a0 * a0 + a1 * a1) + (a2 * a2 + a3 * a3)) + ((a4 * a4 + a5 * a5) + (a6 * a6 + a7 * a7));
        ss += __shfl_xor(ss, 1); ss += __shfl_xor(ss, 2); ss += __shfl_xor(ss, 4); ss += __shfl_xor(ss, 8);
        const float rk = __builtin_amdgcn_rsqf(ss * (1.0f / 128.0f) + EPS);
        v4u o; o.x = pk2(a0 * rk * ga[0], a1 * rk * ga[1]); o.y = pk2(a2 * rk * ga[2], a3 * rk * ga[3]); o.z = pk2(a4 * rk * gb[0], a5 * rk * gb[1]); o.w = pk2(a6 * rk * gb[2], a7 * rk * gb[3]);
        *(LAS v4u*)(lds + lr * 256 + ((c ^ (lr & 15)) << 4)) = o;
        *(LAS v4u*)(lds + 65536 + lr * 256 + ((c ^ ((lr & 7) << 1)) << 4)) = R.vv[i]; }
}
__device__ __forceinline__ void attn_segment(LAS unsigned char* lds, const bf16* proj, const float* gq, const float* gk, bf16* num, float* den, int g, int bh, int r, int n0, int L, int tid) {
    asm volatile("" : "+v"(tid));
    const int dsh = 2 * g, d = 1 << dsh, b = bh >> 2, h = bh & 3, wlen = 128 << dsh;
    const size_t rowb = (size_t)b * SEQ;
    const int w = tid >> 6, lane = tid & 63, q = lane & 15, G = lane >> 4;
    const f32x4 gka = *(const GAS f32x4*)(gk + 8 * (tid & 15)), gkb = *(const GAS f32x4*)(gk + 8 * (tid & 15) + 4);
    f32x4 gqa[4], gqb[4];
#pragma unroll
    for (int ks = 0; ks < 4; ++ks) { gqa[ks] = *(const GAS f32x4*)(gq + 32 * ks + 8 * G); gqb[ks] = *(const GAS f32x4*)(gq + 32 * ks + 8 * G + 4); }
    AttnPre R;
    attn_load(R, proj, rowb, h, (n0 - 1) * wlen + r, d, tid, n0 > 0);
    attn_store_kv(R, lds, (n0 - 1) & 1, gka, gkb, tid);
    attn_load(R, proj, rowb, h, n0 * wlen + r, d, tid, true);
    attn_store_kv(R, lds, n0 & 1, gka, gkb, tid);
    for (int n = n0; n < n0 + L; ++n) {
        const int base = n * wlen + r;
        const size_t qrow = rowb + base + (size_t)(16 * w + q) * d;
        bf16x8 Qf[4];
        {
            float ss = 0.f;
#pragma unroll
            for (int ks = 0; ks < 4; ++ks) { const float a0 = bflo(R.qq[ks].x), a1 = bfhi(R.qq[ks].x), a2 = bflo(R.qq[ks].y), a3 = bfhi(R.qq[ks].y), a4 = bflo(R.qq[ks].z), a5 = bfhi(R.qq[ks].z), a6 = bflo(R.qq[ks].w), a7 = bfhi(R.qq[ks].w);
                ss += ((a0 * a0 + a1 * a1) + (a2 * a2 + a3 * a3)) + ((a4 * a4 + a5 * a5) + (a6 * a6 + a7 * a7)); }
            ss += __shfl_xor(ss, 16); ss += __shfl_xor(ss, 32);
            const float rq = __builtin_amdgcn_rsqf(ss * (1.0f / 128.0f) + EPS) * (0.08838834764831845f * LOG2E);
#pragma unroll
            for (int ks = 0; ks < 4; ++ks) { const f32x4 ga = gqa[ks], gb = gqb[ks];
                v4u o; o.x = pk2(bflo(R.qq[ks].x) * rq * ga[0], bfhi(R.qq[ks].x) * rq * ga[1]); o.y = pk2(bflo(R.qq[ks].y) * rq * ga[2], bfhi(R.qq[ks].y) * rq * ga[3]);
                o.z = pk2(bflo(R.qq[ks].z) * rq * gb[0], bfhi(R.qq[ks].z) * rq * gb[1]); o.w = pk2(bflo(R.qq[ks].w) * rq * gb[2], bfhi(R.qq[ks].w) * rq * gb[3]);
                Qf[ks] = __builtin_bit_cast(bf16x8, o); }
        }
        __syncthreads();
        const bool more = (n + 1 < n0 + L);
#ifndef ATT_NOPF
        if (more) attn_load(R, proj, rowb, h, base + wlen, d, tid, true);
#endif
#ifdef ATT_PFCMP
        AttnPre R2; if (more) attn_load(R2, proj, rowb, h, base + wlen, d, tid, true);
#endif
        f32x4 s[9];
#pragma unroll
        for (int t = 0; t < 9; ++t) { s[t] = (f32x4){0.f, 0.f, 0.f, 0.f}; const int kt = w + t, lr = ((((n - 1) + (kt >> 3)) & 1) << 7) + ((kt & 7) << 4) + q;
            bf16x8 Kf[4];
#pragma unroll
            for (int ks = 0; ks < 4; ++ks) Kf[ks] = *(const LAS bf16x8*)(lds + lr * 256 + (((4 * ks + G) ^ q) << 4));
            __builtin_amdgcn_sched_barrier(0);
#pragma unroll
            for (int ks = 0; ks < 4; ++ks) s[t] = __builtin_amdgcn_mfma_f32_16x16x32_bf16(Kf[ks], Qf[ks], s[t], 0, 0, 0);
            __builtin_amdgcn_sched_barrier(0); }
        float dsum = 0.f; const bool first = (n == 0);
#pragma unroll
        for (int t = 0; t < 9; ++t)
#pragma unroll
            for (int e = 0; e < 4; ++e) { const int kk = 4 * G + e; bool ok = true;
                if (t == 0) ok = kk >= q; if (t == 8) ok = kk <= q; if (first && (w + t) < 8) ok = false;
                const float p = ok ? __builtin_amdgcn_exp2f(s[t][e]) : 0.f; s[t][e] = p; dsum += p; }
        dsum += __shfl_xor(dsum, 16); dsum += __shfl_xor(dsum, 32);
#ifdef ATT_PF_MID
        if (more) attn_load(R, proj, rowb, h, base + wlen, d, tid, true);
#endif
        f32x4 o[8];
#pragma unroll
        for (int nt = 0; nt < 8; ++nt) o[nt] = (f32x4){0.f, 0.f, 0.f, 0.f};
        const int q4 = q >> 2, pp = q & 3;
#pragma unroll
        for (int si = 0; si < 5; ++si) {
            v4u pw; pw.x = pk2(s[2 * si][0], s[2 * si][1]); pw.y = pk2(s[2 * si][2], s[2 * si][3]);
            if (si < 4) { pw.z = pk2(s[2 * si + 1][0], s[2 * si + 1][1]); pw.w = pk2(s[2 * si + 1][2], s[2 * si + 1][3]); } else { pw.z = 0u; pw.w = 0u; }
            const bf16x8 Pf = __builtin_bit_cast(bf16x8, pw);
            const int kt0 = w + 2 * si, kt1 = (si < 4) ? kt0 + 1 : kt0;
            const int key0 = ((((n - 1) + (kt0 >> 3)) & 1) << 7) + ((kt0 & 7) << 4) + 4 * G + q4, key1 = ((((n - 1) + (kt1 >> 3)) & 1) << 7) + ((kt1 & 7) << 4) + 4 * G + q4;
            const int sw0 = (key0 & 7) << 1, sw1 = (key1 & 7) << 1;
#pragma unroll
            for (int nh = 0; nh < 2; ++nh) {
                s16x4 v0[4], v1[4];
#pragma unroll
                for (int n4 = 0; n4 < 4; ++n4) { const int chunk = 2 * (4 * nh + n4) + (pp >> 1);
                    v0[n4] = __builtin_bit_cast(s16x4, __builtin_amdgcn_ds_read_tr16_b64_v4i16((LAS s16x4*)(lds + 65536 + key0 * 256 + ((chunk ^ sw0) << 4) + (pp & 1) * 8)));
                    v1[n4] = __builtin_bit_cast(s16x4, __builtin_amdgcn_ds_read_tr16_b64_v4i16((LAS s16x4*)(lds + 65536 + key1 * 256 + ((chunk ^ sw1) << 4) + (pp & 1) * 8))); }
                __builtin_amdgcn_sched_barrier(0);
#pragma unroll
                for (int n4 = 0; n4 < 4; ++n4) { const bf16x8 Vf = (bf16x8){v0[n4][0], v0[n4][1], v0[n4][2], v0[n4][3], v1[n4][0], v1[n4][1], v1[n4][2], v1[n4][3]};
                    o[4 * nh + n4] = __builtin_amdgcn_mfma_f32_16x16x32_bf16(Vf, Pf, o[4 * nh + n4], 0, 0, 0); }
                __builtin_amdgcn_sched_barrier(0); }
        }
        bf16* np = num + ((size_t)g * NUM_GS + qrow) * 512 + h * 128 + 4 * G;
#pragma unroll
        for (int nt = 0; nt < 8; ++nt) { v2u wv; wv.x = pk2(o[nt][0], o[nt][1]); wv.y = pk2(o[nt][2], o[nt][3]);
#ifdef ATT_NT_STORE
            __builtin_nontemporal_store(wv, (GAS v2u*)(np + 16 * nt));
#else
            *(GAS v2u*)(np + 16 * nt) = wv;
#endif
        }
        if (G == 0) den[((size_t)g * T + qrow) * 4 + h] = dsum;
        __syncthreads();
#if defined(ATT_NOPF) && !defined(ATT_PF_MID)
        if (more) attn_load(R, proj, rowb, h, base + wlen, d, tid, true);
#endif
#ifdef ATT_PFCMP
        if (more) { unsigned df = 0;
#pragma unroll
            for (int i = 0; i < 4; ++i) { df |= (R.kk[i].x ^ R2.kk[i].x) | (R.kk[i].y ^ R2.kk[i].y) | (R.kk[i].z ^ R2.kk[i].z) | (R.kk[i].w ^ R2.kk[i].w) | (R.vv[i].x ^ R2.vv[i].x) | (R.vv[i].y ^ R2.vv[i].y) | (R.vv[i].z ^ R2.vv[i].z) | (R.vv[i].w ^ R2.vv[i].w) | (R.qq[i].x ^ R2.qq[i].x) | (R.qq[i].y ^ R2.qq[i].y) | (R.qq[i].z ^ R2.qq[i].z) | (R.qq[i].w ^ R2.qq[i].w); }
#ifdef ATT_PFCMP_NOFLAG
            asm volatile("" :: "v"(df));
#else
            if (df) den[0] = __builtin_nanf("");
#endif
            }
#endif
#ifdef ATT_VMW
        asm volatile("s_waitcnt vmcnt(0)" ::: "memory");
#endif
        if (more) attn_store_kv(R, lds, (n + 1) & 1, gka, gkb, tid);
    }
    __syncthreads();
}

__device__ __forceinline__ void xa_fill_image(LAS unsigned char* lds, const bf16* src  , int w, int lane) {
    asm volatile("" : "+v"(lane));
    const int rsub = lane >> 5, cp = lane & 31;
#pragma unroll
    for (int j = 0; j < 16; ++j) { const int pi = w * 16 + j, row = 2 * pi + rsub, ch = cp ^ (row & 15);
        __builtin_amdgcn_global_load_lds((const unsigned*)(src + (size_t)row * 256 + ch * 8), (LAS unsigned*)(lds + pi * 1024), 16, 0, 0); }
}
__device__ __forceinline__ void xa_unit(LAS unsigned char* lds, const bf16* Qb, const float* qss, const bf16* Kn_h, const bf16* Vt_h, bf16* Ob, int pm, int h, int tid) {
    asm volatile("" : "+v"(tid));
    pm = __builtin_amdgcn_readfirstlane(pm); h = __builtin_amdgcn_readfirstlane(h);
    const int w = __builtin_amdgcn_readfirstlane(tid >> 6), lane = tid & 63, q = lane & 15, G = lane >> 4;
    const size_t row0 = (size_t)pm * 256 + 32 * w;
    xa_fill_image(lds, Kn_h, w, lane);
    bf16x8 Qf[2][8]; float rq[2];
#pragma unroll
    for (int qt = 0; qt < 2; ++qt) { const size_t row = row0 + 16 * qt + q;
        const f32x4 v = *(const GAS f32x4*)(qss + row * 16 + h * 4); rq[qt] = __builtin_amdgcn_rsqf(((v[0] + v[1]) + (v[2] + v[3])) * (1.0f / 256.0f) + EPS);
#pragma unroll
        for (int ks = 0; ks < 8; ++ks) Qf[qt][ks] = __builtin_bit_cast(bf16x8, *(const GAS v4u*)(Qb + row * 1024 + h * 256 + 32 * ks + 8 * G)); }
    asm volatile("s_waitcnt vmcnt(0)" ::: "memory"); __syncthreads();
    bf16x8 Pf[2][8]; float lsum[2] = {0.f, 0.f};
#pragma unroll
    for (int hk = 0; hk < 2; ++hk) {
        f32x4 sc[2][8];
#pragma unroll
        for (int kt = 0; kt < 8; ++kt) { sc[0][kt] = (f32x4){0.f, 0.f, 0.f, 0.f}; sc[1][kt] = (f32x4){0.f, 0.f, 0.f, 0.f};
#pragma unroll
            for (int kh = 0; kh < 2; ++kh) {
                bf16x8 Kf[4];
#pragma unroll
                for (int k4 = 0; k4 < 4; ++k4) Kf[k4] = *(const LAS bf16x8*)(lds + (16 * (8 * hk + kt) + q) * 512 + (((4 * (4 * kh + k4) + G) ^ q) << 4));
                __builtin_amdgcn_sched_barrier(0);
#pragma unroll
                for (int k4 = 0; k4 < 4; ++k4) {
                    sc[0][kt] = __builtin_amdgcn_mfma_f32_16x16x32_bf16(Kf[k4], Qf[0][4 * kh + k4], sc[0][kt], 0, 0, 0);
                    sc[1][kt] = __builtin_amdgcn_mfma_f32_16x16x32_bf16(Kf[k4], Qf[1][4 * kh + k4], sc[1][kt], 0, 0, 0); }
                __builtin_amdgcn_sched_barrier(0); } }
#pragma unroll
        for (int qt = 0; qt < 2; ++qt)
#pragma unroll
            for (int s2 = 0; s2 < 4; ++s2) { float e[8];
#pragma unroll
                for (int r = 0; r < 4; ++r) { e[r] = __builtin_amdgcn_exp2f(sc[qt][2 * s2][r] * rq[qt]); e[4 + r] = __builtin_amdgcn_exp2f(sc[qt][2 * s2 + 1][r] * rq[qt]); }
                lsum[qt] += ((e[0] + e[1]) + (e[2] + e[3])) + ((e[4] + e[5]) + (e[6] + e[7]));
                v4u pw; pw.x = pk2(e[0], e[1]); pw.y = pk2(e[2], e[3]); pw.z = pk2(e[4], e[5]); pw.w = pk2(e[6], e[7]); Pf[qt][4 * hk + s2] = __builtin_bit_cast(bf16x8, pw); }
    }
    __syncthreads();
    xa_fill_image(lds, Vt_h, w, lane);
    float linv[2];
#pragma unroll
    for (int qt = 0; qt < 2; ++qt) { float l = lsum[qt]; l += __shfl_xor(l, 16); l += __shfl_xor(l, 32); linv[qt] = 1.0f / l; }
    asm volatile("s_waitcnt vmcnt(0)" ::: "memory"); __syncthreads();
    bf16* op0 = Ob + (row0 + q) * 1024 + h * 256 + 4 * G; bf16* op1 = op0 + (size_t)16 * 1024;
#pragma unroll
    for (int dt = 0; dt < 16; ++dt) { f32x4 o0 = (f32x4){0.f, 0.f, 0.f, 0.f}, o1 = o0;
        LAS unsigned char* vrow = lds + (16 * dt + q) * 512 + (G & 1) * 8;
        s16x4 va[8], vb[8];
#pragma unroll
        for (int s2 = 0; s2 < 8; ++s2) { va[s2] = *(const LAS s16x4*)(vrow + (((4 * s2 + (G >> 1)) ^ q) << 4)); vb[s2] = *(const LAS s16x4*)(vrow + (((4 * s2 + 2 + (G >> 1)) ^ q) << 4)); }
        __builtin_amdgcn_sched_barrier(0);
#pragma unroll
        for (int s2 = 0; s2 < 8; ++s2) { const bf16x8 Vf = (bf16x8){va[s2][0], va[s2][1], va[s2][2], va[s2][3], vb[s2][0], vb[s2][1], vb[s2][2], vb[s2][3]};
            o0 = __builtin_amdgcn_mfma_f32_16x16x32_bf16(Vf, Pf[0][s2], o0, 0, 0, 0); o1 = __builtin_amdgcn_mfma_f32_16x16x32_bf16(Vf, Pf[1][s2], o1, 0, 0, 0); }
        __builtin_amdgcn_sched_barrier(0);
        v2u w0, w1; w0.x = pk2(o0[0] * linv[0], o0[1] * linv[0]); w0.y = pk2(o0[2] * linv[0], o0[3] * linv[0]); w1.x = pk2(o1[0] * linv[1], o1[1] * linv[1]); w1.y = pk2(o1[2] * linv[1], o1[3] * linv[1]);
        *(GAS v2u*)(op0 + 16 * dt) = w0; *(GAS v2u*)(op1 + 16 * dt) = w1; }
    __syncthreads();
}

__device__ __forceinline__ float rcp_(float x) { return __builtin_amdgcn_rcpf(x); }
__device__ __forceinline__ float sigmoid_fast(float x) { return rcp_(1.0f + __builtin_amdgcn_exp2f(-LOG2E * x)); }
__device__ __forceinline__ float gelu_tanh(float x) { const float u = 0.7978845608028654f * (x + 0.044715f * x * x * x); const float e = __builtin_amdgcn_exp2f((2.0f * LOG2E) * u); return x * (1.0f - rcp_(e + 1.0f)); }
__device__ __forceinline__ void r1_unit(LAS unsigned char* lds, const bf16* proj, const float* cw, const float* cb, const bf16* GaT, const bf16* GxT, const float* ba, const float* bx, const float* lam,
                                        bf16* Y0, int y0p, bf16* Y1, float* Aend, float* Hend, int uid, int tid) {
    asm volatile("" : "+v"(tid));
    const int g = uid & 3, chunk = (uid >> 2) & 31, b = uid >> 7, t0 = chunk * 128;
    const size_t rowb = (size_t)b * SEQ;
    LAS unsigned char* lxc = lds; LAS unsigned char* lgt = lds + 32768; LAS unsigned char* ly0 = lds + 65536; LAS unsigned char* ly1 = lds + 98304;
    {
        const int c8 = tid & 15, ch0 = 128 * g + 8 * c8;
        float wj[4][8], bb[8];
#pragma unroll
        for (int jj = 0; jj < 4; ++jj) { const f32x4 a = *(const GAS f32x4*)(cw + jj * 512 + ch0), c = *(const GAS f32x4*)(cw + jj * 512 + ch0 + 4);
            wj[jj][0] = a[0]; wj[jj][1] = a[1]; wj[jj][2] = a[2]; wj[jj][3] = a[3]; wj[jj][4] = c[0]; wj[jj][5] = c[1]; wj[jj][6] = c[2]; wj[jj][7] = c[3]; }
        { const f32x4 a = *(const GAS f32x4*)(cb + ch0), c = *(const GAS f32x4*)(cb + ch0 + 4); bb[0] = a[0]; bb[1] = a[1]; bb[2] = a[2]; bb[3] = a[3]; bb[4] = c[0]; bb[5] = c[1]; bb[6] = c[2]; bb[7] = c[3]; }
#pragma unroll
        for (int i = 0; i < 4; ++i) { const int tt = (tid >> 4) + 32 * i, t = t0 + tt;
            float a[8];
#pragma unroll
            for (int e = 0; e < 8; ++e) a[e] = bb[e];
#pragma unroll
            for (int jj = 0; jj < 4; ++jj) { const int ts = t - 3 + jj;
                v4u x = *(const GAS v4u*)(proj + (rowb + (ts < 0 ? 0 : ts)) * INC + 1536 + ch0);
                if (ts < 0) x = (v4u){0u, 0u, 0u, 0u};
                a[0] += wj[jj][0] * bflo(x.x); a[1] += wj[jj][1] * bfhi(x.x); a[2] += wj[jj][2] * bflo(x.y); a[3] += wj[jj][3] * bfhi(x.y);
                a[4] += wj[jj][4] * bflo(x.z); a[5] += wj[jj][5] * bfhi(x.z); a[6] += wj[jj][6] * bflo(x.w); a[7] += wj[jj][7] * bfhi(x.w); }
            v4u o; o.x = pk2(a[0], a[1]); o.y = pk2(a[2], a[3]); o.z = pk2(a[4], a[5]); o.w = pk2(a[6], a[7]);
            *(LAS v4u*)(lxc + tt * 256 + ((c8 ^ (tt & 15)) << 4)) = o;
            *(LAS v4u*)(lgt + tt * 256 + ((c8 ^ (tt & 15)) << 4)) = *(const GAS v4u*)(proj + (rowb + t) * INC + 2048 + ch0); }
    }
    const int w = tid >> 6, lane = tid & 63, q = lane & 15, G = lane >> 4;
    const int dd = 16 * w + q, ch = 128 * g + dd;
    bf16x8 Wa[4], Wx[4];
#pragma unroll
    for (int ks = 0; ks < 4; ++ks) { Wa[ks] = __builtin_bit_cast(bf16x8, *(const GAS v4u*)(GaT + dd * 128 + 32 * ks + 8 * G)); Wx[ks] = __builtin_bit_cast(bf16x8, *(const GAS v4u*)(GxT + dd * 128 + 32 * ks + 8 * G)); }
    const float bav = ba[ch], bxv = bx[ch], lv = lam[ch]; const float sp8 = 8.0f * __logf(1.0f + __expf(-lv));
    __syncthreads();
    float Arun = 1.f, Hrun = 0.f;
    const int xoff = ((dd >> 3) << 4), xlo = (dd & 7) * 2;
#pragma unroll 2
    for (int tt8 = 0; tt8 < 8; ++tt8) {
        f32x4 aA = (f32x4){0.f, 0.f, 0.f, 0.f}, aX = (f32x4){0.f, 0.f, 0.f, 0.f};
        bf16x8 Xf[4];
#pragma unroll
        for (int ks = 0; ks < 4; ++ks) Xf[ks] = *(const LAS bf16x8*)(lxc + (16 * tt8 + q) * 256 + (((4 * ks + G) ^ q) << 4));
        float xcv4[4], gtv4[4];
#pragma unroll
        for (int e = 0; e < 4; ++e) { const int tt = 16 * tt8 + 4 * G + e; const int so = tt * 256 + (xoff ^ ((tt & 15) << 4)) + xlo;
            xcv4[e] = bf1(*(const LAS bf16*)(lxc + so)); gtv4[e] = bf1(*(const LAS bf16*)(lgt + so)); }
        __builtin_amdgcn_sched_barrier(0);
#pragma unroll
        for (int ks = 0; ks < 4; ++ks) {
            aA = __builtin_amdgcn_mfma_f32_16x16x32_bf16(Xf[ks], Wa[ks], aA, 0, 0, 0); aX = __builtin_amdgcn_mfma_f32_16x16x32_bf16(Xf[ks], Wx[ks], aX, 0, 0, 0); }
        float Ac[4], Hc[4]; float Ar = 1.f, Hr = 0.f;
#pragma unroll
        for (int e = 0; e < 4; ++e) {
            const float xcv = xcv4[e];
            const float rg = sigmoid_fast(aA[e] + bav), ig = sigmoid_fast(aX[e] + bxv), la = -sp8 * rg, a = __builtin_amdgcn_exp2f(LOG2E * la);
            const float y = 2.0f * la; float pl = 1.0f / 120.0f; pl = pl * y + (1.0f / 24.0f); pl = pl * y + (1.0f / 6.0f); pl = pl * y + 0.5f; pl = pl * y + 1.0f;
            const float u = __builtin_amdgcn_sqrtf(-y * pl) * (ig * xcv);
            Hr = a * Hr + u; Ar = a * Ar; Ac[e] = Ar; Hc[e] = Hr; }
        float Ai = Ar, Hi = Hr;
        { const float Ap = __shfl_up(Ai, 16), Hp = __shfl_up(Hi, 16); if (G >= 1) { Hi = Ai * Hp + Hi; Ai = Ai * Ap; } }
        { const float Ap = __shfl_up(Ai, 32), Hp = __shfl_up(Hi, 32); if (G >= 2) { Hi = Ai * Hp + Hi; Ai = Ai * Ap; } }
        float Ae = __shfl_up(Ai, 16), He = __shfl_up(Hi, 16); if (G == 0) { Ae = 1.f; He = 0.f; }
        const float At = __shfl(Ai, 48 + q), Ht = __shfl(Hi, 48 + q);
        const float Ap0 = Ae * Arun, Hp0 = Ae * Hrun + He;
#pragma unroll
        for (int e = 0; e < 4; ++e) { const int tt = 16 * tt8 + 4 * G + e;
            const float Pv = Ac[e] * Ap0, hl = Hc[e] + Ac[e] * Hp0;
            const int so = tt * 256 + (xoff ^ ((tt & 15) << 4)) + xlo;
            const float gg = gelu_tanh(gtv4[e]);
            *(LAS bf16*)(ly0 + so) = f2bf(hl * gg); *(LAS bf16*)(ly1 + so) = f2bf(Pv * gg); }
        Hrun = At * Hrun + Ht; Arun = At * Arun;
    }
    if (G == 0) { Aend[(size_t)(b * 32 + chunk) * 512 + ch] = Arun; Hend[(size_t)(b * 32 + chunk) * 512 + ch] = Hrun; }
    __syncthreads();
    {
        const int c8 = tid & 15;
#pragma unroll
        for (int i = 0; i < 4; ++i) { const int tt = (tid >> 4) + 32 * i; const int so = tt * 256 + ((c8 ^ (tt & 15)) << 4); const size_t row = rowb + t0 + tt; const int cc = 128 * g + 8 * c8;
            *(GAS v4u*)(Y0 + row * y0p + cc) = *(const LAS v4u*)(ly0 + so); *(GAS v4u*)(Y1 + row * 512 + cc) = *(const LAS v4u*)(ly1 + so); }
    }
    __syncthreads();
}

__device__ __forceinline__ void post_unit(LAS unsigned char* lds, const bf16* __restrict__ num, const float* __restrict__ den, const bf16* __restrict__ Y0, int y0p, const bf16* __restrict__ Y1, const float* __restrict__ Aend, const float* __restrict__ Hend, bf16* __restrict__ aout, int uid, int tid) {
    asm volatile("" : "+v"(tid));
    const int row0 = uid * 64, b = row0 >> 12, chunk = (row0 & 4095) >> 7;
    LAS float* hin = (LAS float*)lds;
    { float H = 0.f; const float* ae = Aend + (size_t)(b * 32) * 512 + tid; const float* he = Hend + (size_t)(b * 32) * 512 + tid;
      int s0 = 0;
      for (; s0 + 8 <= chunk; s0 += 8) { float av[8], hv8[8];
#pragma unroll
          for (int j = 0; j < 8; ++j) { av[j] = ae[(size_t)(s0 + j) * 512]; hv8[j] = he[(size_t)(s0 + j) * 512]; }
#pragma unroll
          for (int j = 0; j < 8; ++j) H = av[j] * H + hv8[j]; }
      for (; s0 < chunk; ++s0) H = ae[(size_t)s0 * 512] * H + he[(size_t)s0 * 512];
      hin[tid] = H; }
    __syncthreads();
    const int c8 = tid & 63, rsub = tid >> 6, h = c8 >> 4;
    float hv[8];
#pragma unroll
    for (int e = 0; e < 8; ++e) hv[e] = hin[8 * c8 + e];
#pragma unroll
    for (int half = 0; half < 2; ++half) {
        v4u ya[4], yp[4], na[4], nb[4], nc[4]; float dn[4];
#pragma unroll
        for (int i = 0; i < 4; ++i) { const size_t row = row0 + rsub + 8 * (4 * half + i);
#ifdef POST_NT
            ya[i] = __builtin_nontemporal_load((const GAS v4u*)(Y0 + row * y0p + 8 * c8)); yp[i] = __builtin_nontemporal_load((const GAS v4u*)(Y1 + row * 512 + 8 * c8));
            na[i] = __builtin_nontemporal_load((const GAS v4u*)(num + ((size_t)0 * NUM_GS + row) * 512 + 8 * c8)); nb[i] = __builtin_nontemporal_load((const GAS v4u*)(num + ((size_t)1 * NUM_GS + row) * 512 + 8 * c8)); nc[i] = __builtin_nontemporal_load((const GAS v4u*)(num + ((size_t)2 * NUM_GS + row) * 512 + 8 * c8));
#else
            ya[i] = *(const GAS v4u*)(Y0 + row * y0p + 8 * c8); yp[i] = *(const GAS v4u*)(Y1 + row * 512 + 8 * c8);
            na[i] = *(const GAS v4u*)(num + ((size_t)0 * NUM_GS + row) * 512 + 8 * c8); nb[i] = *(const GAS v4u*)(num + ((size_t)1 * NUM_GS + row) * 512 + 8 * c8); nc[i] = *(const GAS v4u*)(num + ((size_t)2 * NUM_GS + row) * 512 + 8 * c8);
#endif
            dn[i] = den[((size_t)0 * T + row) * 4 + h] + den[((size_t)1 * T + row) * 4 + h] + den[((size_t)2 * T + row) * 4 + h]; }
#pragma unroll
        for (int i = 0; i < 4; ++i) { const size_t row = row0 + rsub + 8 * (4 * half + i);
            { const v4u a = ya[i], p = yp[i]; v4u o;
              o.x = pk2(bflo(a.x) + bflo(p.x) * hv[0], bfhi(a.x) + bfhi(p.x) * hv[1]); o.y = pk2(bflo(a.y) + bflo(p.y) * hv[2], bfhi(a.y) + bfhi(p.y) * hv[3]);
              o.z = pk2(bflo(a.z) + bflo(p.z) * hv[4], bfhi(a.z) + bfhi(p.z) * hv[5]); o.w = pk2(bflo(a.w) + bflo(p.w) * hv[6], bfhi(a.w) + bfhi(p.w) * hv[7]);
              *(GAS v4u*)(aout + row * 1024 + 512 + 8 * c8) = o; }
            { const float inv = 1.0f / dn[i]; const v4u a = na[i], bq = nb[i], c = nc[i]; v4u o;
              o.x = pk2((bflo(a.x) + bflo(bq.x) + bflo(c.x)) * inv, (bfhi(a.x) + bfhi(bq.x) + bfhi(c.x)) * inv); o.y = pk2((bflo(a.y) + bflo(bq.y) + bflo(c.y)) * inv, (bfhi(a.y) + bfhi(bq.y) + bfhi(c.y)) * inv);
              o.z = pk2((bflo(a.z) + bflo(bq.z) + bflo(c.z)) * inv, (bfhi(a.z) + bfhi(bq.z) + bfhi(c.z)) * inv); o.w = pk2((bflo(a.w) + bflo(bq.w) + bflo(c.w)) * inv, (bfhi(a.w) + bfhi(bq.w) + bfhi(c.w)) * inv);
              *(GAS v4u*)(aout + row * 1024 + 8 * c8) = o; } }
    }
    __syncthreads();
}

__device__ __forceinline__ f32x4 up4(v2u w) { return (f32x4){bflo(w.x), bfhi(w.x), bflo(w.y), bfhi(w.y)}; }
template <int W> __device__ __forceinline__ void poolprep_rows(const bf16* __restrict__ x, bf16* __restrict__ dd, const LAS float* rs  , size_t rbase  , int ts, int c) {
    v2u rw[W - 1 + 32];
#pragma unroll
    for (int i = 0; i < W - 1 + 32; ++i) { const int t = ts - (W - 1) + i; rw[i] = *(const GAS v2u*)(x + (t >= 0 ? rbase + i - (W - 1) : rbase) * 1024 + c); if (t < 0) rw[i] = (v2u){0u, 0u}; }
    f32x4 sum = (f32x4){0.f, 0.f, 0.f, 0.f};
#pragma unroll
    for (int i = 0; i < W - 1; ++i) sum += up4(rw[i]) * rs[15 - (W - 1) + i];
#pragma unroll
    for (int k = 0; k < 32; ++k) { const int t = ts + k;
        const f32x4 hcur = up4(rw[W - 1 + k]) * rs[15 + k];
        sum += hcur;
        const int cnt = (t + 1 < W) ? t + 1 : W; const float inv = 1.0f / (float)cnt;
        const f32x4 dv = sum * inv - hcur;
        v2u o; o.x = pk2(dv[0], dv[1]); o.y = pk2(dv[2], dv[3]); *(GAS v2u*)(dd + (rbase + k) * 1024 + c) = o;
        sum -= up4(rw[k]) * rs[15 + k - (W - 1)]; }
}
__device__ __forceinline__ void poolprep_unit(LAS unsigned char* lds, const bf16* x, const float* ss, bf16* dd, int pm, int g, int tid) {
    asm volatile("" : "+v"(tid));
    pm = __builtin_amdgcn_readfirstlane(pm); g = __builtin_amdgcn_readfirstlane(g);
    const int row0 = pm * 256, tb = row0 & 4095;
    LAS float* rs = (LAS float*)lds;
    if (tid < 271) { const int t = tb - 15 + tid; float r = 0.f;
        if (t >= 0) { const f32x4* p = (const f32x4*)(ss + (size_t)(row0 - 15 + tid) * 16); const f32x4 a = p[0], b4 = p[1], c4 = p[2], d4 = p[3];
            const float s = ((a[0] + a[1]) + (a[2] + a[3])) + ((b4[0] + b4[1]) + (b4[2] + b4[3])) + ((c4[0] + c4[1]) + (c4[2] + c4[3])) + ((d4[0] + d4[1]) + (d4[2] + d4[3]));
            r = 1.0f / sqrtf(s * (1.0f / 1024.0f) + EPS); }
        rs[tid] = r; }
    __syncthreads();
    const int c = 256 * g + 4 * (tid & 63), rblk = tid >> 6;
    const int ts = tb + 32 * rblk; const size_t rbase = (size_t)row0 + 32 * rblk; const LAS float* rsh = rs + 32 * rblk;
    if (g == 0) poolprep_rows<2>(x, dd, rsh, rbase, ts, c);
    else if (g == 1) poolprep_rows<4>(x, dd, rsh, rbase, ts, c);
    else if (g == 2) poolprep_rows<8>(x, dd, rsh, rbase, ts, c);
    else poolprep_rows<16>(x, dd, rsh, rbase, ts, c);
    __syncthreads();
}

#ifndef MK_TEST
constexpr int N_PHASES = 41;
__global__ void __launch_bounds__(NWAVES * 64, 2) mk_fwd(Args args) {
    extern __shared__ __attribute__((aligned(16))) unsigned char lds_raw[];
    LAS unsigned char* lds = (LAS unsigned char*)lds_raw;
    volatile LAS unsigned* MISC = (volatile LAS unsigned*)(lds + MISC_OFF);
#define ws ld_ws(args)
    const int tid = threadIdx.x, wave = __builtin_amdgcn_readfirstlane(tid >> 6);
    const int G = gridDim.x, bid = blockIdx.x;
    const int vcu = (G % 8 == 0) ? (bid % 8) * (G / 8) + bid / 8 : bid;
    const int gw = vcu * NWAVES + wave, NGW = G * NWAVES;
    const int p = (bid >> 3) & 3, c = (bid & 7) | ((bid >> 5) << 3);
    const int PG = 64, gwp = c * NWAVES + wave, NGWP = PG * NWAVES;
    for (int u = tid; u < (LDS_BYTES - LDSCTL_OFF) / 4; u += NWAVES * 64) ((LAS unsigned*)(lds + LDSCTL_OFF))[u] = 0u;
    __syncthreads();
    unsigned* ctl = (unsigned*)(ws + WS_CTL);
    XcdBarrier bar0; bar0.bar = ctl + 1024; bar0.x = 0; bar0.st = nullptr; bar0.G = 0;
    XcdBarrier bar = bar0;
    if (MK_N_LAUNCHES == 1) { bar0 = xcd_barrier_post(ctl + 1024, MISC + 8, (unsigned)G); bar = xcd_barrier_post(ctl + 1024 + 4096 * (1 + p), MISC + 10, (unsigned)PG); }
#if MK_N_LAUNCHES != 1
    const int lo = args.ph_lo, hi = args.ph_hi;
#endif
#if MK_N_LAUNCHES == 1
#define IN(k) true
#else
#define IN(k) (lo <= (k) && (k) < hi)
#endif
#ifdef GLOBAL_BAR
#define SEAM(k) do { if (MK_N_LAUNCHES == 1 && (k) + 1 < N_PHASES) { for (int b_ = 0; b_ < REP_BAR; ++b_) xcd_barrier(bar0); } } while (0)
#else
#define SEAM(k) do { if (MK_N_LAUNCHES == 1 && (k) + 1 < N_PHASES) { for (int b_ = 0; b_ < REP_BAR; ++b_) xcd_barrier(bar); } } while (0)
#endif
#define ZEROS ((const float*)(ws + WS_CTL + 98304))
#define LOCAL_SEAM() do { if (MK_N_LAUNCHES == 1) { asm volatile("s_waitcnt vmcnt(0)" ::: "memory"); __syncthreads(); if (tid == 0) { __builtin_amdgcn_fence(__ATOMIC_ACQUIRE, "agent"); asm volatile("s_waitcnt vmcnt(0)" ::: "memory"); } __syncthreads(); } } while (0)
#define RB ((size_t)p * SEQ)
#define SS ((float*)(ws + WS_SS) + RB * 16)
#define QSS ((float*)(ws + WS_QSS) + RB * 16)
#define LSUM ((float*)(ws + WS_LSUM) + RB * 16)
#define DEN ((float*)(ws + WS_DEN) + RB * 4)
#define AEND ((float*)(ws + WS_AEND) + (size_t)p * 32 * 512)
#define HEND ((float*)(ws + WS_HEND) + (size_t)p * 32 * 512)
#define XB ((bf16*)(ws + WS_XB) + RB * 1024)
#define HB (ws + WS_HID + (size_t)p * 32 * MiB)
#define PROJ ((bf16*)HB)
#define NUM ((bf16*)(HB + 20 * MiB))
#define AOUT ((bf16*)HB)
#define QB ((bf16*)(HB + 8 * MiB))
#define PB ((bf16*)(HB + 16 * MiB))
#define OB ((bf16*)(HB + 24 * MiB))
#define HID ((bf16*)HB)
#define DOP ((unsigned char*)OUTP() + (size_t)p * DO_PIPE)
#define Y0 ((bf16*)(DOP + DO_Y0))
#define Y1 ((bf16*)(DOP + DO_Y1))
#define KVRAW ((bf16*)(DOP + DO_KVRAW))
#define MEMN ((bf16*)(DOP + DO_MEMN))
#define KNP ((bf16*)(DOP + DO_KN))
#define VTP ((bf16*)(DOP + DO_VT))
#ifdef USE_STATIC_ORDER
#define PIPE_ORDER pg8::StaticOrder
#else
#define PIPE_ORDER pg8::XcdOrder
#endif
#ifndef P0B_C0
#define P0B_C0 0
#define P0B_C1 4
#define P0B_C2 12
#endif
#ifndef P0_INFLIGHT
#define P0_INFLIGHT 2
#endif
#ifndef HID_SLAB
#define HID_SLAB 0
#endif
#ifndef CLK_PH
#define CLK_PH -1
#endif
#ifndef STAG
#define STAG 2000
#endif
    if (IN(0)) { REPEAT(REP_P0) { p0_prologue(args, lds, gw, NGW, wave); if (MK_N_LAUNCHES == 1 && rep_ + 1 < REP_P0) xcd_barrier(bar0); }
        if (MK_N_LAUNCHES == 1) { xcd_barrier(bar0);
#ifdef P0_SLEEP_SKEW
            const unsigned long long t0_ = wall_clock64(); const unsigned long long dl_ = (unsigned long long)p * STAG; while (wall_clock64() - t0_ < dl_) __builtin_amdgcn_s_sleep(8);
            if (p > 0) p0_items<1>(args, lds, (p == 1 ? 0 : p == 2 ? P0_NB / 6 : P0_NB / 2), (p == 1 ? P0_NB / 6 : p == 2 ? P0_NB / 2 : P0_NB), gwp, NGWP, wave);
#else
            { constexpr int U = P0_NB / 24; const int c0 = P0B_C0 * U, c1 = P0B_C1 * U, c2 = P0B_C2 * U;
              const int f_ = p == 0 ? 0 : p == 1 ? c0 : p == 2 ? c1 : c2, l_ = p == 0 ? c0 : p == 1 ? c1 : p == 2 ? c2 : P0_NB;
              if (l_ > f_) p0_items<1>(args, lds, f_, l_, gwp, NGWP, wave); }
#endif
            {
                asm volatile("s_waitcnt vmcnt(0)" ::: "memory"); __syncthreads();
                if (tid == 0) { __builtin_amdgcn_fence(__ATOMIC_RELEASE, "agent"); asm volatile("s_waitcnt vmcnt(0)" ::: "memory"); (void)xb_add(ctl + 512, 1u); } } } }

    for (int l = 0; l < 4; ++l) {
        const int pb = 1 + 10 * l;
        if (l == 1 && MK_N_LAUNCHES == 1) {
            if (tid == 0) { XB_SPIN(xb_ld(ctl + 512) < 256u, bar0.bar); __builtin_amdgcn_fence(__ATOMIC_ACQUIRE, "agent"); asm volatile("s_waitcnt vmcnt(0)" ::: "memory"); }
            __syncthreads(); }
        if ((l & 1) == 0) {
            const int e = l >> 1;
            if (IN(pb + 0)) { REPEAT(REP_A1) {
                { pg8::Gemm g{XB, (const bf16*)(ws + WS_WIN) + (size_t)e * INC * D, D, D, D, ~0, 0, (long)256 * D, 30, 0};
                  PIPE_ORDER S; S.init(SEQ / 256, INC / 256, PG, c);
                  pg8::EpiBf16<1> E{PROJ, INC, SS, nullptr};
                  pg8::gemm_phase(lds, g, S, E); }
                if (l == 0) { pg8::Gemm g{MEMN, (const bf16*)(ws + WS_WKV), D, D, D, 0, 0, (long)256 * D, 0, (long)2048 * D};
                  pg8::StaticOrder S; S.init(4, 8, PG - 32, c >= 32 ? c - 32 : (1 << 20));
                  pg8::EpiBf16<0> E{KVRAW, 2048, nullptr, nullptr};
                  pg8::gemm_phase(lds, g, S, E); }
                REP_SEAM(REP_A1); }
                SEAM(pb + 0); }
            if (IN(pb + 1)) { REPEAT(REP_A2) {
                if (l == 0) for (int r2_ = 0; r2_ < REP_KVF; ++r2_) kv_finalize(args, KVRAW, KNP, VTP, gwp, NGWP);
                for (int r2_ = 0; r2_ < REP_ATTN; ++r2_) {
                    for (int sgi = 0; sgi < 2; ++sgi) {
                        int g_, h_, r_, n0_, L_;
                        if (sgi == 1) { g_ = 2; h_ = c >> 4; r_ = c & 15; n0_ = 0; L_ = 2; }
                        else if (c < 32) { g_ = 0; h_ = c >> 3; r_ = 0; n0_ = 4 * (c & 7); L_ = 4; }
                        else { const int id = c - 32, chain = id >> 1; g_ = 1; h_ = chain >> 2; r_ = chain & 3; n0_ = 4 * (id & 1); L_ = 4; }
#ifdef CLK_ACC
                        const unsigned long long ta0_ = wall_clock64();
#endif
                        attn_segment(lds, PROJ, INP(7) + e * 128, INP(8) + e * 128, NUM, DEN, g_, h_, r_, n0_, L_, tid);
#ifdef CLK_ACC
                        if (tid == 0) MISC[16 + 7] += (unsigned)(wall_clock64() - ta0_);
#endif
                    }
                }
                for (int u = c; u < 128; u += PG) for (int r2_ = 0; r2_ < REP_R1; ++r2_) {
#ifdef CLK_ACC
                    const unsigned long long tr0_ = wall_clock64();
#endif
                    r1_unit(lds, PROJ, INP(9) + e * 2048, INP(10) + e * 512, (const bf16*)(ws + WS_GT) + (size_t)((e * 2 + 0) * 4 + (u & 3)) * 16384, (const bf16*)(ws + WS_GT) + (size_t)((e * 2 + 1) * 4 + (u & 3)) * 16384,
                            INP(12) + e * 512, INP(14) + e * 512, INP(15) + e * 512, Y0, 512, Y1, AEND, HEND, u, tid);
#ifdef CLK_ACC
                    if (tid == 0) MISC[16 + 6] += (unsigned)(wall_clock64() - tr0_);
#endif
                }
                REP_SEAM(REP_A2); }
                SEAM(pb + 1); }
            if (IN(pb + 2)) { REPEAT(REP_A3) {
                post_unit(lds, NUM, DEN, Y0, 512, Y1, AEND, HEND, AOUT, c, tid);
                REP_SEAM(REP_A3); }
                SEAM(pb + 2); }
            if (IN(pb + 3)) { REPEAT(REP_A4) {
                pg8::Gemm g{AOUT, (const bf16*)(ws + WS_WOUT) + (size_t)e * D * D, D, D, D, ~0, 0, (long)256 * D, 30, 0};
                PIPE_ORDER S; S.init(SEQ / 256, 4, PG, c);
                pg8::EpiRes E{nullptr, XB, SS, rep_ ? ZEROS : nullptr};
                pg8::gemm_phase(lds, g, S, E);
                REP_SEAM(REP_A4); }
                SEAM(pb + 3); }
        } else {
            const int o = l >> 1;
            if (IN(pb + 0)) { REPEAT(REP_B1) {
                { PIPE_ORDER S; S.init(SEQ / 256, 4, PG, c); pg8::Unit u; if (S.next(0, u)) poolprep_unit(lds, XB, SS, AOUT, u.pm, u.pn, tid); }
                REP_SEAM(REP_B1); }
                LOCAL_SEAM(); }
            if (IN(pb + 1)) { REPEAT(REP_B2) {
                pg8::Gemm g{AOUT, (const bf16*)(ws + WS_POOLT) + (size_t)o * 4 * 65536, D, 256, 256, ~0, 256, (long)65536, 30, 0};
                PIPE_ORDER S; S.init(SEQ / 256, 4, PG, c);
                pg8::EpiRes E{nullptr, XB, SS, rep_ ? ZEROS : INP(18) + o * D};
                pg8::gemm_phase(lds, g, S, E);
                REP_SEAM(REP_B2); }
                SEAM(pb + 3); }
        }
#ifdef CLK_ACC
        if (tid == 0) MISC[16 + 14] = (CLK_PH == 4 || CLK_PH < 0) ? 1u : 0u;
#endif
        if (IN(pb + 4)) { REPEAT(REP_X1) {
            pg8::Gemm g{XB, (const bf16*)(ws + WS_WQ) + (size_t)l * D * D, D, D, D, ~0, 0, (long)256 * D, 30, 0};
            PIPE_ORDER S; S.init(SEQ / 256, 4, PG, c);
            pg8::EpiBf16<3> E{QB, D, SS, QSS};
            pg8::gemm_phase(lds, g, S, E);
            REP_SEAM(REP_X1); }
#ifdef NO_LOCAL_SEAM
            SEAM(pb + 4);
#else
            LOCAL_SEAM();
#endif
            }
#ifndef XA_UNFUSED
        if (IN(pb + 5)) { REPEAT(REP_X2) {
            { PIPE_ORDER S; S.init(SEQ / 256, 4, PG, c); pg8::Unit u; if (S.next(0, u)) xa_unit(lds, QB, QSS, KNP + (size_t)l * 4 * 65536 + (size_t)u.pn * 65536, VTP + (size_t)l * 4 * 65536 + (size_t)u.pn * 65536, OB, u.pm, u.pn, tid); }
            REP_SEAM(REP_X2); }
            SEAM(pb + 6); }
#else
        if (IN(pb + 5)) { REPEAT(REP_X2) {
            pg8::Gemm g{QB, KNP + (size_t)l * 4 * 65536, D, 256, 256, ~0, 256, (long)65536, 30, 0};
            PIPE_ORDER S; S.init(SEQ / 256, 4, PG, c);
            pg8::EpiBf16<4> E{PB, D, QSS, LSUM};
            pg8::gemm_phase(lds, g, S, E);
            REP_SEAM(REP_X2); }
#ifdef NO_LOCAL_SEAM
            SEAM(pb + 5);
#else
            LOCAL_SEAM();
#endif
            }
        if (IN(pb + 6)) { REPEAT(REP_X3) {
            pg8::Gemm g{PB, VTP + (size_t)l * 4 * 65536, D, 256, 256, ~0, 256, (long)65536, 30, 0};
            PIPE_ORDER S; S.init(SEQ / 256, 4, PG, c);
            pg8::EpiBf16<5> E{OB, D, LSUM, nullptr};
            pg8::gemm_phase(lds, g, S, E);
            REP_SEAM(REP_X3); }
            SEAM(pb + 6); }
#endif
        if (IN(pb + 7)) { REPEAT(REP_X4) {
            pg8::Gemm g{OB, (const bf16*)(ws + WS_WO) + (size_t)l * D * D, D, D, D, ~0, 0, (long)256 * D, 30, 0};
            PIPE_ORDER S; S.init(SEQ / 256, 4, PG, c);
            pg8::EpiRes E{nullptr, XB, SS, rep_ ? ZEROS : nullptr};
            pg8::gemm_phase(lds, g, S, E);
            REP_SEAM(REP_X4); }
            SEAM(pb + 7); }
#ifdef CLK_ACC
        if (tid == 0) MISC[16 + 14] = (CLK_PH == 8 || CLK_PH < 0) ? 1u : 0u;
#endif
        if (IN(pb + 8)) { REPEAT(REP_M1) {
            pg8::Gemm g{XB, (const bf16*)(ws + WS_W1) + (size_t)l * FF * D, D, D, D, ~0, 0, (long)256 * D, 30, 0};
            PIPE_ORDER S; S.init(SEQ / 256, FF / 256, PG, c);
            pg8::EpiBf16<2, HID_SLAB != 0> E{HID, FF, SS, nullptr};
            pg8::gemm_phase(lds, g, S, E);
            REP_SEAM(REP_M1); }
            SEAM(pb + 8); }
#ifdef CLK_ACC
        if (tid == 0) MISC[16 + 14] = (CLK_PH == 9 || CLK_PH < 0) ? 1u : 0u;
#endif
        if (IN(pb + 9)) { REPEAT(REP_M2) {
            pg8::Gemm g{HID, (const bf16*)(ws + WS_W2) + (size_t)l * D * FF, HID_SLAB ? 64 : FF, FF, FF, ~0, 0, (long)256 * FF, 30, 0, HID_SLAB ? (long)256 * 64 : (long)64, (long)256 * FF};
            PIPE_ORDER S; S.init(SEQ / 256, 4, PG, c);
            pg8::EpiRes E{(l == 3 && rep_ == 0) ? OUTP() + RB * 1024 : nullptr, XB, SS, rep_ ? ZEROS : nullptr};
            pg8::gemm_phase(lds, g, S, E);
            REP_SEAM(REP_M2); }
            SEAM(pb + 9); }
    }
#ifdef CLK_ACC
    xcd_barrier(bar0);
    if (bid == 0 && tid == 0) { const float us = (float)MISC[16 + CLK_ACC] * 0.01f; OUTP()[0] = floorf(us / (float)CLK_STEP + 0.5f) * (float)CLK_STEP * 1000.0f; }
#endif
#ifdef WS_PROBE
    xcd_barrier(bar0);
    if (bid == 0 && tid == 0) OUTP()[0] = (float)args.ph_hi * 1000.0f;
#endif
#undef IN
#undef SEAM
#undef ws
}
#endif

extern "C" void kernel_launch(void* const* d_in, const int* in_sizes, int n_in, void* d_out, int out_size, void* d_ws, size_t ws_size, hipStream_t stream) {
    static int grid = 0;
    if (grid == 0) {
        if (n_in != 26 || in_sizes[0] != T * D || out_size != T * D || ws_size < WS_END) { fprintf(stderr, "kernel_launch: unexpected shapes: n_in %d in0 %d out %d ws %zu (need %zu); nothing launched\n", n_in, n_in > 0 ? in_sizes[0] : -1, out_size, ws_size, (size_t)WS_END); grid = -1; return; }
        int dev = 0, cus = 0, per_cu = 0;
        if (hipGetDevice(&dev) != hipSuccess || hipDeviceGetAttribute(&cus, hipDeviceAttributeMultiprocessorCount, dev) != hipSuccess) { grid = -1; return; }
        if (hipFuncSetAttribute((const void*)mk_fwd, hipFuncAttributeMaxDynamicSharedMemorySize, LDS_BYTES) != hipSuccess) { fprintf(stderr, "kernel_launch: hipFuncSetAttribute failed\n"); grid = -1; return; }
        if (hipOccupancyMaxActiveBlocksPerMultiprocessor(&per_cu, (const void*)mk_fwd, NWAVES * 64, LDS_BYTES) != hipSuccess || per_cu < 1) fprintf(stderr, "kernel_launch: occupancy query reports %d\n", per_cu);
        (void)hipGetLastError();
        grid = cus;
        if (grid != 256) fprintf(stderr, "kernel_launch: %d CUs (built for 256)\n", grid);
    }
    if (grid < 0) return;
    (void)hipMemsetAsync((char*)d_ws + WS_CTL, 0, CTL_ZERO_BYTES, stream);
    Args a{};
    for (int i = 0; i < 26; ++i) a.p.in[i] = (const float*)d_in[i];
    a.p.out = (float*)d_out; a.p.ws = (unsigned char*)d_ws;
    if (MK_N_LAUNCHES == 1) { a.ph_lo = 0; a.ph_hi = N_PHASES;
#ifdef WS_PROBE
        a.ph_hi = (int)(ws_size >> 20);
#endif
 hipLaunchKernelGGL(mk_fwd, dim3(grid), dim3(NWAVES * 64), LDS_BYTES, stream, a); }
    else {
        for (int k = 0; k < N_PHASES; ++k) {
            const int l = (k - 1) / 10, s = (k - 1) % 10;
            if (k > 0 && (l & 1) == 1 && (s == 2 || s == 3)) continue;
            a.ph_lo = k; a.ph_hi = k + 1; hipLaunchKernelGGL(mk_fwd, dim3(grid), dim3(NWAVES * 64), LDS_BYTES, stream, a);
        }
    }
}
```

```cpp
#include <hip/hip_runtime.h>
#include <cstdio>
#include <cstdint>

#ifdef P0_NT_STORE
#define P0_NTS(set) ((set) >= (2 - P0_NT_STORE))
#else
#define P0_NTS(set) false
#endif
#ifndef NO_STREAM_NT
#define ATT_NT_STORE 1
#define POST_NT 1
#endif
#ifndef P0_NO_NT
#define P0_NT 1
#endif

#ifndef ATT_PREFETCH
#define ATT_NOPF 1
#ifndef ATT_NO_PF_MID
#define ATT_PF_MID 1
#endif
#endif
#ifndef MK_N_LAUNCHES
#define MK_N_LAUNCHES 1
#endif

#ifndef REP_P0
#define REP_P0 1
#endif
#ifndef REP_A1
#define REP_A1 1
#endif
#ifndef REP_A2
#define REP_A2 1
#endif
#ifndef REP_A3
#define REP_A3 1
#endif
#ifndef REP_A4
#define REP_A4 1
#endif
#ifndef REP_B1
#define REP_B1 1
#endif
#ifndef REP_B2
#define REP_B2 1
#endif
#ifndef REP_X1
#define REP_X1 1
#endif
#ifndef REP_X2
#define REP_X2 1
#endif
#ifndef REP_X3
#define REP_X3 1
#endif
#ifndef REP_X4
#define REP_X4 1
#endif
#ifndef REP_M1
#define REP_M1 1
#endif
#ifndef REP_M2
#define REP_M2 1
#endif
#ifndef REP_BAR
#define REP_BAR 1
#endif
#ifndef REP_ATTN
#define REP_ATTN 1
#endif
#ifndef REP_R1
#define REP_R1 1
#endif
#ifndef REP_KVF
#define REP_KVF 1
#endif
#define REPEAT(n) for (int rep_ = 0; rep_ < (n); ++rep_)
#define REP_SEAM(n) do { if (rep_ + 1 < (n)) xcd_barrier(bar); } while (0)
namespace pg8 {
#define PG8_LAS __attribute__((address_space(3)))
typedef unsigned short bf16_t;
typedef short bf16x8 __attribute__((ext_vector_type(8)));
typedef float f32x4 __attribute__((ext_vector_type(4)));
typedef float f32x2 __attribute__((ext_vector_type(2)));
typedef unsigned u32x4 __attribute__((ext_vector_type(4)));
typedef unsigned u32x2 __attribute__((ext_vector_type(2)));
#ifdef PG8_COLS_SPLIT
constexpr int WCS = 32, BJS = 128;
#else
constexpr int WCS = 64, BJS = 32;
#endif
constexpr int BM = 256, BK = 64, HALF = 128, HTB = HALF * BK * 2, STAGE_BYTES = 8 * HTB, NXCD = 8, WGM = 8;

__host__ __device__ __forceinline__ int lds_byte(int r, int c) { const int st = (r >> 4) * 2 + (c >> 5), rr = r & 15, cc = c & 31, ob = rr * 64 + cc * 2; return st * 1024 + (ob ^ (((ob >> 9) & 1) << 5)); }
__host__ __device__ __forceinline__ void stage_rc(int b, int& R, int& C) { const int st = b / 1024, sb = b % 1024, swz = sb ^ (((sb >> 9) & 1) << 5); R = (st >> 1) * 16 + swz / 64; C = (st & 1) * 32 + (swz % 64) / 2; }
__host__ __device__ __forceinline__ int perm32(int rho) { const int n = rho >> 4, i = rho & 15; return 8 * (i >> 2) + 4 * n + (i & 3); }

struct Unit { int pm, pn; };
struct Gemm { const bf16_t* A; const bf16_t* Bt; int lda, ldb, K; int a_pm_mask, a_pn_cols; long b_pn_elems; int b_pm_shift; long b_batch_elems; long a_kstep = BK; long a_pm_elems = 0  ; };

struct StaticOrder {
    int nM, nN, nwg, G, c;
    __host__ __device__ __forceinline__ void init(int nM_, int nN_, int G_, int c_) { nM = nM_; nN = nN_; nwg = nM * nN; G = G_; c = c_; }
    __host__ __device__ __forceinline__ bool next(int i, Unit& u) const {
        const long L = (long)i * G + c; if (L >= nwg) return false;
        int wgid = (int)L; { const int q = nwg / NXCD, r = nwg % NXCD, xcd = wgid % NXCD, off = wgid / NXCD; wgid = (xcd < r ? xcd * (q + 1) : r * (q + 1) + (xcd - r) * q) + off; }
        const int nig = WGM * nN, gid = wgid / nig, fm = gid * WGM, gsz = (nM - fm) < WGM ? (nM - fm) : WGM;
        u.pm = fm + ((wgid % nig) % gsz); u.pn = (wgid % nig) / gsz; return true;
    }
};

struct XcdOrder {
    int nMx, nN, J, x, j;
    __host__ __device__ __forceinline__ void init(int nM, int nN_, int G, int c) { nMx = nM / 8; nN = nN_; J = G / 8; x = c & 7; j = c >> 3; }
    __host__ __device__ __forceinline__ bool next(int i, Unit& u) const {
#ifdef XCD_ORDER_KEEPROW
        if (nMx == 2 && J == 8 && (nN & 3) == 0) { if (4 * i >= nN) return false; u.pm = x * 2 + ((j >> 2) & 1); u.pn = (j & 3) + 4 * i; return true; }
#endif
        const int q = j + J * i; if (q >= nMx * nN) return false; u.pm = x * nMx + q / nN; u.pn = q % nN; return true; }
};

__device__ __forceinline__ unsigned cvt_pk_bf16(float lo, float hi) { unsigned r; asm volatile("v_cvt_pk_bf16_f32 %0, %1, %2" : "=v"(r) : "v"(lo), "v"(hi)); return r; }

constexpr float EPS = 1e-6f;
template <int MODE, bool SLAB = false> struct EpiBf16 {
    static constexpr bool PERM = true;
    bf16_t* O; int ldc; const float* aux_in; float* aux_out;
    mutable int cpm = -1; mutable float cf[8] = {0.f, 0.f, 0.f, 0.f, 0.f, 0.f, 0.f, 0.f};
    __device__ __forceinline__ void operator()(const f32x4 (&acc)[2][2][4][2], const Unit& u, int wr, int wc, int fr, int fq) const {
        const int row0 = u.pm * BM + wr * 64 + fr, col0 = u.pn * BM + wc * WCS + 8 * fq;
        if ((MODE == 1 || MODE == 2) && u.pm != cpm) {
            f32x4 v[8];
#pragma unroll
            for (int i = 0; i < 8; ++i) v[i] = *(const f32x4*)(aux_in + (size_t)(row0 + (i >> 2) * HALF + (i & 3) * 16) * 16 + fq * 4);
#pragma unroll
            for (int i = 0; i < 8; ++i) { float s = (v[i][0] + v[i][1]) + (v[i][2] + v[i][3]); s += __shfl_xor(s, 16); s += __shfl_xor(s, 32); cf[i] = __builtin_amdgcn_rsqf(s * (1.0f / 1024.0f) + EPS); }
            cpm = u.pm; }
#pragma unroll
        for (int ai = 0; ai < 2; ++ai)
#pragma unroll
            for (int m = 0; m < 4; ++m) {
                const int row = row0 + ai * HALF + m * 16; float f = 1.f;
                if (MODE == 1 || MODE == 2) f = cf[ai * 4 + m];
                if (MODE == 3) { const f32x4 v = *(const f32x4*)(aux_in + (size_t)row * 16 + fq * 4); float s = (v[0] + v[1]) + (v[2] + v[3]); s += __shfl_xor(s, 16); s += __shfl_xor(s, 32); f = __builtin_amdgcn_rsqf(s * (1.0f / 1024.0f) + EPS); }
                if (MODE == 4) { const f32x4 v = *(const f32x4*)(aux_in + (size_t)row * 16 + u.pn * 4); const float s = (v[0] + v[1]) + (v[2] + v[3]); f = __builtin_amdgcn_rsqf(s * (1.0f / 256.0f) + EPS); }
                if (MODE == 5) { const f32x4 v = *(const f32x4*)(aux_in + (size_t)row * 16 + u.pn * 4); const float s = (v[0] + v[1]) + (v[2] + v[3]); f = 1.0f / s; }
                bf16_t* rowp = SLAB ? O + ((size_t)(u.pm * (ldc >> 6) + u.pn * 4 + wc) * 256 + (row & 255)) * 64 + 8 * fq : O + (size_t)row * ldc + col0; float part = 0.f;
#pragma unroll
                for (int bj = 0; bj < 2; ++bj) { f32x4 v0 = acc[ai][bj][m][0] * f, v1 = acc[ai][bj][m][1] * f;
                    if (MODE == 2) {
#pragma unroll
                        for (int e = 0; e < 4; ++e) { const float a = v0[e] > 0.f ? v0[e] : 0.f, b = v1[e] > 0.f ? v1[e] : 0.f; v0[e] = a * a; v1[e] = b * b; } }
                    if (MODE == 4) {
#pragma unroll
                        for (int e = 0; e < 4; ++e) { v0[e] = __builtin_amdgcn_exp2f(v0[e]); v1[e] = __builtin_amdgcn_exp2f(v1[e]); } }
                    if (MODE == 3) part += (v0[0] * v0[0] + v0[1] * v0[1]) + (v0[2] * v0[2] + v0[3] * v0[3]) + (v1[0] * v1[0] + v1[1] * v1[1]) + (v1[2] * v1[2] + v1[3] * v1[3]);
                    if (MODE == 4) part += (v0[0] + v0[1]) + (v0[2] + v0[3]) + (v1[0] + v1[1]) + (v1[2] + v1[3]);
                    u32x4 w; w.x = cvt_pk_bf16(v0[0], v0[1]); w.y = cvt_pk_bf16(v0[2], v0[3]); w.z = cvt_pk_bf16(v1[0], v1[1]); w.w = cvt_pk_bf16(v1[2], v1[3]);
                    *(u32x4*)(rowp + bj * BJS) = w; }
                if (MODE == 3 || MODE == 4) { part += __shfl_xor(part, 16); part += __shfl_xor(part, 32); if (fq == 0) aux_out[(size_t)row * 16 + u.pn * 4 + wc] = part; }
            }
    }
};
struct EpiRes {
    static constexpr bool PERM = true;
    float* out32; bf16_t* xb; float* ss; const float* scale;
    __device__ __forceinline__ void operator()(const f32x4 (&acc)[2][2][4][2], const Unit& u, int wr, int wc, int fr, int fq) const {
        const int row0 = u.pm * BM + wr * 64 + fr, col0 = u.pn * BM + wc * WCS + 8 * fq;
#pragma unroll
        for (int ai = 0; ai < 2; ++ai) {
            u32x4 xw[4][2];
#pragma unroll
            for (int m = 0; m < 4; ++m)
#pragma unroll
                for (int bj = 0; bj < 2; ++bj) xw[m][bj] = *(const u32x4*)(xb + (size_t)(row0 + ai * HALF + m * 16) * 1024 + col0 + bj * BJS);
#pragma unroll
            for (int m = 0; m < 4; ++m) {
                const int row = row0 + ai * HALF + m * 16; const size_t off = (size_t)row * 1024 + col0; float sq = 0.f;
#pragma unroll
                for (int bj = 0; bj < 2; ++bj) { const int co = bj * BJS; f32x4 a0 = acc[ai][bj][m][0], a1 = acc[ai][bj][m][1];
                    if (scale) { a0 = a0 * *(const f32x4*)(scale + col0 + co); a1 = a1 * *(const f32x4*)(scale + col0 + co + 4); }
                    const u32x4 w = xw[m][bj];
                    f32x4 x0 = (f32x4){__uint_as_float(w.x << 16), __uint_as_float(w.x & 0xffff0000u), __uint_as_float(w.y << 16), __uint_as_float(w.y & 0xffff0000u)};
                    f32x4 x1 = (f32x4){__uint_as_float(w.z << 16), __uint_as_float(w.z & 0xffff0000u), __uint_as_float(w.w << 16), __uint_as_float(w.w & 0xffff0000u)};
                    x0 = x0 + a0; x1 = x1 + a1;
                    if (out32) { *(f32x4*)(out32 + off + co) = x0; *(f32x4*)(out32 + off + co + 4) = x1; }
                    else { sq += ((x0[0] * x0[0] + x0[1] * x0[1]) + (x0[2] * x0[2] + x0[3] * x0[3])) + ((x1[0] * x1[0] + x1[1] * x1[1]) + (x1[2] * x1[2] + x1[3] * x1[3]));
                           u32x4 o; o.x = cvt_pk_bf16(x0[0], x0[1]); o.y = cvt_pk_bf16(x0[2], x0[3]); o.z = cvt_pk_bf16(x1[0], x1[1]); o.w = cvt_pk_bf16(x1[2], x1[3]); *(u32x4*)(xb + off + co) = o; } }
                if (!out32) { sq += __shfl_xor(sq, 16); sq += __shfl_xor(sq, 32); if (fq == 0) ss[(size_t)row * 16 + u.pn * 4 + wc] = sq; }
            }
            asm volatile("" ::: "memory");
        }
    }
};

template <class Epi, class Sched>
__device__ __forceinline__ void gemm_phase(PG8_LAS unsigned char* lds, const Gemm g, const Sched& S, const Epi& E) {
    int tid_ = threadIdx.x; asm volatile("" : "+v"(tid_));
    const int tid = tid_, wid = __builtin_amdgcn_readfirstlane(tid >> 6), lane = tid & 63, wr = wid >> 2, wc = wid & 3, fr = lane & 15, fq = lane >> 4;
    int K_ = g.K; asm volatile("" : "+s"(K_));
    const int K = K_, nt = K / BK;
    unsigned voffA[2], voffB[2];
#pragma unroll
    for (int i = 0; i < 2; ++i) { int R, C; stage_rc(tid * 16 + i * 8192, R, C); const int Rb = Epi::PERM ? ((R >> 5) * WCS + perm32(R & 31)) : R;
        voffA[i] = (unsigned)(R * g.lda + C) * 2u; voffB[i] = (unsigned)(Rb * g.ldb + C) * 2u; }
    const size_t kstep = (size_t)(BK * 2), kstepA = (size_t)g.a_kstep * 2;
    const size_t hstepA = (size_t)HALF * g.lda * 2, hstepB = (size_t)(Epi::PERM ? BJS : HALF) * g.ldb * 2;
    const unsigned ldsw = (unsigned)wid * 1024u;
    const int aoff = lds_byte(wr * 64 + fr, fq * 8), boff = lds_byte(wc * 32 + fr, fq * 8);
#define PG8_SA(b, h) (((b) * 2 + (h)) * HTB)
#define PG8_SB(b, h) ((4 + (b) * 2 + (h)) * HTB)
#define PG8_STAGE(bufoff, gbase, voff) do { _Pragma("unroll") for (int _i = 0; _i < 2; ++_i) \
        __builtin_amdgcn_global_load_lds((const unsigned*)((const char*)(gbase) + (voff)[_i]), (PG8_LAS unsigned*)(lds + (bufoff) + ldsw + _i * 8192), 16, 0, 0); } while (0)
#define PG8_LDA(dst, b, h) do { _Pragma("unroll") for (int m = 0; m < 4; ++m) _Pragma("unroll") for (int k = 0; k < 2; ++k) dst[m][k] = *(const PG8_LAS bf16x8*)(lds + PG8_SA(b, h) + aoff + m * 2048 + k * 1024); } while (0)
#define PG8_LDB(dst, b, h) do { _Pragma("unroll") for (int n = 0; n < 2; ++n) _Pragma("unroll") for (int k = 0; k < 2; ++k) dst[n][k] = *(const PG8_LAS bf16x8*)(lds + PG8_SB(b, h) + boff + n * 2048 + k * 1024); } while (0)
#ifdef PG8_NO_SETPRIO
#define PG8_SETPRIO(x)
#else
#ifndef PG8_PRIO_HI
#define PG8_PRIO_HI 1
#endif
#ifdef PG8_PRIO_STATIC
#define PG8_SETPRIO(x)
#elif defined(PG8_PRIO_INV)
#define PG8_SETPRIO(x) __builtin_amdgcn_s_setprio((x) ? 0 : 2)
#else
#define PG8_SETPRIO(x) __builtin_amdgcn_s_setprio((x) ? PG8_PRIO_HI : 0)
#endif
#endif
#define PG8_MMA(ai, bj, At, Bt) do { PG8_SETPRIO(1); _Pragma("unroll") for (int m = 0; m < 4; ++m) _Pragma("unroll") for (int n = 0; n < 2; ++n) _Pragma("unroll") for (int k = 0; k < 2; ++k) \
        acc[ai][bj][m][n] = __builtin_amdgcn_mfma_f32_16x16x32_bf16(Bt[n][k], At[m][k], acc[ai][bj][m][n], 0, 0, 0); PG8_SETPRIO(0); } while (0)
#define PG8_MMA_ST(ai, bj, At, Bt, so0, g0, so1, g1) do { PG8_SETPRIO(1); _Pragma("unroll") for (int m = 0; m < 4; ++m) { _Pragma("unroll") for (int n = 0; n < 2; ++n) _Pragma("unroll") for (int k = 0; k < 2; ++k) \
        acc[ai][bj][m][n] = __builtin_amdgcn_mfma_f32_16x16x32_bf16(Bt[n][k], At[m][k], acc[ai][bj][m][n], 0, 0, 0); \
        if (m == 0) { PG8_SCHED; PG8_STAGE(so0, g0, voffB); PG8_SCHED; } if (m == 2) { PG8_SCHED; PG8_STAGE(so1, g1, voffB); PG8_SCHED; } } PG8_SETPRIO(0); } while (0)
#define PG8_WAIT_V(n) asm volatile("s_waitcnt vmcnt(" #n ")" ::: "memory")
#define PG8_WAIT_L(n) asm volatile("s_waitcnt lgkmcnt(" #n ")" ::: "memory")
#define PG8_BAR __builtin_amdgcn_s_barrier()
#define PG8_SCHED __builtin_amdgcn_sched_barrier(0)
#define PG8_APTR(u) ((const char*)g.A + ((size_t)((u).pm & g.a_pm_mask) * (g.a_pm_elems ? (size_t)g.a_pm_elems : (size_t)256 * g.lda) + (size_t)(u).pn * g.a_pn_cols) * 2)
#define PG8_BPTR(u) ((const char*)g.Bt + ((size_t)(u).pn * g.b_pn_elems + (size_t)((u).pm >> g.b_pm_shift) * g.b_batch_elems) * 2)
    Unit cur, nxt; int ui = 0;
    if (!S.next(0, cur)) return;
#ifdef PG8_PRIO_STATIC
    if (wid >= 4) __builtin_amdgcn_s_setprio(1);
#endif
#ifdef CLK_ACC
    unsigned long long tp0_ = wall_clock64();
#endif
    f32x4 acc[2][2][4][2];
#pragma unroll
    for (int a = 0; a < 2; ++a)
#pragma unroll
        for (int b = 0; b < 2; ++b)
#pragma unroll
            for (int m = 0; m < 4; ++m)
#pragma unroll
                for (int n = 0; n < 2; ++n) acc[a][b][m][n] = (f32x4){0.f, 0.f, 0.f, 0.f};
    bf16x8 At[4][2], B0[2][2], B1[2][2];
    const char* cA = PG8_APTR(cur); const char* cB = PG8_BPTR(cur);
    PG8_STAGE(PG8_SB(0, 0), cB, voffB); PG8_STAGE(PG8_SB(0, 1), cB + hstepB, voffB); PG8_STAGE(PG8_SA(0, 0), cA, voffA); PG8_STAGE(PG8_SA(0, 1), cA + hstepA, voffA);
    PG8_STAGE(PG8_SB(1, 0), cB + kstep, voffB); PG8_STAGE(PG8_SA(1, 0), cA + kstepA, voffA); PG8_STAGE(PG8_SB(1, 1), cB + hstepB + kstep, voffB);
    if (wr == 1) PG8_BAR;
    PG8_WAIT_V(8); PG8_BAR;
    PG8_WAIT_V(6); PG8_BAR;
#ifdef CLK_ACC
    if (tid == 0) { PG8_LAS unsigned* mm = (PG8_LAS unsigned*)(lds + 131072 + 320) + 16; if (mm[14]) { mm[2] += (unsigned)(wall_clock64() - tp0_); mm[3] += 1u; } }
#endif
    for (;;) {
        const bool has_next = S.next(ui + 1, nxt);
        const char* nA = has_next ? PG8_APTR(nxt) : cA; const char* nB = has_next ? PG8_BPTR(nxt) : cB;
        for (int t = 0; t < nt; t += 2) {
            const bool last = (t == nt - 2);
            const char* a1 = cA + (size_t)(t + 1) * kstepA;
            const char* a2 = last ? nA : cA + (size_t)(t + 2) * kstepA; const char* b2 = last ? nB : cB + (size_t)(t + 2) * kstep;
            const char* a3 = a2 + kstepA; const char* b3 = b2 + kstep;
            const bool fin = last && !has_next;
            PG8_LDB(B0, 0, 0); PG8_LDB(B1, 0, 1); PG8_SCHED; PG8_LDA(At, 0, 0); PG8_STAGE(PG8_SA(1, 1), a1 + hstepA, voffA);
            PG8_WAIT_V(8); PG8_WAIT_L(0); PG8_BAR; PG8_MMA(0, 0, At, B0); PG8_MMA(0, 1, At, B1); PG8_BAR; PG8_SCHED;
            PG8_LDA(At, 0, 1);
            if (!fin) { PG8_STAGE(PG8_SB(0, 0), b2, voffB); PG8_STAGE(PG8_SB(0, 1), b2 + hstepB, voffB); PG8_STAGE(PG8_SA(0, 0), a2, voffA); PG8_WAIT_V(8); } else { PG8_WAIT_V(2); }
            PG8_WAIT_L(0); PG8_BAR; PG8_MMA(1, 0, At, B0); PG8_MMA(1, 1, At, B1); PG8_BAR; PG8_SCHED;
            PG8_LDB(B0, 1, 0); PG8_LDB(B1, 1, 1); PG8_SCHED; PG8_LDA(At, 1, 0);
            if (!fin) { PG8_STAGE(PG8_SA(0, 1), a2 + hstepA, voffA); PG8_WAIT_V(8); } else { PG8_WAIT_V(0); }
            PG8_WAIT_L(0); PG8_BAR; PG8_MMA(0, 0, At, B0); PG8_MMA(0, 1, At, B1); PG8_BAR; PG8_SCHED;
            PG8_LDA(At, 1, 1);
            if (!fin) { PG8_STAGE(PG8_SB(1, 0), b3, voffB); PG8_STAGE(PG8_SB(1, 1), b3 + hstepB, voffB); PG8_STAGE(PG8_SA(1, 0), a3, voffA); PG8_WAIT_V(8); }
            PG8_WAIT_L(0); PG8_BAR; PG8_MMA(1, 0, At, B0); PG8_MMA(1, 1, At, B1); PG8_BAR; PG8_SCHED;
        }
        if (wr == 0) PG8_BAR;
#ifdef CLK_ACC
        unsigned long long te0_ = wall_clock64();
#endif
        E(acc, cur, wr, wc, fr, fq);
#ifdef CLK_ACC
        asm volatile("s_waitcnt vmcnt(0)" ::: "memory"); if (tid == 0) { PG8_LAS unsigned* mm = (PG8_LAS unsigned*)(lds + 131072 + 320) + 16; if (mm[14]) { mm[0] += (unsigned)(wall_clock64() - te0_); mm[1] += 1u; } }
#endif
        if (!has_next) break;
#pragma unroll
        for (int a = 0; a < 2; ++a)
#pragma unroll
            for (int b = 0; b < 2; ++b)
#pragma unroll
                for (int m = 0; m < 4; ++m)
#pragma unroll
                    for (int n = 0; n < 2; ++n) acc[a][b][m][n] = (f32x4){0.f, 0.f, 0.f, 0.f};
        cur = nxt; cA = nA; cB = nB; ++ui;
        if (wr == 1) PG8_BAR;
    }
    PG8_WAIT_V(0);
    PG8_BAR;
#ifdef PG8_PRIO_STATIC
    __builtin_amdgcn_s_setprio(0);
#endif
#ifdef CLK_ACC
    if (tid == 0) { PG8_LAS unsigned* mm = (PG8_LAS unsigned*)(lds + 131072 + 320) + 16; if (mm[14]) mm[4] += (unsigned)(wall_clock64() - tp0_); }
#endif
#undef PG8_SA
#undef PG8_SB
#undef PG8_STAGE
#undef PG8_LDA
#undef PG8_LDB
#undef PG8_MMA
#undef PG8_MMA_ST
#undef PG8_WAIT_V
#undef PG8_WAIT_L
#undef PG8_BAR
#undef PG8_SCHED
#undef PG8_APTR
#undef PG8_BPTR
}
}

constexpr int NWAVES = 8;
constexpr int D = 1024, BATCH = 4, SEQ = 4096, T = BATCH * SEQ, NMEM = 256, TM = BATCH * NMEM, FF = 4096, INC = 2560;
constexpr float EPS = 1e-6f;
constexpr float LOG2E = 1.4426950408889634f;
constexpr int NUM_GS = SEQ;

constexpr size_t MiB = 1u << 20;
constexpr size_t WS_CTL = 0, CTL_ZERO_BYTES = 128 * 1024;
constexpr size_t WS_SS = 1 * MiB, WS_QSS = 2 * MiB, WS_LSUM = 3 * MiB, WS_DEN = 4 * MiB, WS_AEND = 5 * MiB, WS_HEND = 5 * MiB + 256 * 1024;
constexpr size_t WS_GT = 6 * MiB, WS_POOLT = 7 * MiB;
constexpr size_t WS_WIN = 8 * MiB, WS_WOUT = 18 * MiB, WS_WQ = 22 * MiB, WS_WO = 30 * MiB, WS_W1 = 38 * MiB, WS_W2 = 70 * MiB, WS_WKV = 102 * MiB;
constexpr size_t WS_KN = 102 * MiB, WS_VT = 110 * MiB;
constexpr size_t WS_XB = 118 * MiB;
constexpr size_t WS_HID = 150 * MiB, WS_PROJ = 150 * MiB, WS_NUM = 230 * MiB, WS_AOUT = 150 * MiB, WS_Q = 182 * MiB, WS_P = 214 * MiB, WS_O = 246 * MiB;
constexpr size_t WS_END = 278 * MiB;
constexpr size_t DO_PIPE = 16 * MiB, DO_Y0 = 0, DO_Y1 = 4 * MiB, DO_KVRAW = 8 * MiB, DO_KN = 12 * MiB, DO_VT = 14 * MiB, DO_MEMN = 0;

constexpr int RING_BYTES = 131072, LDSCTL_OFF = RING_BYTES, MISC_OFF = LDSCTL_OFF + 320, LDS_BYTES = 147456;

#define GAS __attribute__((address_space(1)))
#define LAS __attribute__((address_space(3)))
typedef unsigned short bf16;
typedef unsigned v4u __attribute__((ext_vector_type(4)));
typedef unsigned v2u __attribute__((ext_vector_type(2)));
typedef float f32x4 __attribute__((ext_vector_type(4)));
typedef short bf16x8 __attribute__((ext_vector_type(8)));
typedef short s16x4 __attribute__((ext_vector_type(4)));
#define LDS_WAIT() asm volatile("s_waitcnt lgkmcnt(0)" ::: "memory")
#define VM_WAIT() asm volatile("s_waitcnt vmcnt(0)" ::: "memory")
__device__ __forceinline__ unsigned pk2(float lo, float hi) { return pg8::cvt_pk_bf16(lo, hi); }
__device__ __forceinline__ float bflo(unsigned w) { return __uint_as_float(w << 16); }
__device__ __forceinline__ float bfhi(unsigned w) { return __uint_as_float(w & 0xffff0000u); }
__device__ __forceinline__ float bf1(bf16 h) { return __uint_as_float((unsigned)h << 16); }
__device__ __forceinline__ bf16 f2bf(float f) { return (bf16)(pg8::cvt_pk_bf16(f, 0.f) & 0xffffu); }

#define XB_TMO      128
#define XB_XCNT(j)  (256  + 64 * (j))
#define XB_XSUB(j)  (1280 + 64 * (j))
#define XB_XGEN(j)  (2304 + 64 * (j))
#define XB_TOP      3328
#define XB_TOPGEN   3392
#define XCD_BAR_WORDS 3456
#define XB_SPIN_CAP (1u << 22)
__device__ __forceinline__ unsigned xb_ld(unsigned* p)              { return __hip_atomic_load(p, __ATOMIC_RELAXED, __HIP_MEMORY_SCOPE_AGENT); }
__device__ __forceinline__ unsigned xb_add(unsigned* p, unsigned v) { return __hip_atomic_fetch_add(p, v, __ATOMIC_RELAXED, __HIP_MEMORY_SCOPE_AGENT); }
__device__ __forceinline__ unsigned xb_xcc_id() { return (unsigned)__builtin_amdgcn_s_getreg((3 << 11) | 20) & 0xFu; }
#define XB_SPIN(cond, bar) do { unsigned _sp = 0; while (cond) { __builtin_amdgcn_s_sleep(1); \
    if ((++_sp & 255u) == 0u) { if (xb_ld(&(bar)[XB_TMO])) break; if (_sp > XB_SPIN_CAP) { atomicAdd(&(bar)[XB_TMO], 1u); break; } } } } while (0)
struct XcdBarrier { unsigned* bar; unsigned x; volatile LAS unsigned* st; unsigned G; };
__device__ __forceinline__ XcdBarrier xcd_barrier_post(unsigned* bar, volatile LAS unsigned* st, unsigned G) {
    XcdBarrier b; b.bar = bar; b.x = xb_xcc_id(); b.st = st; b.G = G;
    if (threadIdx.x == 0) (void)xb_add(&bar[XB_XCNT(b.x)], 1u);
    return b;
}
__device__ __forceinline__ void xcd_barrier_complete(unsigned* bar, unsigned x, unsigned G, unsigned& nloc, unsigned& nx) {
    unsigned sum, cnt, mine, sp = 0u;
    for (;;) {
        sum = 0u; cnt = 0u; mine = 0u;
#pragma unroll
        for (unsigned j = 0; j < 16; ++j) { const unsigned c = xb_ld(&bar[XB_XCNT(j)]); sum += c; cnt += (c > 0u) ? 1u : 0u; mine = (j == x) ? c : mine; }
        if (sum == G) break;
        __builtin_amdgcn_s_sleep(1);
        if ((++sp & 255u) == 0u) { if (xb_ld(&bar[XB_TMO])) break; if (sp > XB_SPIN_CAP) { atomicAdd(&bar[XB_TMO], 1u); break; } }
    }
    nloc = mine > 0u ? mine : 1u; nx = cnt > 0u ? cnt : 1u;
}
__device__ __forceinline__ void xcd_barrier_discover(const XcdBarrier& b) {
    if (threadIdx.x == 0) { unsigned nloc, nx; xcd_barrier_complete(b.bar, b.x, b.G, nloc, nx); b.st[0] = nloc; b.st[1] = nx; }
}
__device__ __forceinline__ void xcd_barrier(const XcdBarrier& b) {
    asm volatile("s_waitcnt vmcnt(0)" ::: "memory");
    __syncthreads();
    if (threadIdx.x == 0) {
#ifdef CLK_ACC
        const unsigned long long tb0_ = wall_clock64();
#endif
        unsigned* bar = b.bar;
        __builtin_amdgcn_s_waitcnt(0);
        const unsigned nloc = b.st[0], nx = b.st[1];
        const unsigned old = xb_add(&bar[XB_XSUB(b.x)], 1u);
        const unsigned gen = old / nloc;
        if (old + 1u == (gen + 1u) * nloc) {
            __builtin_amdgcn_fence(__ATOMIC_RELEASE, "agent");
            asm volatile("s_waitcnt vmcnt(0)" ::: "memory");
            const unsigned og = xb_add(&bar[XB_TOP], 1u);
            const unsigned tg = og / nx;
            if (og + 1u == (tg + 1u) * nx) xb_add(&bar[XB_TOPGEN], 1u);
            else XB_SPIN(xb_ld(&bar[XB_TOPGEN]) == tg, bar);
            __builtin_amdgcn_fence(__ATOMIC_ACQUIRE, "agent");
            xb_add(&bar[XB_XGEN(b.x)], 1u);
            asm volatile("s_waitcnt vmcnt(0)" ::: "memory");
        } else {
            XB_SPIN(xb_ld(&bar[XB_XGEN(b.x)]) == gen, bar);
            __builtin_amdgcn_fence(__ATOMIC_ACQUIRE, "agent");
            asm volatile("s_waitcnt vmcnt(0)" ::: "memory");
        }
#ifdef CLK_ACC
        b.st[8 + 5 - (b.G == 64 ? 2 : 0)] += (unsigned)(wall_clock64() - tb0_);
#endif
    }
    __syncthreads();
}

__device__ __forceinline__ float wave_sum(float v) {
#pragma unroll
    for (int o = 1; o < 64; o <<= 1) v += __shfl_xor(v, o);
    return v;
}

struct P0Item { const float* W; bf16* WT; const float* gain; int K, N, item; };
__device__ __forceinline__ void p0_load(const P0Item& I, float (&v)[32], int lane) {
    const int nblk = I.N / 32, kb = I.item / nblk, nb = I.item % nblk, k0 = 64 * kb, n0 = 32 * nb;
#pragma unroll
    for (int i = 0; i < 32; ++i) { const int kk = 2 * i + (lane >> 5);
#ifdef P0_NT
        v[i] = __builtin_nontemporal_load(I.W + (size_t)(k0 + kk) * I.N + n0 + (lane & 31));
#else
        v[i] = I.W[(size_t)(k0 + kk) * I.N + n0 + (lane & 31)];
#endif
    }
}
template <bool NTS = false> __device__ __forceinline__ void p0_finish(const P0Item& I, const float (&v)[32], LAS float* scr, int lane) {
    const int nblk = I.N / 32, kb = I.item / nblk, nb = I.item % nblk, k0 = 64 * kb, n0 = 32 * nb;
    const int c = lane & 7;
    f32x4 g0 = (f32x4){1.f, 1.f, 1.f, 1.f}, g1 = g0;
    if (I.gain) { g0 = *(const GAS f32x4*)(I.gain + k0 + 8 * c); g1 = *(const GAS f32x4*)(I.gain + k0 + 8 * c + 4); }
#pragma unroll
    for (int i = 0; i < 32; ++i) { const int kk = 2 * i + (lane >> 5); scr[kk * 33 + (lane & 31)] = v[i]; }
    LDS_WAIT(); asm volatile("" ::: "memory");
#pragma unroll
    for (int j = 0; j < 4; ++j) { const int n = (lane >> 3) + 8 * j; const LAS float* s = scr + (8 * c) * 33 + n;
        v4u o; o.x = pk2(s[0 * 33] * g0[0], s[1 * 33] * g0[1]); o.y = pk2(s[2 * 33] * g0[2], s[3 * 33] * g0[3]); o.z = pk2(s[4 * 33] * g1[0], s[5 * 33] * g1[1]); o.w = pk2(s[6 * 33] * g1[2], s[7 * 33] * g1[3]);
        if (NTS) __builtin_nontemporal_store(o, (GAS v4u*)(I.WT + (size_t)(n0 + n) * I.K + k0 + 8 * c)); else *(GAS v4u*)(I.WT + (size_t)(n0 + n) * I.K + k0 + 8 * c) = o; }
    LDS_WAIT(); asm volatile("" ::: "memory");
}

struct Ptrs {
    const float* in[26]; float* out; unsigned char* ws;
};

struct Args { Ptrs p; int ph_lo, ph_hi; };
__device__ __forceinline__ const float* ld_in(const Args& a, int i) { asm volatile("" : "+s"(i)); return a.p.in[i]; }
__device__ __forceinline__ float* ld_out(const Args& a) { int i = 0; asm volatile("" : "+s"(i)); return (&a.p.out)[i]; }
__device__ __forceinline__ unsigned char* ld_ws(const Args& a) { int i = 0; asm volatile("" : "+s"(i)); return (&a.p.ws)[i]; }
#define INP(i) ld_in(args, (i))
#define OUTP() ld_out(args)
constexpr int P0_I_WIN = 16 * 80, P0_I_SQ = 16 * 32, P0_I_G = 2 * 4, P0_I_POOL = 4 * 8, P0_I_KV = 16 * 64, P0_I_W1 = 16 * 128, P0_I_W2 = 64 * 32;
constexpr int P0_NA = P0_I_W1 + P0_I_W2 + 4 * P0_I_KV + P0_I_WIN + 3 * P0_I_SQ + 8 * P0_I_G;
constexpr int P0_NB = 3 * P0_I_W1 + 3 * P0_I_W2 + P0_I_WIN + P0_I_SQ + 6 * P0_I_SQ + 8 * P0_I_POOL + 8 * P0_I_G;
static_assert(P0_NA == 11072 && P0_NB == 17472 && P0_NB % 6 == 0, "item counts");
template <int SET> __device__ __forceinline__ P0Item p0_decode(const Args& args, unsigned char* ws, int it) {
    constexpr int l0 = SET ? 1 : 0, nl = SET ? 3 : 1, e0 = SET ? 1 : 0;
    P0Item I; int r = it;
    if (r < nl * P0_I_W1) { const int l = l0 + r / P0_I_W1; I = P0Item{INP(24) + (size_t)l * D * FF, (bf16*)(ws + WS_W1) + (size_t)l * FF * D, INP(5) + l * D, D, FF, r % P0_I_W1}; return I; } r -= nl * P0_I_W1;
    if (r < nl * P0_I_W2) { const int l = l0 + r / P0_I_W2; I = P0Item{INP(25) + (size_t)l * FF * D, (bf16*)(ws + WS_W2) + (size_t)l * D * FF, nullptr, FF, D, r % P0_I_W2}; return I; } r -= nl * P0_I_W2;
    if (!SET) { if (r < 4 * P0_I_KV) { const int l = r / P0_I_KV; I = P0Item{INP(20) + (size_t)l * D * 2048, (bf16*)(ws + WS_WKV) + (size_t)l * 2048 * D, nullptr, D, 2048, r % P0_I_KV}; return I; } r -= 4 * P0_I_KV; }
    if (r < P0_I_WIN) { I = P0Item{INP(6) + (size_t)e0 * D * INC, (bf16*)(ws + WS_WIN) + (size_t)e0 * INC * D, INP(3) + (2 * e0) * D, D, INC, r}; return I; } r -= P0_I_WIN;
    if (r < P0_I_SQ) { I = P0Item{INP(16) + (size_t)e0 * D * D, (bf16*)(ws + WS_WOUT) + (size_t)e0 * D * D, nullptr, D, D, r}; return I; } r -= P0_I_SQ;
    if (r < nl * P0_I_SQ) { const int l = l0 + r / P0_I_SQ; I = P0Item{INP(19) + (size_t)l * D * D, (bf16*)(ws + WS_WQ) + (size_t)l * D * D, INP(4) + l * D, D, D, r % P0_I_SQ}; return I; } r -= nl * P0_I_SQ;
    if (r < nl * P0_I_SQ) { const int l = l0 + r / P0_I_SQ; I = P0Item{INP(23) + (size_t)l * D * D, (bf16*)(ws + WS_WO) + (size_t)l * D * D, nullptr, D, D, r % P0_I_SQ}; return I; } r -= nl * P0_I_SQ;
    if (SET) { if (r < 8 * P0_I_POOL) { const int mat = r / P0_I_POOL, o = mat >> 2, g = mat & 3; I = P0Item{INP(17) + (size_t)mat * 65536, (bf16*)(ws + WS_POOLT) + (size_t)mat * 65536, INP(3) + (2 * o + 1) * D + g * 256, 256, 256, r % P0_I_POOL}; return I; } r -= 8 * P0_I_POOL; }
    { const int mat = r / P0_I_G, kind = mat >> 2, g = mat & 3, eg = e0 * 4 + g;
      I = P0Item{(kind ? INP(13) : INP(11)) + (size_t)eg * 16384, (bf16*)(ws + WS_GT) + (size_t)((e0 * 2 + kind) * 4 + g) * 16384, nullptr, 128, 128, r % P0_I_G}; }
    return I;
}
template <int SET> __device__ __forceinline__ void p0_items(const Args& args, LAS unsigned char* lds, int first, int last, int w, int NW, int wave) {
    int tid_ = threadIdx.x; asm volatile("" : "+v"(tid_)); const int lane = tid_ & 63;
    LAS float* scr = (LAS float*)(lds + wave * 16384);
    unsigned char* ws = ld_ws(args);
#if P0_INFLIGHT == 4
    for (int it = first + w; it < last; it += 4 * NW) {
        float va[32], vb[32], vc[32], vd[32];
        const bool hb = (it + NW < last), hc = (it + 2 * NW < last), hd = (it + 3 * NW < last);
        const P0Item A = p0_decode<SET>(args, ws, it); p0_load(A, va, lane);
        P0Item B = A, C = A, Dd = A;
        if (hb) { B = p0_decode<SET>(args, ws, it + NW); p0_load(B, vb, lane); }
        if (hc) { C = p0_decode<SET>(args, ws, it + 2 * NW); p0_load(C, vc, lane); }
        if (hd) { Dd = p0_decode<SET>(args, ws, it + 3 * NW); p0_load(Dd, vd, lane); }
        p0_finish<P0_NTS(SET)>(A, va, scr, lane);
        if (hb) p0_finish<P0_NTS(SET)>(B, vb, scr, lane);
        if (hc) p0_finish<P0_NTS(SET)>(C, vc, scr, lane);
        if (hd) p0_finish<P0_NTS(SET)>(Dd, vd, scr, lane);
    }
#else
    for (int it = first + w; it < last; it += 2 * NW) {
        float va[32], vb[32];
        const P0Item A = p0_decode<SET>(args, ws, it); p0_load(A, va, lane);
        const bool two = (it + NW < last);
        P0Item B = A; if (two) { B = p0_decode<SET>(args, ws, it + NW); p0_load(B, vb, lane); }
        p0_finish<P0_NTS(SET)>(A, va, scr, lane);
        if (two) p0_finish<P0_NTS(SET)>(B, vb, scr, lane);
    }
#endif
}
__device__ __forceinline__ void p0_prologue(const Args& args, LAS unsigned char* lds, int gw, int NGW, int wave) {
    int tid_ = threadIdx.x; asm volatile("" : "+v"(tid_)); const int lane = tid_ & 63;
    unsigned char* ws = ld_ws(args);
    p0_items<0>(args, lds, 0, P0_NA, gw, NGW, wave);
    if (MK_N_LAUNCHES != 1) p0_items<1>(args, lds, 0, P0_NB, gw, NGW, wave);
    for (int m = gw; m < T; m += 2 * NGW) {
        f32x4 v[2][4];
#pragma unroll
        for (int r = 0; r < 2; ++r) { const GAS f32x4* xr = (const GAS f32x4*)(INP(0) + (size_t)(m + r * NGW) * D) + lane;
#pragma unroll
            for (int j = 0; j < 4; ++j) {
#ifdef P0_NT
                v[r][j] = __builtin_nontemporal_load((const f32x4*)(INP(0) + (size_t)(m + r * NGW) * D) + lane + 64 * j);
#else
                v[r][j] = xr[64 * j];
#endif
            } }
#pragma unroll
        for (int r = 0; r < 2; ++r) { const int mm = m + r * NGW; float s = 0.f;
#pragma unroll
            for (int j = 0; j < 4; ++j) s += (v[r][j][0] * v[r][j][0] + v[r][j][1] * v[r][j][1]) + (v[r][j][2] * v[r][j][2] + v[r][j][3] * v[r][j][3]);
            s = wave_sum(s);
            GAS v2u* o8 = (GAS v2u*)((bf16*)(ws + WS_XB) + (size_t)mm * D) + lane;
#pragma unroll
            for (int j = 0; j < 4; ++j) { v2u w; w.x = pk2(v[r][j][0], v[r][j][1]); w.y = pk2(v[r][j][2], v[r][j][3]); o8[64 * j] = w; }
            if (lane < 16) ((float*)(ws + WS_SS))[(size_t)mm * 16 + lane] = lane == 0 ? s : 0.f; }
    }
    for (int m = gw; m < TM; m += NGW) {
        const GAS f32x4* xr = (const GAS f32x4*)(INP(1) + (size_t)m * D) + lane; const GAS f32x4* gr = (const GAS f32x4*)(INP(2)) + lane; f32x4 v[4]; float s = 0.f;
#pragma unroll
        for (int j = 0; j < 4; ++j) { v[j] = xr[64 * j]; s += (v[j][0] * v[j][0] + v[j][1] * v[j][1]) + (v[j][2] * v[j][2] + v[j][3] * v[j][3]); }
        const float rs = 1.0f / sqrtf(wave_sum(s) * (1.0f / D) + EPS);
        GAS v2u* o8 = (GAS v2u*)((bf16*)((unsigned char*)OUTP() + (size_t)(m >> 8) * DO_PIPE + DO_MEMN) + (size_t)(m & 255) * D) + lane;
#pragma unroll
        for (int j = 0; j < 4; ++j) { const f32x4 gg = gr[64 * j]; v2u w; w.x = pk2(v[j][0] * rs * gg[0], v[j][1] * rs * gg[1]); w.y = pk2(v[j][2] * rs * gg[2], v[j][3] * rs * gg[3]); o8[64 * j] = w; }
    }
}

__device__ __forceinline__ void kv_finalize(const Args& args, const bf16* __restrict__ kvraw  , bf16* __restrict__ Kn  , bf16* __restrict__ Vt, int gw, int NGW) {
    int tid_ = threadIdx.x; asm volatile("" : "+v"(tid_)); const int lane = tid_ & 63;
    for (int row0 = gw; row0 < 4 * 256 * 4; row0 += 4 * NGW) {
        v2u w[4];
#pragma unroll
        for (int r = 0; r < 4; ++r) { const int row = row0 + r * NGW, l = row >> 10, m = (row >> 2) & 255, h = row & 3;
            w[r] = *(const GAS v2u*)(kvraw + ((size_t)(l * 256 + m)) * 2048 + h * 256 + 4 * lane); }
#pragma unroll
        for (int r = 0; r < 4; ++r) { const int row = row0 + r * NGW, l = row >> 10, m = (row >> 2) & 255, h = row & 3;
            const float k0 = bflo(w[r].x), k1 = bfhi(w[r].x), k2 = bflo(w[r].y), k3 = bfhi(w[r].y);
            const float ss = wave_sum((k0 * k0 + k1 * k1) + (k2 * k2 + k3 * k3));
            const float sc = (1.0f / sqrtf(ss * (1.0f / 256.0f) + EPS)) * (0.0625f * LOG2E);
            const f32x4 gk = *(const GAS f32x4*)(INP(22) + l * 256 + 4 * lane), gq = *(const GAS f32x4*)(INP(21) + l * 256 + 4 * lane);
            v2u o; o.x = pk2(k0 * sc * gk[0] * gq[0], k1 * sc * gk[1] * gq[1]); o.y = pk2(k2 * sc * gk[2] * gq[2], k3 * sc * gk[3] * gq[3]);
            *(GAS v2u*)(Kn + ((size_t)(l * 4 + h) * 256 + m) * 256 + 4 * lane) = o; }
    }
    for (int it0 = gw; it0 < 2048; it0 += 4 * NGW) {
        v4u w[4];
#pragma unroll
        for (int r = 0; r < 4; ++r) { const int it = it0 + r * NGW, l = it >> 9, h = (it >> 7) & 3, kb = (it >> 5) & 3, dc = it & 31, key = 64 * kb + lane;
            w[r] = *(const GAS v4u*)(kvraw + ((size_t)(l * 256 + key)) * 2048 + 1024 + h * 256 + 8 * dc); }
#pragma unroll
        for (int r = 0; r < 4; ++r) { const int it = it0 + r * NGW, l = it >> 9, h = (it >> 7) & 3, kb = (it >> 5) & 3, dc = it & 31, key = 64 * kb + lane;
            bf16* dst = Vt + ((size_t)(l * 4 + h) * 256 + 8 * dc) * 256 + key;
            dst[0 * 256] = (bf16)(w[r].x & 0xffffu); dst[1 * 256] = (bf16)(w[r].x >> 16); dst[2 * 256] = (bf16)(w[r].y & 0xffffu); dst[3 * 256] = (bf16)(w[r].y >> 16);
            dst[4 * 256] = (bf16)(w[r].z & 0xffffu); dst[5 * 256] = (bf16)(w[r].z >> 16); dst[6 * 256] = (bf16)(w[r].w & 0xffffu); dst[7 * 256] = (bf16)(w[r].w >> 16); }
    }
}

struct AttnPre { v4u kk[4], vv[4], qq[4]; };
__device__ __forceinline__ void attn_load(AttnPre& R, const bf16* proj, size_t rowb, int h, int base, int d, int tid, bool valid) {
    const int c = tid & 15, w = tid >> 6, lane = tid & 63, q = lane & 15, G = lane >> 4;
    const int bs = valid ? base : 0;
#pragma unroll
    for (int i = 0; i < 4; ++i) { const int kr = (tid >> 4) + 32 * i;
        const bf16* p = proj + (rowb + bs + (size_t)kr * d) * INC + 512 + h * 128 + 8 * c; R.kk[i] = *(const GAS v4u*)p; R.vv[i] = *(const GAS v4u*)(p + 512);
        if (!valid) { R.kk[i] = (v4u){0u, 0u, 0u, 0u}; R.vv[i] = (v4u){0u, 0u, 0u, 0u}; } }
    {
        const size_t qrow = rowb + bs + (size_t)(16 * w + q) * d;
#pragma unroll
        for (int ks = 0; ks < 4; ++ks) R.qq[ks] = *(const GAS v4u*)(proj + qrow * INC + h * 128 + 32 * ks + 8 * G); }
}
__device__ __forceinline__ void attn_store_kv(const AttnPre& R, LAS unsigned char* lds, int slot, const f32x4 ga, const f32x4 gb, int tid) {
    const int c = tid & 15;
#pragma unroll
    for (int i = 0; i < 4; ++i) { const int kr = (tid >> 4) + 32 * i, lr = slot * 128 + kr;
        const float a0 = bflo(R.kk[i].x), a1 = bfhi(R.kk[i].x), a2 = bflo(R.kk[i].y), a3 = bfhi(R.kk[i].y), a4 = bflo(R.kk[i].z), a5 = bfhi(R.kk[i].z), a6 = bflo(R.kk[i].w), a7 = bfhi(R.kk[i].w);
        float ss = ((a0 * a0 + a1 * a1) + (a2 * a2 + a3 * a3)) + ((a4 * a4 + a5 * a5) + (a6 * a6 + a7 * a7));
        ss += __shfl_xor(ss, 1); ss += __shfl_xor(ss, 2); ss += __shfl_xor(ss, 4); ss += __shfl_xor(ss, 8);
        const float rk = __builtin_amdgcn_rsqf(ss * (1.0f / 128.0f) + EPS);
        v4u o; o.x = pk2(a0 * rk * ga[0], a1 * rk * ga[1]); o.y = pk2(a2 * rk * ga[2], a3 * rk * ga[3]); o.z = pk2(a4 * rk * gb[0], a5 * rk * gb[1]); o.w = pk2(a6 * rk * gb[2], a7 * rk * gb[3]);
        *(LAS v4u*)(lds + lr * 256 + ((c ^ (lr & 15)) << 4)) = o;
        *(LAS v4u*)(lds + 65536 + lr * 256 + ((c ^ ((lr & 7) << 1)) << 4)) = R.vv[i]; }
}
__device__ __forceinline__ void attn_segment(LAS unsigned char* lds, const bf16* proj, const float* gq, const float* gk, bf16* num, float* den, int g, int bh, int r, int n0, int L, int tid) {
    asm volatile("" : "+v"(tid));
    const int dsh = 2 * g, d = 1 << dsh, b = bh >> 2, h = bh & 3, wlen = 128 << dsh;
    const size_t rowb = (size_t)b * SEQ;
    const int w = tid >> 6, lane = tid & 63, q = lane & 15, G = lane >> 4;
    const f32x4 gka = *(const GAS f32x4*)(gk + 8 * (tid & 15)), gkb = *(const GAS f32x4*)(gk + 8 * (tid & 15) + 4);
    f32x4 gqa[4], gqb[4];
#pragma unroll
    for (int ks = 0; ks < 4; ++ks) { gqa[ks] = *(const GAS f32x4*)(gq + 32 * ks + 8 * G); gqb[ks] = *(const GAS f32x4*)(gq + 32 * ks + 8 * G + 4); }
    AttnPre R;
    attn_load(R, proj, rowb, h, (n0 - 1) * wlen + r, d, tid, n0 > 0);
    attn_store_kv(R, lds, (n0 - 1) & 1, gka, gkb, tid);
    attn_load(R, proj, rowb, h, n0 * wlen + r, d, tid, true);
    attn_store_kv(R, lds, n0 & 1, gka, gkb, tid);
    for (int n = n0; n < n0 + L; ++n) {
        const int base = n * wlen + r;
        const size_t qrow = rowb + base + (size_t)(16 * w + q) * d;
        bf16x8 Qf[4];
        {
            float ss = 0.f;
#pragma unroll
            for (int ks = 0; ks < 4; ++ks) { const float a0 = bflo(R.qq[ks].x), a1 = bfhi(R.qq[ks].x), a2 = bflo(R.qq[ks].y), a3 = bfhi(R.qq[ks].y), a4 = bflo(R.qq[ks].z), a5 = bfhi(R.qq[ks].z), a6 = bflo(R.qq[ks].w), a7 = bfhi(R.qq[ks].w);
                ss += ((a0 * a0 + a1 * a1) + (a2 * a2 + a3 * a3)) + ((a4 * a4 + a5 * a5) + (a6 * a6 + a7 * a7)); }
            ss += __shfl_xor(ss, 16); ss += __shfl_xor(ss, 32);
            const float rq = __builtin_amdgcn_rsqf(ss * (1.0f / 128.0f) + EPS) * (0.08838834764831845f * LOG2E);
#pragma unroll
            for (int ks = 0; ks < 4; ++ks) { const f32x4 ga = gqa[ks], gb = gqb[ks];
                v4u o; o.x = pk2(bflo(R.qq[ks].x) * rq * ga[0], bfhi(R.qq[ks].x) * rq * ga[1]); o.y = pk2(bflo(R.qq[ks].y) * rq * ga[2], bfhi(R.qq[ks].y) * rq * ga[3]);
                o.z = pk2(bflo(R.qq[ks].z) * rq * gb[0], bfhi(R.qq[ks].z) * rq * gb[1]); o.w = pk2(bflo(R.qq[ks].w) * rq * gb[2], bfhi(R.qq[ks].w) * rq * gb[3]);
                Qf[ks] = __builtin_bit_cast(bf16x8, o); }
        }
        __syncthreads();
        const bool more = (n + 1 < n0 + L);
#ifndef ATT_NOPF
        if (more) attn_load(R, proj, rowb, h, base + wlen, d, tid, true);
#endif
#ifdef ATT_PFCMP
        AttnPre R2; if (more) attn_load(R2, proj, rowb, h, base + wlen, d, tid, true);
#endif
        f32x4 s[9];
#pragma unroll
        for (int t = 0; t < 9; ++t) { s[t] = (f32x4){0.f, 0.f, 0.f, 0.f}; const int kt = w + t, lr = ((((n - 1) + (kt >> 3)) & 1) << 7) + ((kt & 7) << 4) + q;
            bf16x8 Kf[4];
#pragma unroll
            for (int ks = 0; ks < 4; ++ks) Kf[ks] = *(const LAS bf16x8*)(lds + lr * 256 + (((4 * ks + G) ^ q) << 4));
            __builtin_amdgcn_sched_barrier(0);
#pragma unroll
            for (int ks = 0; ks < 4; ++ks) s[t] = __builtin_amdgcn_mfma_f32_16x16x32_bf16(Kf[ks], Qf[ks], s[t], 0, 0, 0);
            __builtin_amdgcn_sched_barrier(0); }
        float dsum = 0.f; const bool first = (n == 0);
#pragma unroll
        for (int t = 0; t < 9; ++t)
#pragma unroll
            for (int e = 0; e < 4; ++e) { const int kk = 4 * G + e; bool ok = true;
                if (t == 0) ok = kk >= q; if (t == 8) ok = kk <= q; if (first && (w + t) < 8) ok = false;
                const float p = ok ? __builtin_amdgcn_exp2f(s[t][e]) : 0.f; s[t][e] = p; dsum += p; }
        dsum += __shfl_xor(dsum, 16); dsum += __shfl_xor(dsum, 32);
#ifdef ATT_PF_MID
        if (more) attn_load(R, proj, rowb, h, base + wlen, d, tid, true);
#endif
        f32x4 o[8];
#pragma unroll
        for (int nt = 0; nt < 8; ++nt) o[nt] = (f32x4){0.f, 0.f, 0.f, 0.f};
        const int q4 = q >> 2, pp = q & 3;
#pragma unroll
        for (int si = 0; si < 5; ++si) {
            v4u pw; pw.x = pk2(s[2 * si][0], s[2 * si][1]); pw.y = pk2(s[2 * si][2], s[2 * si][3]);
            if (si < 4) { pw.z = pk2(s[2 * si + 1][0], s[2 * si + 1][1]); pw.w = pk2(s[2 * si + 1][2], s[2 * si + 1][3]); } else { pw.z = 0u; pw.w = 0u; }
            const bf16x8 Pf = __builtin_bit_cast(bf16x8, pw);
            const int kt0 = w + 2 * si, kt1 = (si < 4) ? kt0 + 1 : kt0;
            const int key0 = ((((n - 1) + (kt0 >> 3)) & 1) << 7) + ((kt0 & 7) << 4) + 4 * G + q4, key1 = ((((n - 1) + (kt1 >> 3)) & 1) << 7) + ((kt1 & 7) << 4) + 4 * G + q4;
            const int sw0 = (key0 & 7) << 1, sw1 = (key1 & 7) << 1;
#pragma unroll
            for (int nh = 0; nh < 2; ++nh) {
                s16x4 v0[4], v1[4];
#pragma unroll
                for (int n4 = 0; n4 < 4; ++n4) { const int chunk = 2 * (4 * nh + n4) + (pp >> 1);
                    v0[n4] = __builtin_bit_cast(s16x4, __builtin_amdgcn_ds_read_tr16_b64_v4i16((LAS s16x4*)(lds + 65536 + key0 * 256 + ((chunk ^ sw0) << 4) + (pp & 1) * 8)));
                    v1[n4] = __builtin_bit_cast(s16x4, __builtin_amdgcn_ds_read_tr16_b64_v4i16((LAS s16x4*)(lds + 65536 + key1 * 256 + ((chunk ^ sw1) << 4) + (pp & 1) * 8))); }
                __builtin_amdgcn_sched_barrier(0);
#pragma unroll
                for (int n4 = 0; n4 < 4; ++n4) { const bf16x8 Vf = (bf16x8){v0[n4][0], v0[n4][1], v0[n4][2], v0[n4][3], v1[n4][0], v1[n4][1], v1[n4][2], v1[n4][3]};
                    o[4 * nh + n4] = __builtin_amdgcn_mfma_f32_16x16x32_bf16(Vf, Pf, o[4 * nh + n4], 0, 0, 0); }
                __builtin_amdgcn_sched_barrier(0); }
        }
        bf16* np = num + ((size_t)g * NUM_GS + qrow) * 512 + h * 128 + 4 * G;
#pragma unroll
        for (int nt = 0; nt < 8; ++nt) { v2u wv; wv.x = pk2(o[nt][0], o[nt][1]); wv.y = pk2(o[nt][2], o[nt][3]);
#ifdef ATT_NT_STORE
            __builtin_nontemporal_store(wv, (GAS v2u*)(np + 16 * nt));
#else
            *(GAS v2u*)(np + 16 * nt) = wv;
#endif
        }
        if (G == 0) den[((size_t)g * T + qrow) * 4 + h] = dsum;
        __syncthreads();
#if defined(ATT_NOPF) && !defined(ATT_PF_MID)
        if (more) attn_load(R, proj, rowb, h, base + wlen, d, tid, true);
#endif
#ifdef ATT_PFCMP
        if (more) { unsigned df = 0;
#pragma unroll
            for (int i = 0; i < 4; ++i) { df |= (R.kk[i].x ^ R2.kk[i].x) | (R.kk[i].y ^ R2.kk[i].y) | (R.kk[i].z ^ R2.kk[i].z) | (R.kk[i].w ^ R2.kk[i].w) | (R.vv[i].x ^ R2.vv[i].x) | (R.vv[i].y ^ R2.vv[i].y) | (R.vv[i].z ^ R2.vv[i].z) | (R.vv[i].w ^ R2.vv[i].w) | (R.qq[i].x ^ R2.qq[i].x) | (R.qq[i].y ^ R2.qq[i].y) | (R.qq[i].z ^ R2.qq[i].z) | (R.qq[i].w ^ R2.qq[i].w); }
#ifdef ATT_PFCMP_NOFLAG
            asm volatile("" :: "v"(df));
#else
            if (df) den[0] = __builtin_nanf("");
#endif
            }
#endif
#ifdef ATT_VMW
        asm volatile("s_waitcnt vmcnt(0)" ::: "memory");
#endif
        if (more) attn_store_kv(R, lds, (n + 1) & 1, gka, gkb, tid);
    }
    __syncthreads();
}

__device__ __forceinline__ void xa_fill_image(LAS unsigned char* lds, const bf16* src  , int w, int lane) {
    asm volatile("" : "+v"(lane));
    const int rsub = lane >> 5, cp = lane & 31;
#pragma unroll
    for (int j = 0; j < 16; ++j) { const int pi = w * 16 + j, row = 2 * pi + rsub, ch = cp ^ (row & 15);
        __builtin_amdgcn_global_load_lds((const unsigned*)(src + (size_t)row * 256 + ch * 8), (LAS unsigned*)(lds + pi * 1024), 16, 0, 0); }
}
__device__ __forceinline__ void xa_unit(LAS unsigned char* lds, const bf16* Qb, const float* qss, const bf16* Kn_h, const bf16* Vt_h, bf16* Ob, int pm, int h, int tid) {
    asm volatile("" : "+v"(tid));
    pm = __builtin_amdgcn_readfirstlane(pm); h = __builtin_amdgcn_readfirstlane(h);
    const int w = __builtin_amdgcn_readfirstlane(tid >> 6), lane = tid & 63, q = lane & 15, G = lane >> 4;
    const size_t row0 = (size_t)pm * 256 + 32 * w;
    xa_fill_image(lds, Kn_h, w, lane);
    bf16x8 Qf[2][8]; float rq[2];
#pragma unroll
    for (int qt = 0; qt < 2; ++qt) { const size_t row = row0 + 16 * qt + q;
        const f32x4 v = *(const GAS f32x4*)(qss + row * 16 + h * 4); rq[qt] = __builtin_amdgcn_rsqf(((v[0] + v[1]) + (v[2] + v[3])) * (1.0f / 256.0f) + EPS);
#pragma unroll
        for (int ks = 0; ks < 8; ++ks) Qf[qt][ks] = __builtin_bit_cast(bf16x8, *(const GAS v4u*)(Qb + row * 1024 + h * 256 + 32 * ks + 8 * G)); }
    asm volatile("s_waitcnt vmcnt(0)" ::: "memory"); __syncthreads();
    bf16x8 Pf[2][8]; float lsum[2] = {0.f, 0.f};
#pragma unroll
    for (int hk = 0; hk < 2; ++hk) {
        f32x4 sc[2][8];
#pragma unroll
        for (int kt = 0; kt < 8; ++kt) { sc[0][kt] = (f32x4){0.f, 0.f, 0.f, 0.f}; sc[1][kt] = (f32x4){0.f, 0.f, 0.f, 0.f};
#pragma unroll
            for (int kh = 0; kh < 2; ++kh) {
                bf16x8 Kf[4];
#pragma unroll
                for (int k4 = 0; k4 < 4; ++k4) Kf[k4] = *(const LAS bf16x8*)(lds + (16 * (8 * hk + kt) + q) * 512 + (((4 * (4 * kh + k4) + G) ^ q) << 4));
                __builtin_amdgcn_sched_barrier(0);
#pragma unroll
                for (int k4 = 0; k4 < 4; ++k4) {
                    sc[0][kt] = __builtin_amdgcn_mfma_f32_16x16x32_bf16(Kf[k4], Qf[0][4 * kh + k4], sc[0][kt], 0, 0, 0);
                    sc[1][kt] = __builtin_amdgcn_mfma_f32_16x16x32_bf16(Kf[k4], Qf[1][4 * kh + k4], sc[1][kt], 0, 0, 0); }
                __builtin_amdgcn_sched_barrier(0); } }
#pragma unroll
        for (int qt = 0; qt < 2; ++qt)
#pragma unroll
            for (int s2 = 0; s2 < 4; ++s2) { float e[8];
#pragma unroll
                for (int r = 0; r < 4; ++r) { e[r] = __builtin_amdgcn_exp2f(sc[qt][2 * s2][r] * rq[qt]); e[4 + r] = __builtin_amdgcn_exp2f(sc[qt][2 * s2 + 1][r] * rq[qt]); }
                lsum[qt] += ((e[0] + e[1]) + (e[2] + e[3])) + ((e[4] + e[5]) + (e[6] + e[7]));
                v4u pw; pw.x = pk2(e[0], e[1]); pw.y = pk2(e[2], e[3]); pw.z = pk2(e[4], e[5]); pw.w = pk2(e[6], e[7]); Pf[qt][4 * hk + s2] = __builtin_bit_cast(bf16x8, pw); }
    }
    __syncthreads();
    xa_fill_image(lds, Vt_h, w, lane);
    float linv[2];
#pragma unroll
    for (int qt = 0; qt < 2; ++qt) { float l = lsum[qt]; l += __shfl_xor(l, 16); l += __shfl_xor(l, 32); linv[qt] = 1.0f / l; }
    asm volatile("s_waitcnt vmcnt(0)" ::: "memory"); __syncthreads();
    bf16* op0 = Ob + (row0 + q) * 1024 + h * 256 + 4 * G; bf16* op1 = op0 + (size_t)16 * 1024;
#pragma unroll
    for (int dt = 0; dt < 16; ++dt) { f32x4 o0 = (f32x4){0.f, 0.f, 0.f, 0.f}, o1 = o0;
        LAS unsigned char* vrow = lds + (16 * dt + q) * 512 + (G & 1) * 8;
        s16x4 va[8], vb[8];
#pragma unroll
        for (int s2 = 0; s2 < 8; ++s2) { va[s2] = *(const LAS s16x4*)(vrow + (((4 * s2 + (G >> 1)) ^ q) << 4)); vb[s2] = *(const LAS s16x4*)(vrow + (((4 * s2 + 2 + (G >> 1)) ^ q) << 4)); }
        __builtin_amdgcn_sched_barrier(0);
#pragma unroll
        for (int s2 = 0; s2 < 8; ++s2) { const bf16x8 Vf = (bf16x8){va[s2][0], va[s2][1], va[s2][2], va[s2][3], vb[s2][0], vb[s2][1], vb[s2][2], vb[s2][3]};
            o0 = __builtin_amdgcn_mfma_f32_16x16x32_bf16(Vf, Pf[0][s2], o0, 0, 0, 0); o1 = __builtin_amdgcn_mfma_f32_16x16x32_bf16(Vf, Pf[1][s2], o1, 0, 0, 0); }
        __builtin_amdgcn_sched_barrier(0);
        v2u w0, w1; w0.x = pk2(o0[0] * linv[0], o0[1] * linv[0]); w0.y = pk2(o0[2] * linv[0], o0[3] * linv[0]); w1.x = pk2(o1[0] * linv[1], o1[1] * linv[1]); w1.y = pk2(o1[2] * linv[1], o1[3] * linv[1]);
        *(GAS v2u*)(op0 + 16 * dt) = w0; *(GAS v2u*)(op1 + 16 * dt) = w1; }
    __syncthreads();
}

__device__ __forceinline__ float rcp_(float x) { return __builtin_amdgcn_rcpf(x); }
__device__ __forceinline__ float sigmoid_fast(float x) { return rcp_(1.0f + __builtin_amdgcn_exp2f(-LOG2E * x)); }
__device__ __forceinline__ float gelu_tanh(float x) { const float u = 0.7978845608028654f * (x + 0.044715f * x * x * x); const float e = __builtin_amdgcn_exp2f((2.0f * LOG2E) * u); return x * (1.0f - rcp_(e + 1.0f)); }
__device__ __forceinline__ void r1_unit(LAS unsigned char* lds, const bf16* proj, const float* cw, const float* cb, const bf16* GaT, const bf16* GxT, const float* ba, const float* bx, const float* lam,
                                        bf16* Y0, int y0p, bf16* Y1, float* Aend, float* Hend, int uid, int tid) {
    asm volatile("" : "+v"(tid));
    const int g = uid & 3, chunk = (uid >> 2) & 31, b = uid >> 7, t0 = chunk * 128;
    const size_t rowb = (size_t)b * SEQ;
    LAS unsigned char* lxc = lds; LAS unsigned char* lgt = lds + 32768; LAS unsigned char* ly0 = lds + 65536; LAS unsigned char* ly1 = lds + 98304;
    {
        const int c8 = tid & 15, ch0 = 128 * g + 8 * c8;
        float wj[4][8], bb[8];
#pragma unroll
        for (int jj = 0; jj < 4; ++jj) { const f32x4 a = *(const GAS f32x4*)(cw + jj * 512 + ch0), c = *(const GAS f32x4*)(cw + jj * 512 + ch0 + 4);
            wj[jj][0] = a[0]; wj[jj][1] = a[1]; wj[jj][2] = a[2]; wj[jj][3] = a[3]; wj[jj][4] = c[0]; wj[jj][5] = c[1]; wj[jj][6] = c[2]; wj[jj][7] = c[3]; }
        { const f32x4 a = *(const GAS f32x4*)(cb + ch0), c = *(const GAS f32x4*)(cb + ch0 + 4); bb[0] = a[0]; bb[1] = a[1]; bb[2] = a[2]; bb[3] = a[3]; bb[4] = c[0]; bb[5] = c[1]; bb[6] = c[2]; bb[7] = c[3]; }
#pragma unroll
        for (int i = 0; i < 4; ++i) { const int tt = (tid >> 4) + 32 * i, t = t0 + tt;
            float a[8];
#pragma unroll
            for (int e = 0; e < 8; ++e) a[e] = bb[e];
#pragma unroll
            for (int jj = 0; jj < 4; ++jj) { const int ts = t - 3 + jj;
                v4u x = *(const GAS v4u*)(proj + (rowb + (ts < 0 ? 0 : ts)) * INC + 1536 + ch0);
                if (ts < 0) x = (v4u){0u, 0u, 0u, 0u};
                a[0] += wj[jj][0] * bflo(x.x); a[1] += wj[jj][1] * bfhi(x.x); a[2] += wj[jj][2] * bflo(x.y); a[3] += wj[jj][3] * bfhi(x.y);
                a[4] += wj[jj][4] * bflo(x.z); a[5] += wj[jj][5] * bfhi(x.z); a[6] += wj[jj][6] * bflo(x.w); a[7] += wj[jj][7] * bfhi(x.w); }
            v4u o; o.x = pk2(a[0], a[1]); o.y = pk2(a[2], a[3]); o.z = pk2(a[4], a[5]); o.w = pk2(a[6], a[7]);
            *(LAS v4u*)(lxc + tt * 256 + ((c8 ^ (tt & 15)) << 4)) = o;
            *(LAS v4u*)(lgt + tt * 256 + ((c8 ^ (tt & 15)) << 4)) = *(const GAS v4u*)(proj + (rowb + t) * INC + 2048 + ch0); }
    }
    const int w = tid >> 6, lane = tid & 63, q = lane & 15, G = lane >> 4;
    const int dd = 16 * w + q, ch = 128 * g + dd;
    bf16x8 Wa[4], Wx[4];
#pragma unroll
    for (int ks = 0; ks < 4; ++ks) { Wa[ks] = __builtin_bit_cast(bf16x8, *(const GAS v4u*)(GaT + dd * 128 + 32 * ks + 8 * G)); Wx[ks] = __builtin_bit_cast(bf16x8, *(const GAS v4u*)(GxT + dd * 128 + 32 * ks + 8 * G)); }
    const float bav = ba[ch], bxv = bx[ch], lv = lam[ch]; const float sp8 = 8.0f * __logf(1.0f + __expf(-lv));
    __syncthreads();
    float Arun = 1.f, Hrun = 0.f;
    const int xoff = ((dd >> 3) << 4), xlo = (dd & 7) * 2;
#pragma unroll 2
    for (int tt8 = 0; tt8 < 8; ++tt8) {
        f32x4 aA = (f32x4){0.f, 0.f, 0.f, 0.f}, aX = (f32x4){0.f, 0.f, 0.f, 0.f};
        bf16x8 Xf[4];
#pragma unroll
        for (int ks = 0; ks < 4; ++ks) Xf[ks] = *(const LAS bf16x8*)(lxc + (16 * tt8 + q) * 256 + (((4 * ks + G) ^ q) << 4));
        float xcv4[4], gtv4[4];
#pragma unroll
        for (int e = 0; e < 4; ++e) { const int tt = 16 * tt8 + 4 * G + e; const int so = tt * 256 + (xoff ^ ((tt & 15) << 4)) + xlo;
            xcv4[e] = bf1(*(const LAS bf16*)(lxc + so)); gtv4[e] = bf1(*(const LAS bf16*)(lgt + so)); }
        __builtin_amdgcn_sched_barrier(0);
#pragma unroll
        for (int ks = 0; ks < 4; ++ks) {
            aA = __builtin_amdgcn_mfma_f32_16x16x32_bf16(Xf[ks], Wa[ks], aA, 0, 0, 0); aX = __builtin_amdgcn_mfma_f32_16x16x32_bf16(Xf[ks], Wx[ks], aX, 0, 0, 0); }
        float Ac[4], Hc[4]; float Ar = 1.f, Hr = 0.f;
#pragma unroll
        for (int e = 0; e < 4; ++e) {
            const float xcv = xcv4[e];
            const float rg = sigmoid_fast(aA[e] + bav), ig = sigmoid_fast(aX[e] + bxv), la = -sp8 * rg, a = __builtin_amdgcn_exp2f(LOG2E * la);
            const float y = 2.0f * la; float pl = 1.0f / 120.0f; pl = pl * y + (1.0f / 24.0f); pl = pl * y + (1.0f / 6.0f); pl = pl * y + 0.5f; pl = pl * y + 1.0f;
            const float u = __builtin_amdgcn_sqrtf(-y * pl) * (ig * xcv);
            Hr = a * Hr + u; Ar = a * Ar; Ac[e] = Ar; Hc[e] = Hr; }
        float Ai = Ar, Hi = Hr;
        { const float Ap = __shfl_up(Ai, 16), Hp = __shfl_up(Hi, 16); if (G >= 1) { Hi = Ai * Hp + Hi; Ai = Ai * Ap; } }
        { const float Ap = __shfl_up(Ai, 32), Hp = __shfl_up(Hi, 32); if (G >= 2) { Hi = Ai * Hp + Hi; Ai = Ai * Ap; } }
        float Ae = __shfl_up(Ai, 16), He = __shfl_up(Hi, 16); if (G == 0) { Ae = 1.f; He = 0.f; }
        const float At = __shfl(Ai, 48 + q), Ht = __shfl(Hi, 48 + q);
        const float Ap0 = Ae * Arun, Hp0 = Ae * Hrun + He;
#pragma unroll
        for (int e = 0; e < 4; ++e) { const int tt = 16 * tt8 + 4 * G + e;
            const float Pv = Ac[e] * Ap0, hl = Hc[e] + Ac[e] * Hp0;
            const int so = tt * 256 + (xoff ^ ((tt & 15) << 4)) + xlo;
            const float gg = gelu_tanh(gtv4[e]);
            *(LAS bf16*)(ly0 + so) = f2bf(hl * gg); *(LAS bf16*)(ly1 + so) = f2bf(Pv * gg); }
        Hrun = At * Hrun + Ht; Arun = At * Arun;
    }
    if (G == 0) { Aend[(size_t)(b * 32 + chunk) * 512 + ch] = Arun; Hend[(size_t)(b * 32 + chunk) * 512 + ch] = Hrun; }
    __syncthreads();
    {
        const int c8 = tid & 15;
#pragma unroll
        for (int i = 0; i < 4; ++i) { const int tt = (tid >> 4) + 32 * i; const int so = tt * 256 + ((c8 ^ (tt & 15)) << 4); const size_t row = rowb + t0 + tt; const int cc = 128 * g + 8 * c8;
            *(GAS v4u*)(Y0 + row * y0p + cc) = *(const LAS v4u*)(ly0 + so); *(GAS v4u*)(Y1 + row * 512 + cc) = *(const LAS v4u*)(ly1 + so); }
    }
    __syncthreads();
}

__device__ __forceinline__ void post_unit(LAS unsigned char* lds, const bf16* __restrict__ num, const float* __restrict__ den, const bf16* __restrict__ Y0, int y0p, const bf16* __restrict__ Y1, const float* __restrict__ Aend, const float* __restrict__ Hend, bf16* __restrict__ aout, int uid, int tid) {
    asm volatile("" : "+v"(tid));
    const int row0 = uid * 64, b = row0 >> 12, chunk = (row0 & 4095) >> 7;
    LAS float* hin = (LAS float*)lds;
    { float H = 0.f; const float* ae = Aend + (size_t)(b * 32) * 512 + tid; const float* he = Hend + (size_t)(b * 32) * 512 + tid;
      int s0 = 0;
      for (; s0 + 8 <= chunk; s0 += 8) { float av[8], hv8[8];
#pragma unroll
          for (int j = 0; j < 8; ++j) { av[j] = ae[(size_t)(s0 + j) * 512]; hv8[j] = he[(size_t)(s0 + j) * 512]; }
#pragma unroll
          for (int j = 0; j < 8; ++j) H = av[j] * H + hv8[j]; }
      for (; s0 < chunk; ++s0) H = ae[(size_t)s0 * 512] * H + he[(size_t)s0 * 512];
      hin[tid] = H; }
    __syncthreads();
    const int c8 = tid & 63, rsub = tid >> 6, h = c8 >> 4;
    float hv[8];
#pragma unroll
    for (int e = 0; e < 8; ++e) hv[e] = hin[8 * c8 + e];
#pragma unroll
    for (int half = 0; half < 2; ++half) {
        v4u ya[4], yp[4], na[4], nb[4], nc[4]; float dn[4];
#pragma unroll
        for (int i = 0; i < 4; ++i) { const size_t row = row0 + rsub + 8 * (4 * half + i);
#ifdef POST_NT
            ya[i] = __builtin_nontemporal_load((const GAS v4u*)(Y0 + row * y0p + 8 * c8)); yp[i] = __builtin_nontemporal_load((const GAS v4u*)(Y1 + row * 512 + 8 * c8));
            na[i] = __builtin_nontemporal_load((const GAS v4u*)(num + ((size_t)0 * NUM_GS + row) * 512 + 8 * c8)); nb[i] = __builtin_nontemporal_load((const GAS v4u*)(num + ((size_t)1 * NUM_GS + row) * 512 + 8 * c8)); nc[i] = __builtin_nontemporal_load((const GAS v4u*)(num + ((size_t)2 * NUM_GS + row) * 512 + 8 * c8));
#else
            ya[i] = *(const GAS v4u*)(Y0 + row * y0p + 8 * c8); yp[i] = *(const GAS v4u*)(Y1 + row * 512 + 8 * c8);
            na[i] = *(const GAS v4u*)(num + ((size_t)0 * NUM_GS + row) * 512 + 8 * c8); nb[i] = *(const GAS v4u*)(num + ((size_t)1 * NUM_GS + row) * 512 + 8 * c8); nc[i] = *(const GAS v4u*)(num + ((size_t)2 * NUM_GS + row) * 512 + 8 * c8);
#endif
            dn[i] = den[((size_t)0 * T + row) * 4 + h] + den[((size_t)1 * T + row) * 4 + h] + den[((size_t)2 * T + row) * 4 + h]; }
#pragma unroll
        for (int i = 0; i < 4; ++i) { const size_t row = row0 + rsub + 8 * (4 * half + i);
            { const v4u a = ya[i], p = yp[i]; v4u o;
              o.x = pk2(bflo(a.x) + bflo(p.x) * hv[0], bfhi(a.x) + bfhi(p.x) * hv[1]); o.y = pk2(bflo(a.y) + bflo(p.y) * hv[2], bfhi(a.y) + bfhi(p.y) * hv[3]);
              o.z = pk2(bflo(a.z) + bflo(p.z) * hv[4], bfhi(a.z) + bfhi(p.z) * hv[5]); o.w = pk2(bflo(a.w) + bflo(p.w) * hv[6], bfhi(a.w) + bfhi(p.w) * hv[7]);
              *(GAS v4u*)(aout + row * 1024 + 512 + 8 * c8) = o; }
            { const float inv = 1.0f / dn[i]; const v4u a = na[i], bq = nb[i], c = nc[i]; v4u o;
              o.x = pk2((bflo(a.x) + bflo(bq.x) + bflo(c.x)) * inv, (bfhi(a.x) + bfhi(bq.x) + bfhi(c.x)) * inv); o.y = pk2((bflo(a.y) + bflo(bq.y) + bflo(c.y)) * inv, (bfhi(a.y) + bfhi(bq.y) + bfhi(c.y)) * inv);
              o.z = pk2((bflo(a.z) + bflo(bq.z) + bflo(c.z)) * inv, (bfhi(a.z) + bfhi(bq.z) + bfhi(c.z)) * inv); o.w = pk2((bflo(a.w) + bflo(bq.w) + bflo(c.w)) * inv, (bfhi(a.w) + bfhi(bq.w) + bfhi(c.w)) * inv);
              *(GAS v4u*)(aout + row * 1024 + 8 * c8) = o; } }
    }
    __syncthreads();
}

__device__ __forceinline__ f32x4 up4(v2u w) { return (f32x4){bflo(w.x), bfhi(w.x), bflo(w.y), bfhi(w.y)}; }
template <int W> __device__ __forceinline__ void poolprep_rows(const bf16* __restrict__ x, bf16* __restrict__ dd, const LAS float* rs  , size_t rbase  , int ts, int c) {
    v2u rw[W - 1 + 32];
#pragma unroll
    for (int i = 0; i < W - 1 + 32; ++i) { const int t = ts - (W - 1) + i; rw[i] = *(const GAS v2u*)(x + (t >= 0 ? rbase + i - (W - 1) : rbase) * 1024 + c); if (t < 0) rw[i] = (v2u){0u, 0u}; }
    f32x4 sum = (f32x4){0.f, 0.f, 0.f, 0.f};
#pragma unroll
    for (int i = 0; i < W - 1; ++i) sum += up4(rw[i]) * rs[15 - (W - 1) + i];
#pragma unroll
    for (int k = 0; k < 32; ++k) { const int t = ts + k;
        const f32x4 hcur = up4(rw[W - 1 + k]) * rs[15 + k];
        sum += hcur;
        const int cnt = (t + 1 < W) ? t + 1 : W; const float inv = 1.0f / (float)cnt;
        const f32x4 dv = sum * inv - hcur;
        v2u o; o.x = pk2(dv[0], dv[1]); o.y = pk2(dv[2], dv[3]); *(GAS v2u*)(dd + (rbase + k) * 1024 + c) = o;
        sum -= up4(rw[k]) * rs[15 + k - (W - 1)]; }
}
__device__ __forceinline__ void poolprep_unit(LAS unsigned char* lds, const bf16* x, const float* ss, bf16* dd, int pm, int g, int tid) {
    asm volatile("" : "+v"(tid));
    pm = __builtin_amdgcn_readfirstlane(pm); g = __builtin_amdgcn_readfirstlane(g);
    const int row0 = pm * 256, tb = row0 & 4095;
    LAS float* rs = (LAS float*)lds;
    if (tid < 271) { const int t = tb - 15 + tid; float r = 0.f;
        if (t >= 0) { const f32x4* p = (const f32x4*)(ss + (size_t)(row0 - 15 + tid) * 16); const f32x4 a = p[0], b4 = p[1], c4 = p[2], d4 = p[3];
            const float s = ((a[0] + a[1]) + (a[2] + a[3])) + ((b4[0] + b4[1]) + (b4[2] + b4[3])) + ((c4[0] + c4[1]) + (c4[2] + c4[3])) + ((d4[0] + d4[1]) + (d4[2] + d4[3]));
            r = 1.0f / sqrtf(s * (1.0f / 1024.0f) + EPS); }
        rs[tid] = r; }
    __syncthreads();
    const int c = 256 * g + 4 * (tid & 63), rblk = tid >> 6;
    const int ts = tb + 32 * rblk; const size_t rbase = (size_t)row0 + 32 * rblk; const LAS float* rsh = rs + 32 * rblk;
    if (g == 0) poolprep_rows<2>(x, dd, rsh, rbase, ts, c);
    else if (g == 1) poolprep_rows<4>(x, dd, rsh, rbase, ts, c);
    else if (g == 2) poolprep_rows<8>(x, dd, rsh, rbase, ts, c);
    else poolprep_rows<16>(x, dd, rsh, rbase, ts, c);
    __syncthreads();
}

#ifndef MK_TEST
constexpr int N_PHASES = 41;
__global__ void __launch_bounds__(NWAVES * 64, 2) mk_fwd(Args args) {
    extern __shared__ __attribute__((aligned(16))) unsigned char lds_raw[];
    LAS unsigned char* lds = (LAS unsigned char*)lds_raw;
    volatile LAS unsigned* MISC = (volatile LAS unsigned*)(lds + MISC_OFF);
#define ws ld_ws(args)
    const int tid = threadIdx.x, wave = __builtin_amdgcn_readfirstlane(tid >> 6);
    const int G = gridDim.x, bid = blockIdx.x;
    const int vcu = (G % 8 == 0) ? (bid % 8) * (G / 8) + bid / 8 : bid;
    const int gw = vcu * NWAVES + wave, NGW = G * NWAVES;
    const int p = (bid >> 3) & 3, c = (bid & 7) | ((bid >> 5) << 3);
    const int PG = 64, gwp = c * NWAVES + wave, NGWP = PG * NWAVES;
    for (int u = tid; u < (LDS_BYTES - LDSCTL_OFF) / 4; u += NWAVES * 64) ((LAS unsigned*)(lds + LDSCTL_OFF))[u] = 0u;
    __syncthreads();
    unsigned* ctl = (unsigned*)(ws + WS_CTL);
    XcdBarrier bar0; bar0.bar = ctl + 1024; bar0.x = 0; bar0.st = nullptr; bar0.G = 0;
    XcdBarrier bar = bar0;
    if (MK_N_LAUNCHES == 1) { bar0 = xcd_barrier_post(ctl + 1024, MISC + 8, (unsigned)G); bar = xcd_barrier_post(ctl + 1024 + 4096 * (1 + p), MISC + 10, (unsigned)PG); }
#if MK_N_LAUNCHES != 1
    const int lo = args.ph_lo, hi = args.ph_hi;
#endif
#if MK_N_LAUNCHES == 1
#define IN(k) true
#else
#define IN(k) (lo <= (k) && (k) < hi)
#endif
#ifdef GLOBAL_BAR
#define SEAM(k) do { if (MK_N_LAUNCHES == 1 && (k) + 1 < N_PHASES) { for (int b_ = 0; b_ < REP_BAR; ++b_) xcd_barrier(bar0); } } while (0)
#else
#define SEAM(k) do { if (MK_N_LAUNCHES == 1 && (k) + 1 < N_PHASES) { for (int b_ = 0; b_ < REP_BAR; ++b_) xcd_barrier(bar); } } while (0)
#endif
#define ZEROS ((const float*)(ws + WS_CTL + 98304))
#define LOCAL_SEAM() do { if (MK_N_LAUNCHES == 1) { asm volatile("s_waitcnt vmcnt(0)" ::: "memory"); __syncthreads(); if (tid == 0) { __builtin_amdgcn_fence(__ATOMIC_ACQUIRE, "agent"); asm volatile("s_waitcnt vmcnt(0)" ::: "memory"); } __syncthreads(); } } while (0)
#define RB ((size_t)p * SEQ)
#define SS ((float*)(ws + WS_SS) + RB * 16)
#define QSS ((float*)(ws + WS_QSS) + RB * 16)
#define LSUM ((float*)(ws + WS_LSUM) + RB * 16)
#define DEN ((float*)(ws + WS_DEN) + RB * 4)
#define AEND ((float*)(ws + WS_AEND) + (size_t)p * 32 * 512)
#define HEND ((float*)(ws + WS_HEND) + (size_t)p * 32 * 512)
#define XB ((bf16*)(ws + WS_XB) + RB * 1024)
#define HB (ws + WS_HID + (size_t)p * 32 * MiB)
#define PROJ ((bf16*)HB)
#define NUM ((bf16*)(HB + 20 * MiB))
#define AOUT ((bf16*)HB)
#define QB ((bf16*)(HB + 8 * MiB))
#define PB ((bf16*)(HB + 16 * MiB))
#define OB ((bf16*)(HB + 24 * MiB))
#define HID ((bf16*)HB)
#define DOP ((unsigned char*)OUTP() + (size_t)p * DO_PIPE)
#define Y0 ((bf16*)(DOP + DO_Y0))
#define Y1 ((bf16*)(DOP + DO_Y1))
#define KVRAW ((bf16*)(DOP + DO_KVRAW))
#define MEMN ((bf16*)(DOP + DO_MEMN))
#define KNP ((bf16*)(DOP + DO_KN))
#define VTP ((bf16*)(DOP + DO_VT))
#ifdef USE_STATIC_ORDER
#define PIPE_ORDER pg8::StaticOrder
#else
#define PIPE_ORDER pg8::XcdOrder
#endif
#ifndef P0B_C0
#define P0B_C0 0
#define P0B_C1 4
#define P0B_C2 12
#endif
#ifndef P0_INFLIGHT
#define P0_INFLIGHT 2
#endif
#ifndef HID_SLAB
#define HID_SLAB 0
#endif
#ifndef CLK_PH
#define CLK_PH -1
#endif
#ifndef STAG
#define STAG 2000
#endif
    if (IN(0)) { if (MK_N_LAUNCHES == 1 && REP_P0 > 1) xcd_barrier_discover(bar0);
        REPEAT(REP_P0) { p0_prologue(args, lds, gw, NGW, wave); if (MK_N_LAUNCHES == 1 && rep_ + 1 < REP_P0) xcd_barrier(bar0); }
        if (MK_N_LAUNCHES == 1) { if (REP_P0 <= 1) xcd_barrier_discover(bar0);
            xcd_barrier(bar0); xcd_barrier_discover(bar);
#ifdef P0_SLEEP_SKEW
            const unsigned long long t0_ = wall_clock64(); const unsigned long long dl_ = (unsigned long long)p * STAG; while (wall_clock64() - t0_ < dl_) __builtin_amdgcn_s_sleep(8);
            if (p > 0) p0_items<1>(args, lds, (p == 1 ? 0 : p == 2 ? P0_NB / 6 : P0_NB / 2), (p == 1 ? P0_NB / 6 : p == 2 ? P0_NB / 2 : P0_NB), gwp, NGWP, wave);
#else
            { constexpr int U = P0_NB / 24; const int c0 = P0B_C0 * U, c1 = P0B_C1 * U, c2 = P0B_C2 * U;
              const int f_ = p == 0 ? 0 : p == 1 ? c0 : p == 2 ? c1 : c2, l_ = p == 0 ? c0 : p == 1 ? c1 : p == 2 ? c2 : P0_NB;
              if (l_ > f_) p0_items<1>(args, lds, f_, l_, gwp, NGWP, wave); }
#endif
            {
                asm volatile("s_waitcnt vmcnt(0)" ::: "memory"); __syncthreads();
                if (tid == 0) { __builtin_amdgcn_fence(__ATOMIC_RELEASE, "agent"); asm volatile("s_waitcnt vmcnt(0)" ::: "memory"); (void)xb_add(ctl + 512, 1u); } } } }

    for (int l = 0; l < 4; ++l) {
        const int pb = 1 + 10 * l;
        if (l == 1 && MK_N_LAUNCHES == 1) {
            if (tid == 0) { XB_SPIN(xb_ld(ctl + 512) < 256u, bar0.bar); __builtin_amdgcn_fence(__ATOMIC_ACQUIRE, "agent"); asm volatile("s_waitcnt vmcnt(0)" ::: "memory"); }
            __syncthreads(); }
        if ((l & 1) == 0) {
            const int e = l >> 1;
            if (IN(pb + 0)) { REPEAT(REP_A1) {
                { pg8::Gemm g{XB, (const bf16*)(ws + WS_WIN) + (size_t)e * INC * D, D, D, D, ~0, 0, (long)256 * D, 30, 0};
                  PIPE_ORDER S; S.init(SEQ / 256, INC / 256, PG, c);
                  pg8::EpiBf16<1> E{PROJ, INC, SS, nullptr};
                  pg8::gemm_phase(lds, g, S, E); }
                if (l == 0) { pg8::Gemm g{MEMN, (const bf16*)(ws + WS_WKV), D, D, D, 0, 0, (long)256 * D, 0, (long)2048 * D};
                  pg8::StaticOrder S; S.init(4, 8, PG - 32, c >= 32 ? c - 32 : (1 << 20));
                  pg8::EpiBf16<0> E{KVRAW, 2048, nullptr, nullptr};
                  pg8::gemm_phase(lds, g, S, E); }
                REP_SEAM(REP_A1); }
                SEAM(pb + 0); }
            if (IN(pb + 1)) { REPEAT(REP_A2) {
                if (l == 0) for (int r2_ = 0; r2_ < REP_KVF; ++r2_) kv_finalize(args, KVRAW, KNP, VTP, gwp, NGWP);
                for (int r2_ = 0; r2_ < REP_ATTN; ++r2_) {
                    for (int sgi = 0; sgi < 2; ++sgi) {
                        int g_, h_, r_, n0_, L_;
                        if (sgi == 1) { g_ = 2; h_ = c >> 4; r_ = c & 15; n0_ = 0; L_ = 2; }
                        else if (c < 32) { g_ = 0; h_ = c >> 3; r_ = 0; n0_ = 4 * (c & 7); L_ = 4; }
                        else { const int id = c - 32, chain = id >> 1; g_ = 1; h_ = chain >> 2; r_ = chain & 3; n0_ = 4 * (id & 1); L_ = 4; }
#ifdef CLK_ACC
                        const unsigned long long ta0_ = wall_clock64();
#endif
                        attn_segment(lds, PROJ, INP(7) + e * 128, INP(8) + e * 128, NUM, DEN, g_, h_, r_, n0_, L_, tid);
#ifdef CLK_ACC
                        if (tid == 0) MISC[16 + 7] += (unsigned)(wall_clock64() - ta0_);
#endif
                    }
                }
                for (int u = c; u < 128; u += PG) for (int r2_ = 0; r2_ < REP_R1; ++r2_) {
#ifdef CLK_ACC
                    const unsigned long long tr0_ = wall_clock64();
#endif
                    r1_unit(lds, PROJ, INP(9) + e * 2048, INP(10) + e * 512, (const bf16*)(ws + WS_GT) + (size_t)((e * 2 + 0) * 4 + (u & 3)) * 16384, (const bf16*)(ws + WS_GT) + (size_t)((e * 2 + 1) * 4 + (u & 3)) * 16384,
                            INP(12) + e * 512, INP(14) + e * 512, INP(15) + e * 512, Y0, 512, Y1, AEND, HEND, u, tid);
#ifdef CLK_ACC
                    if (tid == 0) MISC[16 + 6] += (unsigned)(wall_clock64() - tr0_);
#endif
                }
                REP_SEAM(REP_A2); }
                SEAM(pb + 1); }
            if (IN(pb + 2)) { REPEAT(REP_A3) {
                post_unit(lds, NUM, DEN, Y0, 512, Y1, AEND, HEND, AOUT, c, tid);
                REP_SEAM(REP_A3); }
                SEAM(pb + 2); }
            if (IN(pb + 3)) { REPEAT(REP_A4) {
                pg8::Gemm g{AOUT, (const bf16*)(ws + WS_WOUT) + (size_t)e * D * D, D, D, D, ~0, 0, (long)256 * D, 30, 0};
                PIPE_ORDER S; S.init(SEQ / 256, 4, PG, c);
                pg8::EpiRes E{nullptr, XB, SS, rep_ ? ZEROS : nullptr};
                pg8::gemm_phase(lds, g, S, E);
                REP_SEAM(REP_A4); }
                SEAM(pb + 3); }
        } else {
            const int o = l >> 1;
            if (IN(pb + 0)) { REPEAT(REP_B1) {
                { PIPE_ORDER S; S.init(SEQ / 256, 4, PG, c); pg8::Unit u; if (S.next(0, u)) poolprep_unit(lds, XB, SS, AOUT, u.pm, u.pn, tid); }
                REP_SEAM(REP_B1); }
                LOCAL_SEAM(); }
            if (IN(pb + 1)) { REPEAT(REP_B2) {
                pg8::Gemm g{AOUT, (const bf16*)(ws + WS_POOLT) + (size_t)o * 4 * 65536, D, 256, 256, ~0, 256, (long)65536, 30, 0};
                PIPE_ORDER S; S.init(SEQ / 256, 4, PG, c);
                pg8::EpiRes E{nullptr, XB, SS, rep_ ? ZEROS : INP(18) + o * D};
                pg8::gemm_phase(lds, g, S, E);
                REP_SEAM(REP_B2); }
                SEAM(pb + 3); }
        }
#ifdef CLK_ACC
        if (tid == 0) MISC[16 + 14] = (CLK_PH == 4 || CLK_PH < 0) ? 1u : 0u;
#endif
        if (IN(pb + 4)) { REPEAT(REP_X1) {
            pg8::Gemm g{XB, (const bf16*)(ws + WS_WQ) + (size_t)l * D * D, D, D, D, ~0, 0, (long)256 * D, 30, 0};
            PIPE_ORDER S; S.init(SEQ / 256, 4, PG, c);
            pg8::EpiBf16<3> E{QB, D, SS, QSS};
            pg8::gemm_phase(lds, g, S, E);
            REP_SEAM(REP_X1); }
#ifdef NO_LOCAL_SEAM
            SEAM(pb + 4);
#else
            LOCAL_SEAM();
#endif
            }
#ifndef XA_UNFUSED
        if (IN(pb + 5)) { REPEAT(REP_X2) {
            { PIPE_ORDER S; S.init(SEQ / 256, 4, PG, c); pg8::Unit u; if (S.next(0, u)) xa_unit(lds, QB, QSS, KNP + (size_t)l * 4 * 65536 + (size_t)u.pn * 65536, VTP + (size_t)l * 4 * 65536 + (size_t)u.pn * 65536, OB, u.pm, u.pn, tid); }
            REP_SEAM(REP_X2); }
            SEAM(pb + 6); }
#else
        if (IN(pb + 5)) { REPEAT(REP_X2) {
            pg8::Gemm g{QB, KNP + (size_t)l * 4 * 65536, D, 256, 256, ~0, 256, (long)65536, 30, 0};
            PIPE_ORDER S; S.init(SEQ / 256, 4, PG, c);
            pg8::EpiBf16<4> E{PB, D, QSS, LSUM};
            pg8::gemm_phase(lds, g, S, E);
            REP_SEAM(REP_X2); }
#ifdef NO_LOCAL_SEAM
            SEAM(pb + 5);
#else
            LOCAL_SEAM();
#endif
            }
        if (IN(pb + 6)) { REPEAT(REP_X3) {
            pg8::Gemm g{PB, VTP + (size_t)l * 4 * 65536, D, 256, 256, ~0, 256, (long)65536, 30, 0};
            PIPE_ORDER S; S.init(SEQ / 256, 4, PG, c);
            pg8::EpiBf16<5> E{OB, D, LSUM, nullptr};
            pg8::gemm_phase(lds, g, S, E);
            REP_SEAM(REP_X3); }
            SEAM(pb + 6); }
#endif
        if (IN(pb + 7)) { REPEAT(REP_X4) {
            pg8::Gemm g{OB, (const bf16*)(ws + WS_WO) + (size_t)l * D * D, D, D, D, ~0, 0, (long)256 * D, 30, 0};
            PIPE_ORDER S; S.init(SEQ / 256, 4, PG, c);
            pg8::EpiRes E{nullptr, XB, SS, rep_ ? ZEROS : nullptr};
            pg8::gemm_phase(lds, g, S, E);
            REP_SEAM(REP_X4); }
            SEAM(pb + 7); }
#ifdef CLK_ACC
        if (tid == 0) MISC[16 + 14] = (CLK_PH == 8 || CLK_PH < 0) ? 1u : 0u;
#endif
        if (IN(pb + 8)) { REPEAT(REP_M1) {
            pg8::Gemm g{XB, (const bf16*)(ws + WS_W1) + (size_t)l * FF * D, D, D, D, ~0, 0, (long)256 * D, 30, 0};
            PIPE_ORDER S; S.init(SEQ / 256, FF / 256, PG, c);
            pg8::EpiBf16<2, HID_SLAB != 0> E{HID, FF, SS, nullptr};
            pg8::gemm_phase(lds, g, S, E);
            REP_SEAM(REP_M1); }
            SEAM(pb + 8); }
#ifdef CLK_ACC
        if (tid == 0) MISC[16 + 14] = (CLK_PH == 9 || CLK_PH < 0) ? 1u : 0u;
#endif
        if (IN(pb + 9)) { REPEAT(REP_M2) {
            pg8::Gemm g{HID, (const bf16*)(ws + WS_W2) + (size_t)l * D * FF, HID_SLAB ? 64 : FF, FF, FF, ~0, 0, (long)256 * FF, 30, 0, HID_SLAB ? (long)256 * 64 : (long)64, (long)256 * FF};
            PIPE_ORDER S; S.init(SEQ / 256, 4, PG, c);
            pg8::EpiRes E{(l == 3 && rep_ == 0) ? OUTP() + RB * 1024 : nullptr, XB, SS, rep_ ? ZEROS : nullptr};
            pg8::gemm_phase(lds, g, S, E);
            REP_SEAM(REP_M2); }
            SEAM(pb + 9); }
    }
#ifdef CLK_ACC
    xcd_barrier(bar0);
    if (bid == 0 && tid == 0) { const float us = (float)MISC[16 + CLK_ACC] * 0.01f; OUTP()[0] = floorf(us / (float)CLK_STEP + 0.5f) * (float)CLK_STEP * 1000.0f; }
#endif
#ifdef WS_PROBE
    xcd_barrier(bar0);
    if (bid == 0 && tid == 0) OUTP()[0] = (float)args.ph_hi * 1000.0f;
#endif
#undef IN
#undef SEAM
#undef ws
}
#endif

extern "C" void kernel_launch(void* const* d_in, const int* in_sizes, int n_in, void* d_out, int out_size, void* d_ws, size_t ws_size, hipStream_t stream) {
    static int grid = 0;
    if (grid == 0) {
        if (n_in != 26 || in_sizes[0] != T * D || out_size != T * D || ws_size < WS_END) { fprintf(stderr, "kernel_launch: unexpected shapes: n_in %d in0 %d out %d ws %zu (need %zu); nothing launched\n", n_in, n_in > 0 ? in_sizes[0] : -1, out_size, ws_size, (size_t)WS_END); grid = -1; return; }
        int dev = 0, cus = 0, per_cu = 0;
        if (hipGetDevice(&dev) != hipSuccess || hipDeviceGetAttribute(&cus, hipDeviceAttributeMultiprocessorCount, dev) != hipSuccess) { grid = -1; return; }
        if (hipFuncSetAttribute((const void*)mk_fwd, hipFuncAttributeMaxDynamicSharedMemorySize, LDS_BYTES) != hipSuccess) { fprintf(stderr, "kernel_launch: hipFuncSetAttribute failed\n"); grid = -1; return; }
        if (hipOccupancyMaxActiveBlocksPerMultiprocessor(&per_cu, (const void*)mk_fwd, NWAVES * 64, LDS_BYTES) != hipSuccess || per_cu < 1) fprintf(stderr, "kernel_launch: occupancy query reports %d\n", per_cu);
        (void)hipGetLastError();
        grid = cus;
        if (grid != 256) fprintf(stderr, "kernel_launch: %d CUs (built for 256)\n", grid);
    }
    if (grid < 0) return;
    (void)hipMemsetAsync((char*)d_ws + WS_CTL, 0, CTL_ZERO_BYTES, stream);
    Args a{};
    for (int i = 0; i < 26; ++i) a.p.in[i] = (const float*)d_in[i];
    a.p.out = (float*)d_out; a.p.ws = (unsigned char*)d_ws;
    if (MK_N_LAUNCHES == 1) { a.ph_lo = 0; a.ph_hi = N_PHASES;
#ifdef WS_PROBE
        a.ph_hi = (int)(ws_size >> 20);
#endif
 hipLaunchKernelGGL(mk_fwd, dim3(grid), dim3(NWAVES * 64), LDS_BYTES, stream, a); }
    else {
        for (int k = 0; k < N_PHASES; ++k) {
            const int l = (k - 1) / 10, s = (k - 1) % 10;
            if (k > 0 && (l & 1) == 1 && (s == 2 || s == 3)) continue;
            a.ph_lo = k; a.ph_hi = k + 1; hipLaunchKernelGGL(mk_fwd, dim3(grid), dim3(NWAVES * 64), LDS_BYTES, stream, a);
        }
    }
}
```

```cpp
#include <hip/hip_runtime.h>
#include <cstdio>
#include <cstdint>

#ifdef P0_NT_STORE
#define P0_NTS(set) ((set) >= (2 - P0_NT_STORE))
#else
#define P0_NTS(set) false
#endif
#ifndef NO_STREAM_NT
#define ATT_NT_STORE 1
#define POST_NT 1
#endif
#ifndef P0_NO_NT
#define P0_NT 1
#endif

#ifndef ATT_PREFETCH
#define ATT_NOPF 1
#ifndef ATT_NO_PF_MID
#define ATT_PF_MID 1
#endif
#endif
#ifndef MK_N_LAUNCHES
#define MK_N_LAUNCHES 1
#endif

#ifndef REP_P0
#define REP_P0 1
#endif
#ifndef REP_A1
#define REP_A1 1
#endif
#ifndef REP_A2
#define REP_A2 1
#endif
#ifndef REP_A3
#define REP_A3 1
#endif
#ifndef REP_A4
#define REP_A4 1
#endif
#ifndef REP_B1
#define REP_B1 1
#endif
#ifndef REP_B2
#define REP_B2 1
#endif
#ifndef REP_X1
#define REP_X1 1
#endif
#ifndef REP_X2
#define REP_X2 1
#endif
#ifndef REP_X3
#define REP_X3 1
#endif
#ifndef REP_X4
#define REP_X4 1
#endif
#ifndef REP_M1
#define REP_M1 1
#endif
#ifndef REP_M2
#define REP_M2 1
#endif
#ifndef REP_BAR
#define REP_BAR 1
#endif
#ifndef REP_ATTN
#define REP_ATTN 1
#endif
#ifndef REP_R1
#define REP_R1 1
#endif
#ifndef REP_KVF
#define REP_KVF 1
#endif
#define REPEAT(n) for (int rep_ = 0; rep_ < (n); ++rep_)
#define REP_SEAM(n) do { if (rep_ + 1 < (n)) xcd_barrier(bar); } while (0)
template <int N> __device__ __forceinline__ float row_ror_(float x) { return __uint_as_float((unsigned)__builtin_amdgcn_update_dpp(0, (int)__float_as_uint(x), 0x120 + N, 0xf, 0xf, false)); }
__device__ __forceinline__ float rowsum16(float s) { s += row_ror_<8>(s); s += row_ror_<4>(s); s += row_ror_<2>(s); s += row_ror_<1>(s); return s; }
__device__ __forceinline__ void rows_up16_top(float x, int G, float& up, float& top) {
    const auto a = __builtin_amdgcn_permlane16_swap(__float_as_uint(x), __float_as_uint(x), false, false);
    const auto b = __builtin_amdgcn_permlane32_swap(a[1], a[1], false, false);
    up = __uint_as_float(G == 2 ? b[0] : a[0]); top = __uint_as_float(b[1]);
}
__device__ __forceinline__ float rows_up32(float x) {
    const auto a = __builtin_amdgcn_permlane32_swap(__float_as_uint(x), __float_as_uint(x), false, false);
    return __uint_as_float(a[0]);
}
__device__ __forceinline__ float xsum_16_32(float s) {
    const auto a = __builtin_amdgcn_permlane16_swap(__float_as_uint(s), __float_as_uint(s), false, false);
    s = __uint_as_float(a[0]) + __uint_as_float(a[1]);
    const auto b = __builtin_amdgcn_permlane32_swap(__float_as_uint(s), __float_as_uint(s), false, false);
    return __uint_as_float(b[0]) + __uint_as_float(b[1]);
}
namespace pg8 {
#define PG8_LAS __attribute__((address_space(3)))
typedef unsigned short bf16_t;
typedef short bf16x8 __attribute__((ext_vector_type(8)));
typedef float f32x4 __attribute__((ext_vector_type(4)));
typedef float f32x2 __attribute__((ext_vector_type(2)));
typedef unsigned u32x4 __attribute__((ext_vector_type(4)));
typedef unsigned u32x2 __attribute__((ext_vector_type(2)));
#ifdef PG8_COLS_SPLIT
constexpr int WCS = 32, BJS = 128;
#else
constexpr int WCS = 64, BJS = 32;
#endif
constexpr int BM = 256, BK = 64, HALF = 128, HTB = HALF * BK * 2, STAGE_BYTES = 8 * HTB, NXCD = 8, WGM = 8;

__host__ __device__ __forceinline__ int lds_byte(int r, int c) { const int st = (r >> 4) * 2 + (c >> 5), rr = r & 15, cc = c & 31, ob = rr * 64 + cc * 2; return st * 1024 + (ob ^ (((ob >> 9) & 1) << 5)); }
__host__ __device__ __forceinline__ void stage_rc(int b, int& R, int& C) { const int st = b / 1024, sb = b % 1024, swz = sb ^ (((sb >> 9) & 1) << 5); R = (st >> 1) * 16 + swz / 64; C = (st & 1) * 32 + (swz % 64) / 2; }
__host__ __device__ __forceinline__ int perm32(int rho) { const int n = rho >> 4, i = rho & 15; return 8 * (i >> 2) + 4 * n + (i & 3); }

struct Unit { int pm, pn; };
struct Gemm { const bf16_t* A; const bf16_t* Bt; int lda, ldb, K; int a_pm_mask, a_pn_cols; long b_pn_elems; int b_pm_shift; long b_batch_elems; long a_kstep = BK; long a_pm_elems = 0  ; };

struct StaticOrder {
    int nM, nN, nwg, G, c;
    __host__ __device__ __forceinline__ void init(int nM_, int nN_, int G_, int c_) { nM = nM_; nN = nN_; nwg = nM * nN; G = G_; c = c_; }
    __host__ __device__ __forceinline__ bool next(int i, Unit& u) const {
        const long L = (long)i * G + c; if (L >= nwg) return false;
        int wgid = (int)L; { const int q = nwg / NXCD, r = nwg % NXCD, xcd = wgid % NXCD, off = wgid / NXCD; wgid = (xcd < r ? xcd * (q + 1) : r * (q + 1) + (xcd - r) * q) + off; }
        const int nig = WGM * nN, gid = wgid / nig, fm = gid * WGM, gsz = (nM - fm) < WGM ? (nM - fm) : WGM;
        u.pm = fm + ((wgid % nig) % gsz); u.pn = (wgid % nig) / gsz; return true;
    }
};

struct XcdOrder {
    int nMx, nN, J, x, j;
    __host__ __device__ __forceinline__ void init(int nM, int nN_, int G, int c) { nMx = nM / 8; nN = nN_; J = G / 8; x = c & 7; j = c >> 3; }
    __host__ __device__ __forceinline__ bool next(int i, Unit& u) const {
#ifdef XCD_ORDER_KEEPROW
        if (nMx == 2 && J == 8 && (nN & 3) == 0) { if (4 * i >= nN) return false; u.pm = x * 2 + ((j >> 2) & 1); u.pn = (j & 3) + 4 * i; return true; }
#endif
        const int q = j + J * i; if (q >= nMx * nN) return false; u.pm = x * nMx + q / nN; u.pn = q % nN; return true; }
};

__device__ __forceinline__ unsigned cvt_pk_bf16(float lo, float hi) { unsigned r; asm("v_cvt_pk_bf16_f32 %0, %1, %2" : "=v"(r) : "v"(lo), "v"(hi)); return r; }

constexpr float EPS = 1e-6f;
constexpr int SS_ROWS = 4096;
__host__ __device__ __forceinline__ size_t ssi(int row, int slot) { return (size_t)slot * SS_ROWS + row; }
template <int MODE, bool SLAB = false> struct EpiBf16 {
    static constexpr bool PERM = true;
    bf16_t* O; int ldc; const float* aux_in; float* aux_out;
    mutable int cpm = -1; mutable float cf[8] = {0.f, 0.f, 0.f, 0.f, 0.f, 0.f, 0.f, 0.f};
    __device__ __forceinline__ void operator()(const f32x4 (&acc)[2][2][4][2], const Unit& u, int wr, int wc, int fr, int fq) const {
        const int row0 = u.pm * BM + wr * 64 + fr, col0 = u.pn * BM + wc * WCS + 8 * fq;
        if (((MODE == 1 || MODE == 2) && u.pm != cpm) || MODE == 3) {
            float v[8][4];
#pragma unroll
            for (int i = 0; i < 8; ++i)
#pragma unroll
                for (int k = 0; k < 4; ++k) v[i][k] = aux_in[ssi(row0 + (i >> 2) * HALF + (i & 3) * 16, fq * 4 + k)];
#pragma unroll
            for (int i = 0; i < 8; ++i) { float s = (v[i][0] + v[i][1]) + (v[i][2] + v[i][3]); s = xsum_16_32(s); cf[i] = __builtin_amdgcn_rsqf(s * (1.0f / 1024.0f) + EPS); }
            cpm = u.pm; }
#pragma unroll
        for (int ai = 0; ai < 2; ++ai)
#pragma unroll
            for (int m = 0; m < 4; ++m) {
                const int row = row0 + ai * HALF + m * 16; float f = 1.f;
                if (MODE == 1 || MODE == 2 || MODE == 3) f = cf[ai * 4 + m];
                if (MODE == 4) { const float v[4] = {aux_in[ssi(row, u.pn * 4)], aux_in[ssi(row, u.pn * 4 + 1)], aux_in[ssi(row, u.pn * 4 + 2)], aux_in[ssi(row, u.pn * 4 + 3)]}; const float s = (v[0] + v[1]) + (v[2] + v[3]); f = __builtin_amdgcn_rsqf(s * (1.0f / 256.0f) + EPS); }
                if (MODE == 5) { const float v[4] = {aux_in[ssi(row, u.pn * 4)], aux_in[ssi(row, u.pn * 4 + 1)], aux_in[ssi(row, u.pn * 4 + 2)], aux_in[ssi(row, u.pn * 4 + 3)]}; const float s = (v[0] + v[1]) + (v[2] + v[3]); f = 1.0f / s; }
                bf16_t* rowp = SLAB ? O + ((size_t)(u.pm * (ldc >> 6) + u.pn * 4 + wc) * 256 + (row & 255)) * 64 + 8 * fq : O + (size_t)row * ldc + col0; float part = 0.f;
#pragma unroll
                for (int bj = 0; bj < 2; ++bj) { f32x4 v0 = acc[ai][bj][m][0] * f, v1 = acc[ai][bj][m][1] * f;
                    if (MODE == 2) {
#pragma unroll
                        for (int e = 0; e < 4; ++e) { const float a = v0[e] > 0.f ? v0[e] : 0.f, b = v1[e] > 0.f ? v1[e] : 0.f; v0[e] = a * a; v1[e] = b * b; } }
                    if (MODE == 4) {
#pragma unroll
                        for (int e = 0; e < 4; ++e) { v0[e] = __builtin_amdgcn_exp2f(v0[e]); v1[e] = __builtin_amdgcn_exp2f(v1[e]); } }
                    if (MODE == 3) part += (v0[0] * v0[0] + v0[1] * v0[1]) + (v0[2] * v0[2] + v0[3] * v0[3]) + (v1[0] * v1[0] + v1[1] * v1[1]) + (v1[2] * v1[2] + v1[3] * v1[3]);
                    if (MODE == 4) part += (v0[0] + v0[1]) + (v0[2] + v0[3]) + (v1[0] + v1[1]) + (v1[2] + v1[3]);
                    u32x4 w; w.x = cvt_pk_bf16(v0[0], v0[1]); w.y = cvt_pk_bf16(v0[2], v0[3]); w.z = cvt_pk_bf16(v1[0], v1[1]); w.w = cvt_pk_bf16(v1[2], v1[3]);
                    *(u32x4*)(rowp + bj * BJS) = w; }
                if (MODE == 3 || MODE == 4) { part = xsum_16_32(part); if (fq == 0) aux_out[ssi(row, u.pn * 4 + wc)] = part; }
            }
    }
};
struct EpiRes {
    static constexpr bool PERM = true;
    float* out32; bf16_t* xb; float* ss; const float* scale; bf16_t* halo = nullptr;
    __device__ __forceinline__ void operator()(const f32x4 (&acc)[2][2][4][2], const Unit& u, int wr, int wc, int fr, int fq) const {
        const int row0 = u.pm * BM + wr * 64 + fr, col0 = u.pn * BM + wc * WCS + 8 * fq;
        u32x4 xwa[2][4][2];
#pragma unroll
        for (int ai = 0; ai < 2; ++ai)
#pragma unroll
            for (int m = 0; m < 4; ++m)
#pragma unroll
                for (int bj = 0; bj < 2; ++bj) xwa[ai][m][bj] = *(const u32x4*)(xb + (size_t)(row0 + ai * HALF + m * 16) * 1024 + col0 + bj * BJS);
#pragma unroll
        for (int ai = 0; ai < 2; ++ai) {
            const u32x4 (&xw)[4][2] = xwa[ai];
#pragma unroll
            for (int m = 0; m < 4; ++m) {
                const int row = row0 + ai * HALF + m * 16; const size_t off = (size_t)row * 1024 + col0; float sq = 0.f;
#pragma unroll
                for (int bj = 0; bj < 2; ++bj) { const int co = bj * BJS; f32x4 a0 = acc[ai][bj][m][0], a1 = acc[ai][bj][m][1];
                    if (scale) { a0 = a0 * *(const f32x4*)(scale + col0 + co); a1 = a1 * *(const f32x4*)(scale + col0 + co + 4); }
                    const u32x4 w = xw[m][bj];
                    f32x4 x0 = (f32x4){__uint_as_float(w.x << 16), __uint_as_float(w.x & 0xffff0000u), __uint_as_float(w.y << 16), __uint_as_float(w.y & 0xffff0000u)};
                    f32x4 x1 = (f32x4){__uint_as_float(w.z << 16), __uint_as_float(w.z & 0xffff0000u), __uint_as_float(w.w << 16), __uint_as_float(w.w & 0xffff0000u)};
                    x0 = x0 + a0; x1 = x1 + a1;
                    if (out32) { *(f32x4*)(out32 + off + co) = x0; *(f32x4*)(out32 + off + co + 4) = x1; }
                    else { sq += ((x0[0] * x0[0] + x0[1] * x0[1]) + (x0[2] * x0[2] + x0[3] * x0[3])) + ((x1[0] * x1[0] + x1[1] * x1[1]) + (x1[2] * x1[2] + x1[3] * x1[3]));
                           u32x4 o; o.x = cvt_pk_bf16(x0[0], x0[1]); o.y = cvt_pk_bf16(x0[2], x0[3]); o.z = cvt_pk_bf16(x1[0], x1[1]); o.w = cvt_pk_bf16(x1[2], x1[3]); *(u32x4*)(xb + off + co) = o;
                           if (ai == 1 && m == 3 && halo && wr == 1 && fr >= 1) *(u32x4*)(halo + ((size_t)u.pm * 15 + (fr - 1)) * 1024 + col0 + co) = o; } }
                if (!out32) { sq = xsum_16_32(sq); if (fq == 0) ss[pg8::ssi(row, u.pn * 4 + wc)] = sq; }
            }
            asm volatile("" ::: "memory");
        }
    }
};

template <class Epi, class Sched>
__device__ __forceinline__ void gemm_phase(PG8_LAS unsigned char* lds, const Gemm g, const Sched& S, const Epi& E) {
    int tid_ = threadIdx.x; asm volatile("" : "+v"(tid_));
    const int tid = tid_, wid = __builtin_amdgcn_readfirstlane(tid >> 6), lane = tid & 63, wr = wid >> 2, wc = wid & 3, fr = lane & 15, fq = lane >> 4;
    int K_ = g.K; asm volatile("" : "+s"(K_));
    const int K = K_, nt = K / BK;
    unsigned voffA[2], voffB[2];
#pragma unroll
    for (int i = 0; i < 2; ++i) { int R, C; stage_rc(tid * 16 + i * 8192, R, C); const int Rb = Epi::PERM ? ((R >> 5) * WCS + perm32(R & 31)) : R;
        voffA[i] = (unsigned)(R * g.lda + C) * 2u; voffB[i] = (unsigned)(Rb * g.ldb + C) * 2u; }
#ifdef PROBE_KSTEP0
    const size_t kstepA = (size_t)g.a_kstep * 2, kstep = (PROBE_KSTEP0 == 2 && g.a_kstep == 0) ? (size_t)0 : (size_t)(BK * 2);
#else
    const size_t kstep = (size_t)(BK * 2), kstepA = (size_t)g.a_kstep * 2;
#endif
    const size_t hstepA = (size_t)HALF * g.lda * 2, hstepB = (size_t)(Epi::PERM ? BJS : HALF) * g.ldb * 2;
    const unsigned ldsw = (unsigned)wid * 1024u;
    const int aoff = lds_byte(wr * 64 + fr, fq * 8), boff = lds_byte(wc * 32 + fr, fq * 8);
#define PG8_SA(b, h) (((b) * 2 + (h)) * HTB)
#define PG8_SB(b, h) ((4 + (b) * 2 + (h)) * HTB)
#define PG8_STAGE(bufoff, gbase, voff) do { _Pragma("unroll") for (int _i = 0; _i < 2; ++_i) \
        __builtin_amdgcn_global_load_lds((const unsigned*)((const char*)(gbase) + (voff)[_i]), (PG8_LAS unsigned*)(lds + (bufoff) + ldsw + _i * 8192), 16, 0, 0); } while (0)
#define PG8_LDA(dst, b, h) do { _Pragma("unroll") for (int m = 0; m < 4; ++m) _Pragma("unroll") for (int k = 0; k < 2; ++k) dst[m][k] = *(const PG8_LAS bf16x8*)(lds + PG8_SA(b, h) + aoff + m * 2048 + k * 1024); } while (0)
#define PG8_LDB(dst, b, h) do { _Pragma("unroll") for (int n = 0; n < 2; ++n) _Pragma("unroll") for (int k = 0; k < 2; ++k) dst[n][k] = *(const PG8_LAS bf16x8*)(lds + PG8_SB(b, h) + boff + n * 2048 + k * 1024); } while (0)
#ifdef PG8_NO_SETPRIO
#define PG8_SETPRIO(x)
#else
#ifndef PG8_PRIO_HI
#define PG8_PRIO_HI 1
#endif
#ifdef PG8_PRIO_STATIC
#define PG8_SETPRIO(x)
#elif defined(PG8_PRIO_INV)
#define PG8_SETPRIO(x) __builtin_amdgcn_s_setprio((x) ? 0 : 2)
#else
#define PG8_SETPRIO(x) __builtin_amdgcn_s_setprio((x) ? PG8_PRIO_HI : 0)
#endif
#endif
#define PG8_MMA(ai, bj, At, Bt) do { PG8_SETPRIO(1); _Pragma("unroll") for (int m = 0; m < 4; ++m) _Pragma("unroll") for (int n = 0; n < 2; ++n) _Pragma("unroll") for (int k = 0; k < 2; ++k) \
        acc[ai][bj][m][n] = __builtin_amdgcn_mfma_f32_16x16x32_bf16(Bt[n][k], At[m][k], acc[ai][bj][m][n], 0, 0, 0); PG8_SETPRIO(0); } while (0)
#define PG8_MMA_ST(ai, bj, At, Bt, so0, g0, so1, g1) do { PG8_SETPRIO(1); _Pragma("unroll") for (int m = 0; m < 4; ++m) { _Pragma("unroll") for (int n = 0; n < 2; ++n) _Pragma("unroll") for (int k = 0; k < 2; ++k) \
        acc[ai][bj][m][n] = __builtin_amdgcn_mfma_f32_16x16x32_bf16(Bt[n][k], At[m][k], acc[ai][bj][m][n], 0, 0, 0); \
        if (m == 0) { PG8_SCHED; PG8_STAGE(so0, g0, voffB); PG8_SCHED; } if (m == 2) { PG8_SCHED; PG8_STAGE(so1, g1, voffB); PG8_SCHED; } } PG8_SETPRIO(0); } while (0)
#define PG8_WAIT_V(n) asm volatile("s_waitcnt vmcnt(" #n ")" ::: "memory")
#define PG8_WAIT_L(n) asm volatile("s_waitcnt lgkmcnt(" #n ")" ::: "memory")
#define PG8_BAR __builtin_amdgcn_s_barrier()
#define PG8_SCHED __builtin_amdgcn_sched_barrier(0)
#define PG8_APTR(u) ((const char*)g.A + ((size_t)((u).pm & g.a_pm_mask) * (g.a_pm_elems ? (size_t)g.a_pm_elems : (size_t)256 * g.lda) + (size_t)(u).pn * g.a_pn_cols) * 2)
#define PG8_BPTR(u) ((const char*)g.Bt + ((size_t)(u).pn * g.b_pn_elems + (size_t)((u).pm >> g.b_pm_shift) * g.b_batch_elems) * 2)
    Unit cur, nxt; int ui = 0;
    if (!S.next(0, cur)) return;
#ifdef PG8_PRIO_STATIC
    if (wid >= 4) __builtin_amdgcn_s_setprio(1);
#endif
#ifdef CLK_ACC
    unsigned long long tp0_ = wall_clock64();
#endif
    f32x4 acc[2][2][4][2];
#pragma unroll
    for (int a = 0; a < 2; ++a)
#pragma unroll
        for (int b = 0; b < 2; ++b)
#pragma unroll
            for (int m = 0; m < 4; ++m)
#pragma unroll
                for (int n = 0; n < 2; ++n) acc[a][b][m][n] = (f32x4){0.f, 0.f, 0.f, 0.f};
    bf16x8 At[4][2], B0[2][2], B1[2][2];
    const char* cA = PG8_APTR(cur); const char* cB = PG8_BPTR(cur);
    PG8_STAGE(PG8_SB(0, 0), cB, voffB); PG8_STAGE(PG8_SB(0, 1), cB + hstepB, voffB); PG8_STAGE(PG8_SA(0, 0), cA, voffA); PG8_STAGE(PG8_SA(0, 1), cA + hstepA, voffA);
    PG8_STAGE(PG8_SB(1, 0), cB + kstep, voffB); PG8_STAGE(PG8_SA(1, 0), cA + kstepA, voffA); PG8_STAGE(PG8_SB(1, 1), cB + hstepB + kstep, voffB);
    if (wr == 1) PG8_BAR;
    PG8_WAIT_V(8); PG8_BAR;
    PG8_WAIT_V(6); PG8_BAR;
#ifdef CLK_ACC
    if (tid == 0) { PG8_LAS unsigned* mm = (PG8_LAS unsigned*)(lds + 131072 + 320) + 16; if (mm[14]) { mm[2] += (unsigned)(wall_clock64() - tp0_); mm[3] += 1u; } }
#endif
    for (;;) {
        const bool has_next = S.next(ui + 1, nxt);
        const char* nA = has_next ? PG8_APTR(nxt) : cA; const char* nB = has_next ? PG8_BPTR(nxt) : cB;
        for (int t = 0; t < nt; t += 2) {
            const bool last = (t == nt - 2);
            const char* a1 = cA + (size_t)(t + 1) * kstepA;
            const char* a2 = last ? nA : cA + (size_t)(t + 2) * kstepA; const char* b2 = last ? nB : cB + (size_t)(t + 2) * kstep;
            const char* a3 = a2 + kstepA; const char* b3 = b2 + kstep;
            const bool fin = last && !has_next;
            PG8_LDB(B0, 0, 0); PG8_LDB(B1, 0, 1); PG8_SCHED; PG8_LDA(At, 0, 0); PG8_STAGE(PG8_SA(1, 1), a1 + hstepA, voffA);
            PG8_WAIT_V(8); PG8_WAIT_L(0); PG8_BAR; PG8_MMA(0, 0, At, B0); PG8_MMA(0, 1, At, B1); PG8_BAR; PG8_SCHED;
            PG8_LDA(At, 0, 1);
            if (!fin) { PG8_STAGE(PG8_SB(0, 0), b2, voffB); PG8_STAGE(PG8_SB(0, 1), b2 + hstepB, voffB); PG8_STAGE(PG8_SA(0, 0), a2, voffA); PG8_WAIT_V(8); } else { PG8_WAIT_V(2); }
            PG8_WAIT_L(0); PG8_BAR; PG8_MMA(1, 0, At, B0); PG8_MMA(1, 1, At, B1); PG8_BAR; PG8_SCHED;
            PG8_LDB(B0, 1, 0); PG8_LDB(B1, 1, 1); PG8_SCHED; PG8_LDA(At, 1, 0);
            if (!fin) { PG8_STAGE(PG8_SA(0, 1), a2 + hstepA, voffA); PG8_WAIT_V(8); } else { PG8_WAIT_V(0); }
            PG8_WAIT_L(0); PG8_BAR; PG8_MMA(0, 0, At, B0); PG8_MMA(0, 1, At, B1); PG8_BAR; PG8_SCHED;
            PG8_LDA(At, 1, 1);
            if (!fin) { PG8_STAGE(PG8_SB(1, 0), b3, voffB); PG8_STAGE(PG8_SB(1, 1), b3 + hstepB, voffB); PG8_STAGE(PG8_SA(1, 0), a3, voffA); PG8_WAIT_V(8); }
            PG8_WAIT_L(0); PG8_BAR; PG8_MMA(1, 0, At, B0); PG8_MMA(1, 1, At, B1); PG8_BAR; PG8_SCHED;
        }
        if (wr == 0) PG8_BAR;
#ifdef CLK_ACC
        unsigned long long te0_ = wall_clock64();
#endif
        E(acc, cur, wr, wc, fr, fq);
#ifdef CLK_ACC
        asm volatile("s_waitcnt vmcnt(0)" ::: "memory"); if (tid == 0) { PG8_LAS unsigned* mm = (PG8_LAS unsigned*)(lds + 131072 + 320) + 16; if (mm[14]) { mm[0] += (unsigned)(wall_clock64() - te0_); mm[1] += 1u; } }
#endif
        if (!has_next) break;
#pragma unroll
        for (int a = 0; a < 2; ++a)
#pragma unroll
            for (int b = 0; b < 2; ++b)
#pragma unroll
                for (int m = 0; m < 4; ++m)
#pragma unroll
                    for (int n = 0; n < 2; ++n) acc[a][b][m][n] = (f32x4){0.f, 0.f, 0.f, 0.f};
        cur = nxt; cA = nA; cB = nB; ++ui;
        if (wr == 1) PG8_BAR;
    }
    PG8_WAIT_V(0);
    PG8_BAR;
#ifdef PG8_PRIO_STATIC
    __builtin_amdgcn_s_setprio(0);
#endif
#ifdef CLK_ACC
    if (tid == 0) { PG8_LAS unsigned* mm = (PG8_LAS unsigned*)(lds + 131072 + 320) + 16; if (mm[14]) mm[4] += (unsigned)(wall_clock64() - tp0_); }
#endif
#undef PG8_SA
#undef PG8_SB
#undef PG8_STAGE
#undef PG8_LDA
#undef PG8_LDB
#undef PG8_MMA
#undef PG8_MMA_ST
#undef PG8_WAIT_V
#undef PG8_WAIT_L
#undef PG8_BAR
#undef PG8_SCHED
#undef PG8_APTR
#undef PG8_BPTR
}
}

constexpr int NWAVES = 8;
constexpr int D = 1024, BATCH = 4, SEQ = 4096, T = BATCH * SEQ, NMEM = 256, TM = BATCH * NMEM, FF = 4096, INC = 2560;
constexpr float EPS = 1e-6f;
constexpr float LOG2E = 1.4426950408889634f;
constexpr int NUM_GS = SEQ;

constexpr size_t MiB = 1u << 20;
constexpr size_t WS_CTL = 0, CTL_ZERO_BYTES = 128 * 1024;
constexpr size_t WS_SS = 1 * MiB, WS_QSS = 2 * MiB, WS_LSUM = 3 * MiB, WS_DEN = 4 * MiB, WS_AEND = 5 * MiB, WS_HEND = 5 * MiB + 256 * 1024;
constexpr size_t WS_GT = 6 * MiB, WS_POOLT = 7 * MiB;
constexpr size_t WS_WIN = 8 * MiB, WS_WOUT = 18 * MiB, WS_WQ = 22 * MiB, WS_WO = 30 * MiB, WS_W1 = 38 * MiB, WS_W2 = 70 * MiB, WS_WKV = 102 * MiB;
constexpr size_t WS_KN = 102 * MiB, WS_VT = 110 * MiB;
constexpr size_t WS_XB = 118 * MiB;
constexpr size_t WS_HID = 150 * MiB, WS_PROJ = 150 * MiB, WS_NUM = 230 * MiB, WS_AOUT = 150 * MiB, WS_Q = 182 * MiB, WS_P = 214 * MiB, WS_O = 246 * MiB;
constexpr size_t WS_END = 278 * MiB;
constexpr size_t DO_PIPE = 16 * MiB, DO_Y0 = 0, DO_Y1 = 4 * MiB, DO_KVRAW = 8 * MiB, DO_KN = 12 * MiB, DO_VT = 14 * MiB, DO_MEMN = 0;

constexpr int RING_BYTES = 131072, LDSCTL_OFF = RING_BYTES, MISC_OFF = LDSCTL_OFF + 320, LDS_BYTES = 147456;

#define GAS __attribute__((address_space(1)))
#define LAS __attribute__((address_space(3)))
typedef unsigned short bf16;
typedef unsigned v4u __attribute__((ext_vector_type(4)));
typedef unsigned v2u __attribute__((ext_vector_type(2)));
typedef float f32x4 __attribute__((ext_vector_type(4)));
typedef short bf16x8 __attribute__((ext_vector_type(8)));
typedef short s16x4 __attribute__((ext_vector_type(4)));
#define LDS_WAIT() asm volatile("s_waitcnt lgkmcnt(0)" ::: "memory")
#define VM_WAIT() asm volatile("s_waitcnt vmcnt(0)" ::: "memory")
__device__ __forceinline__ unsigned pk2(float lo, float hi) { return pg8::cvt_pk_bf16(lo, hi); }
__device__ __forceinline__ float bflo(unsigned w) { return __uint_as_float(w << 16); }
__device__ __forceinline__ float bfhi(unsigned w) { return __uint_as_float(w & 0xffff0000u); }
__device__ __forceinline__ float bf1(bf16 h) { return __uint_as_float((unsigned)h << 16); }
__device__ __forceinline__ bf16 f2bf(float f) { return (bf16)(pg8::cvt_pk_bf16(f, 0.f) & 0xffffu); }

#define XB_TMO      128
#define XB_XCNT(j)  (256  + 64 * (j))
#define XB_XSUB(j)  (1280 + 64 * (j))
#define XB_XGEN(j)  (2304 + 64 * (j))
#define XB_TOP      3328
#define XB_TOPGEN   3392
#define XCD_BAR_WORDS 3456
#define XB_SPIN_CAP (1u << 22)
__device__ __forceinline__ unsigned xb_ld(unsigned* p)              { return __hip_atomic_load(p, __ATOMIC_RELAXED, __HIP_MEMORY_SCOPE_AGENT); }
__device__ __forceinline__ unsigned xb_add(unsigned* p, unsigned v) { return __hip_atomic_fetch_add(p, v, __ATOMIC_RELAXED, __HIP_MEMORY_SCOPE_AGENT); }
__device__ __forceinline__ unsigned xb_xcc_id() { return (unsigned)__builtin_amdgcn_s_getreg((3 << 11) | 20) & 0xFu; }
#define XB_SPIN(cond, bar) do { unsigned _sp = 0; while (cond) { __builtin_amdgcn_s_sleep(1); \
    if ((++_sp & 255u) == 0u) { if (xb_ld(&(bar)[XB_TMO])) break; if (_sp > XB_SPIN_CAP) { atomicAdd(&(bar)[XB_TMO], 1u); break; } } } } while (0)
struct XcdBarrier { unsigned* bar; unsigned x; volatile LAS unsigned* st; unsigned G; };
__device__ __forceinline__ XcdBarrier xcd_barrier_post(unsigned* bar, volatile LAS unsigned* st, unsigned G) {
    XcdBarrier b; b.bar = bar; b.x = xb_xcc_id(); b.st = st; b.G = G;
    if (threadIdx.x == 0) (void)xb_add(&bar[XB_XCNT(b.x)], 1u);
    return b;
}
__device__ __forceinline__ void xcd_barrier_complete(unsigned* bar, unsigned x, unsigned G, unsigned& nloc, unsigned& nx) {
    unsigned sum, cnt, mine, sp = 0u;
    for (;;) {
        sum = 0u; cnt = 0u; mine = 0u;
#pragma unroll
        for (unsigned j = 0; j < 16; ++j) { const unsigned c = xb_ld(&bar[XB_XCNT(j)]); sum += c; cnt += (c > 0u) ? 1u : 0u; mine = (j == x) ? c : mine; }
        if (sum == G) break;
        __builtin_amdgcn_s_sleep(1);
        if ((++sp & 255u) == 0u) { if (xb_ld(&bar[XB_TMO])) break; if (sp > XB_SPIN_CAP) { atomicAdd(&bar[XB_TMO], 1u); break; } }
    }
    nloc = mine > 0u ? mine : 1u; nx = cnt > 0u ? cnt : 1u;
}
__device__ __forceinline__ void xcd_barrier_discover(const XcdBarrier& b) {
    if (threadIdx.x == 0) { unsigned nloc, nx; xcd_barrier_complete(b.bar, b.x, b.G, nloc, nx); b.st[0] = nloc; b.st[1] = nx; }
}
__device__ __forceinline__ void xcd_barrier(const XcdBarrier& b) {
    asm volatile("s_waitcnt vmcnt(0)" ::: "memory");
    __syncthreads();
    if (threadIdx.x == 0) {
#ifdef CLK_ACC
        const unsigned long long tb0_ = wall_clock64();
#endif
        unsigned* bar = b.bar;
        __builtin_amdgcn_s_waitcnt(0);
        const unsigned nloc = b.st[0], nx = b.st[1];
        const unsigned old = xb_add(&bar[XB_XSUB(b.x)], 1u);
        const unsigned gen = old / nloc;
        if (old + 1u == (gen + 1u) * nloc) {
            __builtin_amdgcn_fence(__ATOMIC_RELEASE, "agent");
            asm volatile("s_waitcnt vmcnt(0)" ::: "memory");
            const unsigned og = xb_add(&bar[XB_TOP], 1u);
            const unsigned tg = og / nx;
            if (og + 1u == (tg + 1u) * nx) xb_add(&bar[XB_TOPGEN], 1u);
            else XB_SPIN(xb_ld(&bar[XB_TOPGEN]) == tg, bar);
            (void)xb_add(&bar[XB_XGEN(b.x)], 1u);
            __builtin_amdgcn_fence(__ATOMIC_ACQUIRE, "agent");
            asm volatile("s_waitcnt vmcnt(0)" ::: "memory");
        } else {
            XB_SPIN(xb_ld(&bar[XB_XGEN(b.x)]) == gen, bar);
            __builtin_amdgcn_fence(__ATOMIC_ACQUIRE, "agent");
            asm volatile("s_waitcnt vmcnt(0)" ::: "memory");
        }
#ifdef CLK_ACC
        b.st[8 + 5 - (b.G == 64 ? 2 : 0)] += (unsigned)(wall_clock64() - tb0_);
#endif
    }
    __syncthreads();
}

__device__ __forceinline__ float wave_sum(float v) { return xsum_16_32(rowsum16(v)); }

struct P0Item { const float* W; bf16* WT; const float* gain; int K, N, item; };
__device__ __forceinline__ void p0_load(const P0Item& I, float (&v)[32], int lane) {
    const int nblk = I.N / 32, kb = I.item / nblk, nb = I.item % nblk, k0 = 64 * kb, n0 = 32 * nb;
#pragma unroll
    for (int i = 0; i < 32; ++i) { const int kk = 2 * i + (lane >> 5);
#ifdef P0_NT
        v[i] = __builtin_nontemporal_load(I.W + (size_t)(k0 + kk) * I.N + n0 + (lane & 31));
#else
        v[i] = I.W[(size_t)(k0 + kk) * I.N + n0 + (lane & 31)];
#endif
    }
}
template <bool NTS = false> __device__ __forceinline__ void p0_finish(const P0Item& I, const float (&v)[32], LAS float* scr, int lane) {
    const int nblk = I.N / 32, kb = I.item / nblk, nb = I.item % nblk, k0 = 64 * kb, n0 = 32 * nb;
    const int c = lane & 7;
    f32x4 g0 = (f32x4){1.f, 1.f, 1.f, 1.f}, g1 = g0;
    if (I.gain) { g0 = *(const GAS f32x4*)(I.gain + k0 + 8 * c); g1 = *(const GAS f32x4*)(I.gain + k0 + 8 * c + 4); }
#pragma unroll
    for (int i = 0; i < 32; ++i) { const int kk = 2 * i + (lane >> 5); scr[kk * 33 + (lane & 31)] = v[i]; }
    LDS_WAIT(); asm volatile("" ::: "memory");
#pragma unroll
    for (int j = 0; j < 4; ++j) { const int n = (lane >> 3) + 8 * j; const LAS float* s = scr + (8 * c) * 33 + n;
        v4u o; o.x = pk2(s[0 * 33] * g0[0], s[1 * 33] * g0[1]); o.y = pk2(s[2 * 33] * g0[2], s[3 * 33] * g0[3]); o.z = pk2(s[4 * 33] * g1[0], s[5 * 33] * g1[1]); o.w = pk2(s[6 * 33] * g1[2], s[7 * 33] * g1[3]);
        if (NTS) __builtin_nontemporal_store(o, (GAS v4u*)(I.WT + (size_t)(n0 + n) * I.K + k0 + 8 * c)); else *(GAS v4u*)(I.WT + (size_t)(n0 + n) * I.K + k0 + 8 * c) = o; }
    LDS_WAIT(); asm volatile("" ::: "memory");
}

struct Ptrs {
    const float* in[26]; float* out; unsigned char* ws;
};

struct Args { Ptrs p; int ph_lo, ph_hi; };
__device__ __forceinline__ const float* ld_in(const Args& a, int i) { asm volatile("" : "+s"(i)); return a.p.in[i]; }
__device__ __forceinline__ float* ld_out(const Args& a) { int i = 0; asm volatile("" : "+s"(i)); return (&a.p.out)[i]; }
__device__ __forceinline__ unsigned char* ld_ws(const Args& a) { int i = 0; asm volatile("" : "+s"(i)); return (&a.p.ws)[i]; }
#define INP(i) ld_in(args, (i))
#define OUTP() ld_out(args)
constexpr int P0_I_WIN = 16 * 80, P0_I_SQ = 16 * 32, P0_I_G = 2 * 4, P0_I_POOL = 4 * 8, P0_I_KV = 16 * 64, P0_I_W1 = 16 * 128, P0_I_W2 = 64 * 32;
constexpr int P0_NA = P0_I_W1 + P0_I_W2 + 4 * P0_I_KV + P0_I_WIN + 3 * P0_I_SQ + 8 * P0_I_G;
constexpr int P0_NB = 3 * P0_I_W1 + 3 * P0_I_W2 + P0_I_WIN + P0_I_SQ + 6 * P0_I_SQ + 8 * P0_I_POOL + 8 * P0_I_G;
static_assert(P0_NA == 11072 && P0_NB == 17472 && P0_NB % 6 == 0, "item counts");
template <int SET> __device__ __forceinline__ P0Item p0_decode(const Args& args, unsigned char* ws, int it) {
    constexpr int l0 = SET ? 1 : 0, nl = SET ? 3 : 1, e0 = SET ? 1 : 0;
    P0Item I; int r = it;
    if (r < nl * P0_I_W1) { const int l = l0 + r / P0_I_W1; I = P0Item{INP(24) + (size_t)l * D * FF, (bf16*)(ws + WS_W1) + (size_t)l * FF * D, INP(5) + l * D, D, FF, r % P0_I_W1}; return I; } r -= nl * P0_I_W1;
    if (r < nl * P0_I_W2) { const int l = l0 + r / P0_I_W2; I = P0Item{INP(25) + (size_t)l * FF * D, (bf16*)(ws + WS_W2) + (size_t)l * D * FF, nullptr, FF, D, r % P0_I_W2}; return I; } r -= nl * P0_I_W2;
    if (!SET) { if (r < 4 * P0_I_KV) { const int l = r / P0_I_KV; I = P0Item{INP(20) + (size_t)l * D * 2048, (bf16*)(ws + WS_WKV) + (size_t)l * 2048 * D, nullptr, D, 2048, r % P0_I_KV}; return I; } r -= 4 * P0_I_KV; }
    if (r < P0_I_WIN) { I = P0Item{INP(6) + (size_t)e0 * D * INC, (bf16*)(ws + WS_WIN) + (size_t)e0 * INC * D, INP(3) + (2 * e0) * D, D, INC, r}; return I; } r -= P0_I_WIN;
    if (r < P0_I_SQ) { I = P0Item{INP(16) + (size_t)e0 * D * D, (bf16*)(ws + WS_WOUT) + (size_t)e0 * D * D, nullptr, D, D, r}; return I; } r -= P0_I_SQ;
    if (r < nl * P0_I_SQ) { const int l = l0 + r / P0_I_SQ; I = P0Item{INP(19) + (size_t)l * D * D, (bf16*)(ws + WS_WQ) + (size_t)l * D * D, INP(4) + l * D, D, D, r % P0_I_SQ}; return I; } r -= nl * P0_I_SQ;
    if (r < nl * P0_I_SQ) { const int l = l0 + r / P0_I_SQ; I = P0Item{INP(23) + (size_t)l * D * D, (bf16*)(ws + WS_WO) + (size_t)l * D * D, nullptr, D, D, r % P0_I_SQ}; return I; } r -= nl * P0_I_SQ;
    if (SET) { if (r < 8 * P0_I_POOL) { const int mat = r / P0_I_POOL, o = mat >> 2, g = mat & 3; I = P0Item{INP(17) + (size_t)mat * 65536, (bf16*)(ws + WS_POOLT) + (size_t)mat * 65536, INP(3) + (2 * o + 1) * D + g * 256, 256, 256, r % P0_I_POOL}; return I; } r -= 8 * P0_I_POOL; }
    { const int mat = r / P0_I_G, kind = mat >> 2, g = mat & 3, eg = e0 * 4 + g;
      I = P0Item{(kind ? INP(13) : INP(11)) + (size_t)eg * 16384, (bf16*)(ws + WS_GT) + (size_t)((e0 * 2 + kind) * 4 + g) * 16384, nullptr, 128, 128, r % P0_I_G}; }
    return I;
}
template <int SET> __device__ __forceinline__ void p0_items(const Args& args, LAS unsigned char* lds, int first, int last, int w, int NW, int wave) {
    int tid_ = threadIdx.x; asm volatile("" : "+v"(tid_)); const int lane = tid_ & 63;
    LAS float* scr = (LAS float*)(lds + wave * 16384);
    unsigned char* ws = ld_ws(args);
#if P0_INFLIGHT == 4
    for (int it = first + w; it < last; it += 4 * NW) {
        float va[32], vb[32], vc[32], vd[32];
        const bool hb = (it + NW < last), hc = (it + 2 * NW < last), hd = (it + 3 * NW < last);
        const P0Item A = p0_decode<SET>(args, ws, it); p0_load(A, va, lane);
        P0Item B = A, C = A, Dd = A;
        if (hb) { B = p0_decode<SET>(args, ws, it + NW); p0_load(B, vb, lane); }
        if (hc) { C = p0_decode<SET>(args, ws, it + 2 * NW); p0_load(C, vc, lane); }
        if (hd) { Dd = p0_decode<SET>(args, ws, it + 3 * NW); p0_load(Dd, vd, lane); }
        p0_finish<P0_NTS(SET)>(A, va, scr, lane);
        if (hb) p0_finish<P0_NTS(SET)>(B, vb, scr, lane);
        if (hc) p0_finish<P0_NTS(SET)>(C, vc, scr, lane);
        if (hd) p0_finish<P0_NTS(SET)>(Dd, vd, scr, lane);
    }
#else
    for (int it = first + w; it < last; it += 2 * NW) {
        float va[32], vb[32];
        const P0Item A = p0_decode<SET>(args, ws, it); p0_load(A, va, lane);
        const bool two = (it + NW < last);
        P0Item B = A; if (two) { B = p0_decode<SET>(args, ws, it + NW); p0_load(B, vb, lane); }
        p0_finish<P0_NTS(SET)>(A, va, scr, lane);
        if (two) p0_finish<P0_NTS(SET)>(B, vb, scr, lane);
    }
#endif
}
__device__ __forceinline__ void p0_prologue(const Args& args, LAS unsigned char* lds, int gw, int NGW, int wave) {
    int tid_ = threadIdx.x; asm volatile("" : "+v"(tid_)); const int lane = tid_ & 63;
    unsigned char* ws = ld_ws(args);
    p0_items<0>(args, lds, 0, P0_NA, gw, NGW, wave);
    if (MK_N_LAUNCHES != 1) p0_items<1>(args, lds, 0, P0_NB, gw, NGW, wave);
    for (int m = gw; m < T; m += 2 * NGW) {
        f32x4 v[2][4];
#pragma unroll
        for (int r = 0; r < 2; ++r) { const GAS f32x4* xr = (const GAS f32x4*)(INP(0) + (size_t)(m + r * NGW) * D) + lane;
#pragma unroll
            for (int j = 0; j < 4; ++j) {
#ifdef P0_NT
                v[r][j] = __builtin_nontemporal_load((const f32x4*)(INP(0) + (size_t)(m + r * NGW) * D) + lane + 64 * j);
#else
                v[r][j] = xr[64 * j];
#endif
            } }
#pragma unroll
        for (int r = 0; r < 2; ++r) { const int mm = m + r * NGW; float s = 0.f;
#pragma unroll
            for (int j = 0; j < 4; ++j) s += (v[r][j][0] * v[r][j][0] + v[r][j][1] * v[r][j][1]) + (v[r][j][2] * v[r][j][2] + v[r][j][3] * v[r][j][3]);
            s = wave_sum(s);
            GAS v2u* o8 = (GAS v2u*)((bf16*)(ws + WS_XB) + (size_t)mm * D) + lane;
#pragma unroll
            for (int j = 0; j < 4; ++j) { v2u w; w.x = pk2(v[r][j][0], v[r][j][1]); w.y = pk2(v[r][j][2], v[r][j][3]); o8[64 * j] = w; }
            if (lane == 0) ((float*)(ws + WS_SS))[(size_t)(mm >> 12) * 65536 + pg8::ssi(mm & 4095, 0)] = s; }
    }
    for (int i = gw * 64 + lane; i < 4 * 15 * 1024; i += NGW * 64) { const int pl = i / (15 * 1024), o = i % (15 * 1024);
        *(GAS f32x4*)((float*)(ws + WS_SS) + (size_t)pl * 65536 + 4096 + (size_t)o * 4) = (f32x4){0.f, 0.f, 0.f, 0.f}; }
    for (int m = gw; m < TM; m += NGW) {
        const GAS f32x4* xr = (const GAS f32x4*)(INP(1) + (size_t)m * D) + lane; const GAS f32x4* gr = (const GAS f32x4*)(INP(2)) + lane; f32x4 v[4]; float s = 0.f;
#pragma unroll
        for (int j = 0; j < 4; ++j) { v[j] = xr[64 * j]; s += (v[j][0] * v[j][0] + v[j][1] * v[j][1]) + (v[j][2] * v[j][2] + v[j][3] * v[j][3]); }
        const float rs = 1.0f / sqrtf(wave_sum(s) * (1.0f / D) + EPS);
        GAS v2u* o8 = (GAS v2u*)((bf16*)((unsigned char*)OUTP() + (size_t)(m >> 8) * DO_PIPE + DO_MEMN) + (size_t)(m & 255) * D) + lane;
#pragma unroll
        for (int j = 0; j < 4; ++j) { const f32x4 gg = gr[64 * j]; v2u w; w.x = pk2(v[j][0] * rs * gg[0], v[j][1] * rs * gg[1]); w.y = pk2(v[j][2] * rs * gg[2], v[j][3] * rs * gg[3]); o8[64 * j] = w; }
    }
}

__device__ __forceinline__ void kv_finalize(const Args& args, const bf16* __restrict__ kvraw  , bf16* __restrict__ Kn  , bf16* __restrict__ Vt, int gw, int NGW) {
    int tid_ = threadIdx.x; asm volatile("" : "+v"(tid_)); const int lane = tid_ & 63;
    for (int row0 = gw; row0 < 4 * 256 * 4; row0 += 4 * NGW) {
        v2u w[4];
#pragma unroll
        for (int r = 0; r < 4; ++r) { const int row = row0 + r * NGW, l = row >> 10, m = (row >> 2) & 255, h = row & 3;
            w[r] = *(const GAS v2u*)(kvraw + ((size_t)(l * 256 + m)) * 2048 + h * 256 + 4 * lane); }
#pragma unroll
        for (int r = 0; r < 4; ++r) { const int row = row0 + r * NGW, l = row >> 10, m = (row >> 2) & 255, h = row & 3;
            const float k0 = bflo(w[r].x), k1 = bfhi(w[r].x), k2 = bflo(w[r].y), k3 = bfhi(w[r].y);
            const float ss = wave_sum((k0 * k0 + k1 * k1) + (k2 * k2 + k3 * k3));
            const float sc = (1.0f / sqrtf(ss * (1.0f / 256.0f) + EPS)) * (0.0625f * LOG2E);
            const f32x4 gk = *(const GAS f32x4*)(INP(22) + l * 256 + 4 * lane), gq = *(const GAS f32x4*)(INP(21) + l * 256 + 4 * lane);
            v2u o; o.x = pk2(k0 * sc * gk[0] * gq[0], k1 * sc * gk[1] * gq[1]); o.y = pk2(k2 * sc * gk[2] * gq[2], k3 * sc * gk[3] * gq[3]);
            *(GAS v2u*)(Kn + ((size_t)(l * 4 + h) * 256 + m) * 256 + 4 * lane) = o; }
    }
    for (int it0 = gw; it0 < 2048; it0 += 4 * NGW) {
        v4u w[4];
#pragma unroll
        for (int r = 0; r < 4; ++r) { const int it = it0 + r * NGW, l = it >> 9, h = (it >> 7) & 3, kb = (it >> 5) & 3, dc = it & 31, key = 64 * kb + lane;
            w[r] = *(const GAS v4u*)(kvraw + ((size_t)(l * 256 + key)) * 2048 + 1024 + h * 256 + 8 * dc); }
#pragma unroll
        for (int r = 0; r < 4; ++r) { const int it = it0 + r * NGW, l = it >> 9, h = (it >> 7) & 3, kb = (it >> 5) & 3, dc = it & 31, key = 64 * kb + lane;
            bf16* dst = Vt + ((size_t)(l * 4 + h) * 256 + 8 * dc) * 256 + key;
            dst[0 * 256] = (bf16)(w[r].x & 0xffffu); dst[1 * 256] = (bf16)(w[r].x >> 16); dst[2 * 256] = (bf16)(w[r].y & 0xffffu); dst[3 * 256] = (bf16)(w[r].y >> 16);
            dst[4 * 256] = (bf16)(w[r].z & 0xffffu); dst[5 * 256] = (bf16)(w[r].z >> 16); dst[6 * 256] = (bf16)(w[r].w & 0xffffu); dst[7 * 256] = (bf16)(w[r].w >> 16); }
    }
}

struct AttnPre { v4u kk[4], vv[4], qq[4]; };
__device__ __forceinline__ void attn_load(AttnPre& R, const bf16* proj, size_t rowb, int h, int base, int d, int tid, bool valid) {
    const int c = tid & 15, w = tid >> 6, lane = tid & 63, q = lane & 15, G = lane >> 4;
    const int bs = valid ? base : 0;
#pragma unroll
    for (int i = 0; i < 4; ++i) { const int kr = (tid >> 4) + 32 * i;
        const bf16* p = proj + (rowb + bs + (size_t)kr * d) * INC + 512 + h * 128 + 8 * c; R.kk[i] = *(const GAS v4u*)p; R.vv[i] = *(const GAS v4u*)(p + 512);
        if (!valid) { R.kk[i] = (v4u){0u, 0u, 0u, 0u}; R.vv[i] = (v4u){0u, 0u, 0u, 0u}; } }
    {
        const size_t qrow = rowb + bs + (size_t)(16 * w + q) * d;
#pragma unroll
        for (int ks = 0; ks < 4; ++ks) R.qq[ks] = *(const GAS v4u*)(proj + qrow * INC + h * 128 + 32 * ks + 8 * G); }
}
__device__ __forceinline__ void attn_store_kv(const AttnPre& R, LAS unsigned char* lds, int slot, const f32x4 ga, const f32x4 gb, int tid) {
    const int c = tid & 15;
#pragma unroll
    for (int i = 0; i < 4; ++i) { const int kr = (tid >> 4) + 32 * i, lr = slot * 128 + kr;
        const float a0 = bflo(R.kk[i].x), a1 = bfhi(R.kk[i].x), a2 = bflo(R.kk[i].y), a3 = bfhi(R.kk[i].y), a4 = bflo(R.kk[i].z), a5 = bfhi(R.kk[i].z), a6 = bflo(R.kk[i].w), a7 = bfhi(R.kk[i].w);
        float ss = ((a0 * a0 + a1 * a1) + (a2 * a2 + a3 * a3)) + ((a4 * a4 + a5 * a5) + (a6 * a6 + a7 * a7));
        ss = rowsum16(ss);
        const float rk = __builtin_amdgcn_rsqf(ss * (1.0f / 128.0f) + EPS);
        v4u o; o.x = pk2(a0 * rk * ga[0], a1 * rk * ga[1]); o.y = pk2(a2 * rk * ga[2], a3 * rk * ga[3]); o.z = pk2(a4 * rk * gb[0], a5 * rk * gb[1]); o.w = pk2(a6 * rk * gb[2], a7 * rk * gb[3]);
        *(LAS v4u*)(lds + lr * 256 + ((c ^ (lr & 15)) << 4)) = o;
        *(LAS v4u*)(lds + 65536 + lr * 256 + ((c ^ ((((lr & 7) >> 1) << 2) | (lr & 1))) << 4)) = R.vv[i]; }
}
__device__ __forceinline__ void attn_segment(LAS unsigned char* lds, const bf16* proj, const float* gq, const float* gk, bf16* num, float* den, int g, int bh, int r, int n0, int L, int tid) {
    asm volatile("" : "+v"(tid));
    const int dsh = 2 * g, d = 1 << dsh, b = bh >> 2, h = bh & 3, wlen = 128 << dsh;
    const size_t rowb = (size_t)b * SEQ;
    const int w = tid >> 6, lane = tid & 63, q = lane & 15, G = lane >> 4;
    const f32x4 gka = *(const GAS f32x4*)(gk + 8 * (tid & 15)), gkb = *(const GAS f32x4*)(gk + 8 * (tid & 15) + 4);
    f32x4 gqa[4], gqb[4];
#pragma unroll
    for (int ks = 0; ks < 4; ++ks) { gqa[ks] = *(const GAS f32x4*)(gq + 32 * ks + 8 * G); gqb[ks] = *(const GAS f32x4*)(gq + 32 * ks + 8 * G + 4); }
    AttnPre R;
    { AttnPre R0;
      attn_load(R0, proj, rowb, h, (n0 - 1) * wlen + r, d, tid, n0 > 0);
      attn_load(R, proj, rowb, h, n0 * wlen + r, d, tid, true);
      attn_store_kv(R0, lds, (n0 - 1) & 1, gka, gkb, tid); }
    attn_store_kv(R, lds, n0 & 1, gka, gkb, tid);
    for (int n = n0; n < n0 + L; ++n) {
        const int base = n * wlen + r;
        const size_t qrow = rowb + base + (size_t)(16 * w + q) * d;
        bf16x8 Qf[4];
        {
            float ss = 0.f;
#pragma unroll
            for (int ks = 0; ks < 4; ++ks) { const float a0 = bflo(R.qq[ks].x), a1 = bfhi(R.qq[ks].x), a2 = bflo(R.qq[ks].y), a3 = bfhi(R.qq[ks].y), a4 = bflo(R.qq[ks].z), a5 = bfhi(R.qq[ks].z), a6 = bflo(R.qq[ks].w), a7 = bfhi(R.qq[ks].w);
                ss += ((a0 * a0 + a1 * a1) + (a2 * a2 + a3 * a3)) + ((a4 * a4 + a5 * a5) + (a6 * a6 + a7 * a7)); }
            ss = xsum_16_32(ss);
            const float rq = __builtin_amdgcn_rsqf(ss * (1.0f / 128.0f) + EPS) * (0.08838834764831845f * LOG2E);
#pragma unroll
            for (int ks = 0; ks < 4; ++ks) { const f32x4 ga = gqa[ks], gb = gqb[ks];
                v4u o; o.x = pk2(bflo(R.qq[ks].x) * rq * ga[0], bfhi(R.qq[ks].x) * rq * ga[1]); o.y = pk2(bflo(R.qq[ks].y) * rq * ga[2], bfhi(R.qq[ks].y) * rq * ga[3]);
                o.z = pk2(bflo(R.qq[ks].z) * rq * gb[0], bfhi(R.qq[ks].z) * rq * gb[1]); o.w = pk2(bflo(R.qq[ks].w) * rq * gb[2], bfhi(R.qq[ks].w) * rq * gb[3]);
                Qf[ks] = __builtin_bit_cast(bf16x8, o); }
        }
        __syncthreads();
        const bool more = (n + 1 < n0 + L);
#ifndef ATT_NOPF
        if (more) attn_load(R, proj, rowb, h, base + wlen, d, tid, true);
#endif
#ifdef ATT_PFCMP
        AttnPre R2; if (more) attn_load(R2, proj, rowb, h, base + wlen, d, tid, true);
#endif
        f32x4 s[9];
#pragma unroll
        for (int t = 0; t < 9; ++t) { s[t] = (f32x4){0.f, 0.f, 0.f, 0.f}; const int kt = w + t, lr = ((((n - 1) + (kt >> 3)) & 1) << 7) + ((kt & 7) << 4) + q;
            bf16x8 Kf[4];
#pragma unroll
            for (int ks = 0; ks < 4; ++ks) Kf[ks] = *(const LAS bf16x8*)(lds + lr * 256 + (((4 * ks + G) ^ q) << 4));
            __builtin_amdgcn_sched_barrier(0); __builtin_amdgcn_s_setprio(1);
#pragma unroll
            for (int ks = 0; ks < 4; ++ks) s[t] = __builtin_amdgcn_mfma_f32_16x16x32_bf16(Kf[ks], Qf[ks], s[t], 0, 0, 0);
            __builtin_amdgcn_s_setprio(0); __builtin_amdgcn_sched_barrier(0); }
        float dsum = 0.f; const bool first = (n == 0);
#pragma unroll
        for (int t = 0; t < 9; ++t)
#pragma unroll
            for (int e = 0; e < 4; ++e) { const int kk = 4 * G + e; bool ok = true;
                if (t == 0) ok = kk >= q; if (t == 8) ok = kk <= q; if (first && (w + t) < 8) ok = false;
                const float p = ok ? __builtin_amdgcn_exp2f(s[t][e]) : 0.f; s[t][e] = p; dsum += p; }
        dsum = xsum_16_32(dsum);
#ifdef ATT_PF_MID
        if (more) attn_load(R, proj, rowb, h, base + wlen, d, tid, true);
#endif
        f32x4 o[8];
#pragma unroll
        for (int nt = 0; nt < 8; ++nt) o[nt] = (f32x4){0.f, 0.f, 0.f, 0.f};
        const int q4 = q >> 2, pp = q & 3;
#pragma unroll
        for (int si = 0; si < 5; ++si) {
            v4u pw; pw.x = pk2(s[2 * si][0], s[2 * si][1]); pw.y = pk2(s[2 * si][2], s[2 * si][3]);
            if (si < 4) { pw.z = pk2(s[2 * si + 1][0], s[2 * si + 1][1]); pw.w = pk2(s[2 * si + 1][2], s[2 * si + 1][3]); } else { pw.z = 0u; pw.w = 0u; }
            const bf16x8 Pf = __builtin_bit_cast(bf16x8, pw);
            const int kt0 = w + 2 * si, kt1 = (si < 4) ? kt0 + 1 : kt0;
            const int key0 = ((((n - 1) + (kt0 >> 3)) & 1) << 7) + ((kt0 & 7) << 4) + 4 * G + q4, key1 = ((((n - 1) + (kt1 >> 3)) & 1) << 7) + ((kt1 & 7) << 4) + 4 * G + q4;
            const int sw0 = (((key0 & 7) >> 1) << 2) | (key0 & 1), sw1 = (((key1 & 7) >> 1) << 2) | (key1 & 1);
#pragma unroll
            for (int nh = 0; nh < 2; ++nh) {
                s16x4 v0[4], v1[4];
#pragma unroll
                for (int n4 = 0; n4 < 4; ++n4) { const int nt_ = 4 * nh + n4, chunk = 4 * (nt_ >> 1) + pp, hf = (pp ^ nt_) & 1;
                    v0[n4] = __builtin_bit_cast(s16x4, __builtin_amdgcn_ds_read_tr16_b64_v4i16((LAS s16x4*)(lds + 65536 + key0 * 256 + ((chunk ^ sw0) << 4) + hf * 8)));
                    v1[n4] = __builtin_bit_cast(s16x4, __builtin_amdgcn_ds_read_tr16_b64_v4i16((LAS s16x4*)(lds + 65536 + key1 * 256 + ((chunk ^ sw1) << 4) + hf * 8))); }
                __builtin_amdgcn_sched_barrier(0); __builtin_amdgcn_s_setprio(1);
#pragma unroll
                for (int n4 = 0; n4 < 4; ++n4) { const bf16x8 Vf = (bf16x8){v0[n4][0], v0[n4][1], v0[n4][2], v0[n4][3], v1[n4][0], v1[n4][1], v1[n4][2], v1[n4][3]};
                    o[4 * nh + n4] = __builtin_amdgcn_mfma_f32_16x16x32_bf16(Vf, Pf, o[4 * nh + n4], 0, 0, 0); }
                __builtin_amdgcn_s_setprio(0); __builtin_amdgcn_sched_barrier(0); }
        }
        bf16* np = num + ((size_t)g * NUM_GS + qrow) * 512 + h * 128 + 8 * G;
#pragma unroll
        for (int m = 0; m < 4; ++m) { v2u we, wo; we.x = pk2(o[2 * m][0], o[2 * m][1]); we.y = pk2(o[2 * m][2], o[2 * m][3]); wo.x = pk2(o[2 * m + 1][0], o[2 * m + 1][1]); wo.y = pk2(o[2 * m + 1][2], o[2 * m + 1][3]);
            const bool sw = (G & 1) != 0;
            v4u wv; wv.x = sw ? wo.x : we.x; wv.y = sw ? wo.y : we.y; wv.z = sw ? we.x : wo.x; wv.w = sw ? we.y : wo.y;
#ifdef ATT_NT_STORE
            __builtin_nontemporal_store(wv, (GAS v4u*)(np + 32 * m));
#else
            *(GAS v4u*)(np + 32 * m) = wv;
#endif
        }
        if (G == 0) den[(size_t)(g * 4 + h) * T + qrow] = dsum;
        __syncthreads();
#if defined(ATT_NOPF) && !defined(ATT_PF_MID)
        if (more) attn_load(R, proj, rowb, h, base + wlen, d, tid, true);
#endif
#ifdef ATT_PFCMP
        if (more) { unsigned df = 0;
#pragma unroll
            for (int i = 0; i < 4; ++i) { df |= (R.kk[i].x ^ R2.kk[i].x) | (R.kk[i].y ^ R2.kk[i].y) | (R.kk[i].z ^ R2.kk[i].z) | (R.kk[i].w ^ R2.kk[i].w) | (R.vv[i].x ^ R2.vv[i].x) | (R.vv[i].y ^ R2.vv[i].y) | (R.vv[i].z ^ R2.vv[i].z) | (R.vv[i].w ^ R2.vv[i].w) | (R.qq[i].x ^ R2.qq[i].x) | (R.qq[i].y ^ R2.qq[i].y) | (R.qq[i].z ^ R2.qq[i].z) | (R.qq[i].w ^ R2.qq[i].w); }
#ifdef ATT_PFCMP_NOFLAG
            asm volatile("" :: "v"(df));
#else
            if (df) den[0] = __builtin_nanf("");
#endif
            }
#endif
#ifdef ATT_VMW
        asm volatile("s_waitcnt vmcnt(0)" ::: "memory");
#endif
        if (more) attn_store_kv(R, lds, (n + 1) & 1, gka, gkb, tid);
    }
    __syncthreads();
}

__device__ __forceinline__ void xa_fill_image(LAS unsigned char* lds, const bf16* src  , int w, int lane) {
    asm volatile("" : "+v"(lane));
    const int rsub = lane >> 5, cp = lane & 31;
#pragma unroll
    for (int j = 0; j < 16; ++j) { const int pi = w * 16 + j, row = 2 * pi + rsub, ch = cp ^ (row & 15);
        __builtin_amdgcn_global_load_lds((const unsigned*)(src + (size_t)row * 256 + ch * 8), (LAS unsigned*)(lds + pi * 1024), 16, 0, 0); }
}
__device__ __forceinline__ void xa_fill_half(LAS unsigned char* lds, const bf16* src  , int half, int w, int lane) {
    asm volatile("" : "+v"(lane));
    const int rsub = lane >> 5, cp = lane & 31;
#pragma unroll
    for (int j = 0; j < 8; ++j) { const int pi = half * 64 + w * 8 + j, row = 2 * pi + rsub, ch = cp ^ (4 * ((row >> 3) & 3) + (row & 3));
        __builtin_amdgcn_global_load_lds((const unsigned*)(src + (size_t)row * 256 + ch * 8), (LAS unsigned*)(lds + pi * 1024), 16, 0, 0); }
}
__device__ __forceinline__ void xa_unit(LAS unsigned char* lds, const bf16* Qb, const float* qss, const bf16* Kn_h, const bf16* Vt_h, bf16* Ob, int pm, int h, int tid, bool kpre) {
    asm volatile("" : "+v"(tid));
    pm = __builtin_amdgcn_readfirstlane(pm); h = __builtin_amdgcn_readfirstlane(h);
    const int w = __builtin_amdgcn_readfirstlane(tid >> 6), lane = tid & 63, q = lane & 15, G = lane >> 4;
    const size_t row0 = (size_t)pm * 256 + 32 * w;
    if (!kpre) xa_fill_image(lds, Kn_h, w, lane);
    bf16x8 Qf[2][8]; float rq[2];
#pragma unroll
    for (int qt = 0; qt < 2; ++qt) { const size_t row = row0 + 16 * qt + q;
        const float v[4] = {qss[pg8::ssi((int)row, h * 4)], qss[pg8::ssi((int)row, h * 4 + 1)], qss[pg8::ssi((int)row, h * 4 + 2)], qss[pg8::ssi((int)row, h * 4 + 3)]}; rq[qt] = __builtin_amdgcn_rsqf(((v[0] + v[1]) + (v[2] + v[3])) * (1.0f / 256.0f) + EPS);
#pragma unroll
        for (int ks = 0; ks < 8; ++ks) Qf[qt][ks] = __builtin_bit_cast(bf16x8, *(const GAS v4u*)(Qb + row * 1024 + h * 256 + 32 * ks + 8 * G)); }
    asm volatile("s_waitcnt vmcnt(0)" ::: "memory"); __syncthreads();
    bf16x8 Pf[2][8]; float lsum[2] = {0.f, 0.f};
#pragma unroll
    for (int hk = 0; hk < 2; ++hk) {
        f32x4 sc[2][8];
#pragma unroll
        for (int kt = 0; kt < 8; ++kt) { sc[0][kt] = (f32x4){0.f, 0.f, 0.f, 0.f}; sc[1][kt] = (f32x4){0.f, 0.f, 0.f, 0.f}; }
        bf16x8 Kf[2][4];
#define XA_KLOAD(dst, bt_) do { _Pragma("unroll") for (int k4 = 0; k4 < 4; ++k4) dst[k4] = *(const LAS bf16x8*)(lds + (16 * (8 * hk + ((bt_) >> 1)) + q) * 512 + (((4 * (4 * ((bt_) & 1) + k4) + G) ^ q) << 4)); } while (0)
        XA_KLOAD(Kf[0], 0);
#pragma unroll
        for (int bt = 0; bt < 16; ++bt) { const int kt = bt >> 1, kh = bt & 1;
            if (bt + 1 < 16) XA_KLOAD(Kf[(bt + 1) & 1], bt + 1);
            __builtin_amdgcn_sched_barrier(0); __builtin_amdgcn_s_setprio(1);
#pragma unroll
            for (int k4 = 0; k4 < 4; ++k4) {
                sc[0][kt] = __builtin_amdgcn_mfma_f32_16x16x32_bf16(Kf[bt & 1][k4], Qf[0][4 * kh + k4], sc[0][kt], 0, 0, 0);
                sc[1][kt] = __builtin_amdgcn_mfma_f32_16x16x32_bf16(Kf[bt & 1][k4], Qf[1][4 * kh + k4], sc[1][kt], 0, 0, 0); }
            __builtin_amdgcn_s_setprio(0); __builtin_amdgcn_sched_barrier(0); }
#undef XA_KLOAD
#pragma unroll
        for (int qt = 0; qt < 2; ++qt)
#pragma unroll
            for (int s2 = 0; s2 < 4; ++s2) { float e[8];
#pragma unroll
                for (int r = 0; r < 4; ++r) { e[r] = __builtin_amdgcn_exp2f(sc[qt][2 * s2][r] * rq[qt]); e[4 + r] = __builtin_amdgcn_exp2f(sc[qt][2 * s2 + 1][r] * rq[qt]); }
                lsum[qt] += ((e[0] + e[1]) + (e[2] + e[3])) + ((e[4] + e[5]) + (e[6] + e[7]));
                v4u pw; pw.x = pk2(e[0], e[1]); pw.y = pk2(e[2], e[3]); pw.z = pk2(e[4], e[5]); pw.w = pk2(e[6], e[7]); Pf[qt][4 * hk + s2] = __builtin_bit_cast(bf16x8, pw); }
        __syncthreads();
        xa_fill_half(lds, Vt_h, hk, w, lane);
    }
    float linv[2];
#pragma unroll
    for (int qt = 0; qt < 2; ++qt) { float l = lsum[qt]; l = xsum_16_32(l); linv[qt] = 1.0f / l; }
    bf16* op0 = Ob + (row0 + q) * 1024 + h * 256 + 8 * G; bf16* op1 = op0 + (size_t)16 * 1024; v2u we0 = (v2u){0u, 0u}, we1 = we0;
    s16x4 va[2][8], vb[2][8];
#define XA_VLOAD(d_, dt_) do { LAS unsigned char* vrow = lds + (32 * ((dt_) >> 1) + 8 * (q >> 2) + 4 * ((dt_) & 1) + (q & 3)) * 512 + (G & 1) * 8; _Pragma("unroll") for (int s2 = 0; s2 < 8; ++s2) { \
        va[d_][s2] = *(const LAS s16x4*)(vrow + (((4 * s2 + (G >> 1)) ^ q) << 4)); vb[d_][s2] = *(const LAS s16x4*)(vrow + (((4 * s2 + 2 + (G >> 1)) ^ q) << 4)); } } while (0)
#pragma unroll
    for (int dt = 0; dt < 16; ++dt) { f32x4 o0 = (f32x4){0.f, 0.f, 0.f, 0.f}, o1 = o0;
        if ((dt & 7) == 0) {
            if (dt == 0) asm volatile("s_waitcnt vmcnt(8)" ::: "memory"); else asm volatile("s_waitcnt vmcnt(0)" ::: "memory");
            __syncthreads(); XA_VLOAD(dt & 1, dt); }
        if ((dt & 7) != 7) XA_VLOAD((dt + 1) & 1, dt + 1);
        __builtin_amdgcn_sched_barrier(0); __builtin_amdgcn_s_setprio(1);
#pragma unroll
        for (int s2 = 0; s2 < 8; ++s2) { const bf16x8 Vf = (bf16x8){va[dt & 1][s2][0], va[dt & 1][s2][1], va[dt & 1][s2][2], va[dt & 1][s2][3], vb[dt & 1][s2][0], vb[dt & 1][s2][1], vb[dt & 1][s2][2], vb[dt & 1][s2][3]};
            o0 = __builtin_amdgcn_mfma_f32_16x16x32_bf16(Vf, Pf[0][s2], o0, 0, 0, 0); o1 = __builtin_amdgcn_mfma_f32_16x16x32_bf16(Vf, Pf[1][s2], o1, 0, 0, 0); }
        __builtin_amdgcn_s_setprio(0); __builtin_amdgcn_sched_barrier(0);
        v2u w0, w1; w0.x = pk2(o0[0] * linv[0], o0[1] * linv[0]); w0.y = pk2(o0[2] * linv[0], o0[3] * linv[0]); w1.x = pk2(o1[0] * linv[1], o1[1] * linv[1]); w1.y = pk2(o1[2] * linv[1], o1[3] * linv[1]);
        if ((dt & 1) == 0) { we0 = w0; we1 = w1; }
        else { v4u f0, f1; f0.x = we0.x; f0.y = we0.y; f0.z = w0.x; f0.w = w0.y; f1.x = we1.x; f1.y = we1.y; f1.z = w1.x; f1.w = w1.y;
               *(GAS v4u*)(op0 + 32 * (dt >> 1)) = f0; *(GAS v4u*)(op1 + 32 * (dt >> 1)) = f1; } }
#undef XA_VLOAD
    __syncthreads();
}

__device__ __forceinline__ float rcp_(float x) { return __builtin_amdgcn_rcpf(x); }
__device__ __forceinline__ float sigmoid_fast(float x) { return rcp_(1.0f + __builtin_amdgcn_exp2f(-LOG2E * x)); }
__device__ __forceinline__ float gelu_tanh(float x) { const float u = 0.7978845608028654f * (x + 0.044715f * x * x * x); const float e = __builtin_amdgcn_exp2f((2.0f * LOG2E) * u); return x * (1.0f - rcp_(e + 1.0f)); }
__device__ __forceinline__ void r1_unit(LAS unsigned char* lds, const bf16* proj, const float* cw, const float* cb, const bf16* GaT, const bf16* GxT, const float* ba, const float* bx, const float* lam,
                                        bf16* Y0, int y0p, bf16* Y1, float* Aend, float* Hend, int uid, int tid) {
    asm volatile("" : "+v"(tid));
    const int g = uid & 3, chunk = (uid >> 2) & 31, b = uid >> 7, t0 = chunk * 128;
    const size_t rowb = (size_t)b * SEQ;
    LAS unsigned char* lxc = lds; LAS unsigned char* lgt = lds + 32768; LAS unsigned char* ly0 = lds + 65536; LAS unsigned char* ly1 = lds + 98304;
    {
        const int c8 = tid & 15, ch0 = 128 * g + 8 * c8;
        float wj[4][8], bb[8];
#pragma unroll
        for (int jj = 0; jj < 4; ++jj) { const f32x4 a = *(const GAS f32x4*)(cw + jj * 512 + ch0), c = *(const GAS f32x4*)(cw + jj * 512 + ch0 + 4);
            wj[jj][0] = a[0]; wj[jj][1] = a[1]; wj[jj][2] = a[2]; wj[jj][3] = a[3]; wj[jj][4] = c[0]; wj[jj][5] = c[1]; wj[jj][6] = c[2]; wj[jj][7] = c[3]; }
        { const f32x4 a = *(const GAS f32x4*)(cb + ch0), c = *(const GAS f32x4*)(cb + ch0 + 4); bb[0] = a[0]; bb[1] = a[1]; bb[2] = a[2]; bb[3] = a[3]; bb[4] = c[0]; bb[5] = c[1]; bb[6] = c[2]; bb[7] = c[3]; }
#pragma unroll
        for (int i = 0; i < 4; ++i) { const int tt = (tid >> 4) + 32 * i, t = t0 + tt;
            float a[8];
#pragma unroll
            for (int e = 0; e < 8; ++e) a[e] = bb[e];
#pragma unroll
            for (int jj = 0; jj < 4; ++jj) { const int ts = t - 3 + jj;
                v4u x = *(const GAS v4u*)(proj + (rowb + (ts < 0 ? 0 : ts)) * INC + 1536 + ch0);
                if (ts < 0) x = (v4u){0u, 0u, 0u, 0u};
                a[0] += wj[jj][0] * bflo(x.x); a[1] += wj[jj][1] * bfhi(x.x); a[2] += wj[jj][2] * bflo(x.y); a[3] += wj[jj][3] * bfhi(x.y);
                a[4] += wj[jj][4] * bflo(x.z); a[5] += wj[jj][5] * bfhi(x.z); a[6] += wj[jj][6] * bflo(x.w); a[7] += wj[jj][7] * bfhi(x.w); }
            v4u o; o.x = pk2(a[0], a[1]); o.y = pk2(a[2], a[3]); o.z = pk2(a[4], a[5]); o.w = pk2(a[6], a[7]);
            *(LAS v4u*)(lxc + tt * 256 + ((c8 ^ (tt & 15)) << 4)) = o;
            *(LAS v4u*)(lgt + tt * 256 + ((c8 ^ (tt & 15)) << 4)) = *(const GAS v4u*)(proj + (rowb + t) * INC + 2048 + ch0); }
    }
    const int w = tid >> 6, lane = tid & 63, q = lane & 15, G = lane >> 4;
    const int dd = 16 * w + q, ch = 128 * g + dd;
    bf16x8 Wa[4], Wx[4];
#pragma unroll
    for (int ks = 0; ks < 4; ++ks) { Wa[ks] = __builtin_bit_cast(bf16x8, *(const GAS v4u*)(GaT + dd * 128 + 32 * ks + 8 * G)); Wx[ks] = __builtin_bit_cast(bf16x8, *(const GAS v4u*)(GxT + dd * 128 + 32 * ks + 8 * G)); }
    const float bav = ba[ch], bxv = bx[ch], lv = lam[ch]; const float sp8 = 8.0f * __logf(1.0f + __expf(-lv));
    __syncthreads();
    float Arun = 1.f, Hrun = 0.f;
    const int xoff = ((dd >> 3) << 4), xlo = (dd & 7) * 2;
    bf16x8 XfN[4]; float xcvN[4], gtvN[4];
#define R1_LOAD(t8_) do { _Pragma("unroll") for (int ks = 0; ks < 4; ++ks) XfN[ks] = *(const LAS bf16x8*)(lxc + (16 * (t8_) + q) * 256 + (((4 * ks + G) ^ q) << 4)); \
        _Pragma("unroll") for (int e = 0; e < 4; ++e) { const int tt = 16 * (t8_) + 4 * G + e; const int so = tt * 256 + (xoff ^ ((tt & 15) << 4)) + xlo; \
            xcvN[e] = bf1(*(const LAS bf16*)(lxc + so)); gtvN[e] = bf1(*(const LAS bf16*)(lgt + so)); } } while (0)
    R1_LOAD(0);
#pragma unroll 2
    for (int tt8 = 0; tt8 < 8; ++tt8) {
        f32x4 aA = (f32x4){0.f, 0.f, 0.f, 0.f}, aX = (f32x4){0.f, 0.f, 0.f, 0.f};
        bf16x8 Xf[4]; float xcv4[4], gtv4[4];
#pragma unroll
        for (int e = 0; e < 4; ++e) { Xf[e] = XfN[e]; xcv4[e] = xcvN[e]; gtv4[e] = gtvN[e]; }
        if (tt8 + 1 < 8) R1_LOAD(tt8 + 1);
        __builtin_amdgcn_sched_barrier(0);
#pragma unroll
        for (int ks = 0; ks < 4; ++ks) {
            aA = __builtin_amdgcn_mfma_f32_16x16x32_bf16(Xf[ks], Wa[ks], aA, 0, 0, 0); aX = __builtin_amdgcn_mfma_f32_16x16x32_bf16(Xf[ks], Wx[ks], aX, 0, 0, 0); }
        float Ac[4], Hc[4]; float Ar = 1.f, Hr = 0.f;
#pragma unroll
        for (int e = 0; e < 4; ++e) {
            const float xcv = xcv4[e];
            const float rg = sigmoid_fast(aA[e] + bav), ig = sigmoid_fast(aX[e] + bxv), la = -sp8 * rg, a = __builtin_amdgcn_exp2f(LOG2E * la);
            const float y = 2.0f * la; float pl = 1.0f / 120.0f; pl = pl * y + (1.0f / 24.0f); pl = pl * y + (1.0f / 6.0f); pl = pl * y + 0.5f; pl = pl * y + 1.0f;
            const float u = __builtin_amdgcn_sqrtf(-y * pl) * (ig * xcv);
            Hr = a * Hr + u; Ar = a * Ar; Ac[e] = Ar; Hc[e] = Hr; }
        float Ai = Ar, Hi = Hr;
        { float Ap, Hp, d0, d1; rows_up16_top(Ai, G, Ap, d0); rows_up16_top(Hi, G, Hp, d1); if (G >= 1) { Hi = Ai * Hp + Hi; Ai = Ai * Ap; } }
        { const float Ap = rows_up32(Ai), Hp = rows_up32(Hi); if (G >= 2) { Hi = Ai * Hp + Hi; Ai = Ai * Ap; } }
        float Ae, He, At, Ht;
        rows_up16_top(Ai, G, Ae, At); rows_up16_top(Hi, G, He, Ht); if (G == 0) { Ae = 1.f; He = 0.f; }
        const float Ap0 = Ae * Arun, Hp0 = Ae * Hrun + He;
#pragma unroll
        for (int e = 0; e < 4; ++e) { const int tt = 16 * tt8 + 4 * G + e;
            const float Pv = Ac[e] * Ap0, hl = Hc[e] + Ac[e] * Hp0;
            const int so = tt * 256 + (xoff ^ ((tt & 15) << 4)) + xlo;
            const float gg = gelu_tanh(gtv4[e]);
            *(LAS bf16*)(ly0 + so) = f2bf(hl * gg); *(LAS bf16*)(ly1 + so) = f2bf(Pv * gg); }
        Hrun = At * Hrun + Ht; Arun = At * Arun;
    }
#undef R1_LOAD
    if (G == 0) { Aend[(size_t)(b * 32 + chunk) * 512 + ch] = Arun; Hend[(size_t)(b * 32 + chunk) * 512 + ch] = Hrun; }
    __syncthreads();
    {
        const int c8 = tid & 15;
#pragma unroll
        for (int i = 0; i < 4; ++i) { const int tt = (tid >> 4) + 32 * i; const int so = tt * 256 + ((c8 ^ (tt & 15)) << 4); const size_t row = rowb + t0 + tt; const int cc = 128 * g + 8 * c8;
            *(GAS v4u*)(Y0 + row * y0p + cc) = *(const LAS v4u*)(ly0 + so); *(GAS v4u*)(Y1 + row * 512 + cc) = *(const LAS v4u*)(ly1 + so); }
    }
    __syncthreads();
}

__device__ __forceinline__ void post_unit(LAS unsigned char* lds, const bf16* __restrict__ num, const float* __restrict__ den, const bf16* __restrict__ Y0, int y0p, const bf16* __restrict__ Y1, const float* __restrict__ Aend, const float* __restrict__ Hend, bf16* __restrict__ aout, int uid, int tid) {
    asm volatile("" : "+v"(tid));
    const int row0 = uid * 64, b = row0 >> 12, chunk = (row0 & 4095) >> 7;
    LAS float* hin = (LAS float*)lds;
    const int c8 = tid & 63, rsub = tid >> 6, h = c8 >> 4;
    v4u ya[4], yp[4], na[4], nb[4], nc[4]; float dn[4];
#pragma unroll
        for (int i = 0; i < 4; ++i) { const size_t row = row0 + rsub + 8 * (4 * 0 + i);
#ifdef POST_NT
            ya[i] = __builtin_nontemporal_load((const GAS v4u*)(Y0 + row * y0p + 8 * c8)); yp[i] = __builtin_nontemporal_load((const GAS v4u*)(Y1 + row * 512 + 8 * c8));
            na[i] = __builtin_nontemporal_load((const GAS v4u*)(num + ((size_t)0 * NUM_GS + row) * 512 + 8 * c8)); nb[i] = __builtin_nontemporal_load((const GAS v4u*)(num + ((size_t)1 * NUM_GS + row) * 512 + 8 * c8)); nc[i] = __builtin_nontemporal_load((const GAS v4u*)(num + ((size_t)2 * NUM_GS + row) * 512 + 8 * c8));
#else
            ya[i] = *(const GAS v4u*)(Y0 + row * y0p + 8 * c8); yp[i] = *(const GAS v4u*)(Y1 + row * 512 + 8 * c8);
            na[i] = *(const GAS v4u*)(num + ((size_t)0 * NUM_GS + row) * 512 + 8 * c8); nb[i] = *(const GAS v4u*)(num + ((size_t)1 * NUM_GS + row) * 512 + 8 * c8); nc[i] = *(const GAS v4u*)(num + ((size_t)2 * NUM_GS + row) * 512 + 8 * c8);
#endif
            dn[i] = den[(size_t)(0 * 4 + h) * T + row] + den[(size_t)(1 * 4 + h) * T + row] + den[(size_t)(2 * 4 + h) * T + row]; }
    { float H = 0.f; const float* ae = Aend + (size_t)(b * 32) * 512 + tid; const float* he = Hend + (size_t)(b * 32) * 512 + tid;
      const int nch = __builtin_amdgcn_readfirstlane(chunk);
      for (int s0 = 0; s0 < nch; s0 += 16) { float av[16], hv16[16];
#pragma unroll
          for (int j = 0; j < 16; ++j) { const int sj = (s0 + j < nch) ? s0 + j : 0; av[j] = ae[(size_t)sj * 512]; hv16[j] = he[(size_t)sj * 512]; }
#pragma unroll
          for (int j = 0; j < 16; ++j) { const float mk = (s0 + j < nch) ? 1.0f : 0.0f; H = (av[j] * mk + (1.0f - mk)) * H + hv16[j] * mk; } }
      hin[tid] = H; }
    __syncthreads();
    float hv[8];
#pragma unroll
    for (int e = 0; e < 8; ++e) hv[e] = hin[8 * c8 + e];
#pragma unroll
        for (int i = 0; i < 4; ++i) { const size_t row = row0 + rsub + 8 * (4 * 0 + i);
            { const v4u a = ya[i], p = yp[i]; v4u o;
              o.x = pk2(bflo(a.x) + bflo(p.x) * hv[0], bfhi(a.x) + bfhi(p.x) * hv[1]); o.y = pk2(bflo(a.y) + bflo(p.y) * hv[2], bfhi(a.y) + bfhi(p.y) * hv[3]);
              o.z = pk2(bflo(a.z) + bflo(p.z) * hv[4], bfhi(a.z) + bfhi(p.z) * hv[5]); o.w = pk2(bflo(a.w) + bflo(p.w) * hv[6], bfhi(a.w) + bfhi(p.w) * hv[7]);
              *(GAS v4u*)(aout + row * 1024 + 512 + 8 * c8) = o; }
            { const float inv = 1.0f / dn[i]; const v4u a = na[i], bq = nb[i], c = nc[i]; v4u o;
              o.x = pk2((bflo(a.x) + bflo(bq.x) + bflo(c.x)) * inv, (bfhi(a.x) + bfhi(bq.x) + bfhi(c.x)) * inv); o.y = pk2((bflo(a.y) + bflo(bq.y) + bflo(c.y)) * inv, (bfhi(a.y) + bfhi(bq.y) + bfhi(c.y)) * inv);
              o.z = pk2((bflo(a.z) + bflo(bq.z) + bflo(c.z)) * inv, (bfhi(a.z) + bfhi(bq.z) + bfhi(c.z)) * inv); o.w = pk2((bflo(a.w) + bflo(bq.w) + bflo(c.w)) * inv, (bfhi(a.w) + bfhi(bq.w) + bfhi(c.w)) * inv);
              *(GAS v4u*)(aout + row * 1024 + 8 * c8) = o; } }
#pragma unroll
        for (int i = 0; i < 4; ++i) { const size_t row = row0 + rsub + 8 * (4 * 1 + i);
#ifdef POST_NT
            ya[i] = __builtin_nontemporal_load((const GAS v4u*)(Y0 + row * y0p + 8 * c8)); yp[i] = __builtin_nontemporal_load((const GAS v4u*)(Y1 + row * 512 + 8 * c8));
            na[i] = __builtin_nontemporal_load((const GAS v4u*)(num + ((size_t)0 * NUM_GS + row) * 512 + 8 * c8)); nb[i] = __builtin_nontemporal_load((const GAS v4u*)(num + ((size_t)1 * NUM_GS + row) * 512 + 8 * c8)); nc[i] = __builtin_nontemporal_load((const GAS v4u*)(num + ((size_t)2 * NUM_GS + row) * 512 + 8 * c8));
#else
            ya[i] = *(const GAS v4u*)(Y0 + row * y0p + 8 * c8); yp[i] = *(const GAS v4u*)(Y1 + row * 512 + 8 * c8);
            na[i] = *(const GAS v4u*)(num + ((size_t)0 * NUM_GS + row) * 512 + 8 * c8); nb[i] = *(const GAS v4u*)(num + ((size_t)1 * NUM_GS + row) * 512 + 8 * c8); nc[i] = *(const GAS v4u*)(num + ((size_t)2 * NUM_GS + row) * 512 + 8 * c8);
#endif
            dn[i] = den[(size_t)(0 * 4 + h) * T + row] + den[(size_t)(1 * 4 + h) * T + row] + den[(size_t)(2 * 4 + h) * T + row]; }
#pragma unroll
        for (int i = 0; i < 4; ++i) { const size_t row = row0 + rsub + 8 * (4 * 1 + i);
            { const v4u a = ya[i], p = yp[i]; v4u o;
              o.x = pk2(bflo(a.x) + bflo(p.x) * hv[0], bfhi(a.x) + bfhi(p.x) * hv[1]); o.y = pk2(bflo(a.y) + bflo(p.y) * hv[2], bfhi(a.y) + bfhi(p.y) * hv[3]);
              o.z = pk2(bflo(a.z) + bflo(p.z) * hv[4], bfhi(a.z) + bfhi(p.z) * hv[5]); o.w = pk2(bflo(a.w) + bflo(p.w) * hv[6], bfhi(a.w) + bfhi(p.w) * hv[7]);
              *(GAS v4u*)(aout + row * 1024 + 512 + 8 * c8) = o; }
            { const float inv = 1.0f / dn[i]; const v4u a = na[i], bq = nb[i], c = nc[i]; v4u o;
              o.x = pk2((bflo(a.x) + bflo(bq.x) + bflo(c.x)) * inv, (bfhi(a.x) + bfhi(bq.x) + bfhi(c.x)) * inv); o.y = pk2((bflo(a.y) + bflo(bq.y) + bflo(c.y)) * inv, (bfhi(a.y) + bfhi(bq.y) + bfhi(c.y)) * inv);
              o.z = pk2((bflo(a.z) + bflo(bq.z) + bflo(c.z)) * inv, (bfhi(a.z) + bfhi(bq.z) + bfhi(c.z)) * inv); o.w = pk2((bflo(a.w) + bflo(bq.w) + bflo(c.w)) * inv, (bfhi(a.w) + bfhi(bq.w) + bfhi(c.w)) * inv);
              *(GAS v4u*)(aout + row * 1024 + 8 * c8) = o; } }
    __syncthreads();
}

__device__ __forceinline__ f32x4 up4(v2u w) { return (f32x4){bflo(w.x), bfhi(w.x), bflo(w.y), bfhi(w.y)}; }
constexpr int PU_RS_OFF = RING_BYTES + 1024, PU_PART_OFF = RING_BYTES + 4096;
template <int W> __device__ __forceinline__ void pool_rows(const bf16* __restrict__ x, const bf16* __restrict__ halo  , LAS unsigned char* img, const LAS float* rs  ,
                                                           size_t grow0  , int rloc  , int ts, int c, int l64) {
    v2u rw[W - 1 + 32];
#pragma unroll
    for (int i = 0; i < W - 1 + 32; ++i) { const int lr = rloc - (W - 1) + i, t = ts - (W - 1) + i;
        const bf16* src = (lr >= 0) ? x + (grow0 + lr) * 1024 + c : halo + (size_t)(15 + lr) * 1024 + c;
        if (t < 0) src = x + grow0 * 1024 + c;
        rw[i] = *(const GAS v2u*)src; if (t < 0) rw[i] = (v2u){0u, 0u}; }
    f32x4 sum = (f32x4){0.f, 0.f, 0.f, 0.f};
#pragma unroll
    for (int i = 0; i < W - 1; ++i) sum += up4(rw[i]) * rs[15 - (W - 1) + i];
#pragma unroll
    for (int k = 0; k < 32; ++k) { const int t = ts + k;
        const f32x4 hcur = up4(rw[W - 1 + k]) * rs[15 + k];
        sum += hcur;
        const int cnt = (t + 1 < W) ? t + 1 : W; const float inv = 1.0f / (float)cnt;
        const f32x4 dv = sum * inv - hcur;
        v2u o; o.x = pk2(dv[0], dv[1]); o.y = pk2(dv[2], dv[3]);
        *(LAS v2u*)(img + (rloc + k) * 512 + (((l64 >> 1) ^ (k & 15)) << 4) + (l64 & 1) * 8) = o;
        sum -= up4(rw[k]) * rs[15 + k - (W - 1)]; }
}
__device__ __forceinline__ void pool_unit(LAS unsigned char* lds, bf16* xb, const float* ss, float* ss2, const bf16* halo_all  , const bf16* Wt  , const float* scale, int pm, int g, int tid) {
    asm volatile("" : "+v"(tid));
    pm = __builtin_amdgcn_readfirstlane(pm); g = __builtin_amdgcn_readfirstlane(g);
    const int w = __builtin_amdgcn_readfirstlane(tid >> 6), lane = tid & 63, q = lane & 15, G = lane >> 4;
    const int row0 = pm * 256, tb = row0 & 4095;
    bf16x8 Bf[2][8];
#pragma unroll
    for (int ct = 0; ct < 2; ++ct)
#pragma unroll
        for (int ks = 0; ks < 8; ++ks) Bf[ct][ks] = __builtin_bit_cast(bf16x8, *(const GAS v4u*)(Wt + (size_t)(32 * w + 8 * (q >> 2) + 4 * ct + (q & 3)) * 256 + 32 * ks + 8 * G));
    LAS float* rs = (LAS float*)(lds + PU_RS_OFF);
    if (tid < 271) { const int t = tb - 15 + tid; float r = 0.f;
        if (t >= 0) { float pv[16];
#pragma unroll
            for (int k = 0; k < 16; ++k) pv[k] = ss[pg8::ssi(row0 - 15 + tid, k)];
            const float sm = (((pv[0] + pv[1]) + (pv[2] + pv[3])) + ((pv[4] + pv[5]) + (pv[6] + pv[7]))) + (((pv[8] + pv[9]) + (pv[10] + pv[11])) + ((pv[12] + pv[13]) + (pv[14] + pv[15])));
            r = 1.0f / sqrtf(sm * (1.0f / 1024.0f) + EPS); }
        rs[tid] = r; }
    __syncthreads();
    {
        const int c = 256 * g + 4 * lane, rloc = 32 * w, ts = tb + rloc; const LAS float* rsh = rs + rloc;
        const bf16* halo = pm > 0 ? halo_all + (size_t)(pm - 1) * 15 * 1024 : xb;
        if (g == 0) pool_rows<2>(xb, halo, lds, rsh, (size_t)row0, rloc, ts, c, lane);
        else if (g == 1) pool_rows<4>(xb, halo, lds, rsh, (size_t)row0, rloc, ts, c, lane);
        else if (g == 2) pool_rows<8>(xb, halo, lds, rsh, (size_t)row0, rloc, ts, c, lane);
        else pool_rows<16>(xb, halo, lds, rsh, (size_t)row0, rloc, ts, c, lane);
    }
    __syncthreads();
    const int gc = 256 * g + 32 * w + 8 * G;
    const f32x4 sc0 = *(const GAS f32x4*)(scale + gc), sc1 = *(const GAS f32x4*)(scale + gc + 4);
    LAS float* part = (LAS float*)(lds + PU_PART_OFF);
#pragma unroll
    for (int hh = 0; hh < 2; ++hh) {
        f32x4 acc[8][2]; v4u xv[8];
#pragma unroll
        for (int i = 0; i < 8; ++i) { acc[i][0] = (f32x4){0.f, 0.f, 0.f, 0.f}; acc[i][1] = acc[i][0];
            xv[i] = *(const GAS v4u*)(xb + (size_t)(row0 + (8 * hh + i) * 16 + q) * 1024 + gc); }
        bf16x8 Af[2][4];
#define PU_ALOAD(dst, bt_) do { _Pragma("unroll") for (int k4 = 0; k4 < 4; ++k4) dst[k4] = *(const LAS bf16x8*)(lds + ((8 * hh + ((bt_) >> 1)) * 16 + q) * 512 + (((4 * (4 * ((bt_) & 1) + k4) + G) ^ q) << 4)); } while (0)
        PU_ALOAD(Af[0], 0);
#pragma unroll
        for (int bt = 0; bt < 16; ++bt) { const int i = bt >> 1, kh = bt & 1;
            if (bt + 1 < 16) PU_ALOAD(Af[(bt + 1) & 1], bt + 1);
            __builtin_amdgcn_sched_barrier(0); __builtin_amdgcn_s_setprio(1);
#pragma unroll
            for (int k4 = 0; k4 < 4; ++k4) {
                acc[i][0] = __builtin_amdgcn_mfma_f32_16x16x32_bf16(Bf[0][4 * kh + k4], Af[bt & 1][k4], acc[i][0], 0, 0, 0);
                acc[i][1] = __builtin_amdgcn_mfma_f32_16x16x32_bf16(Bf[1][4 * kh + k4], Af[bt & 1][k4], acc[i][1], 0, 0, 0); }
            __builtin_amdgcn_s_setprio(0); __builtin_amdgcn_sched_barrier(0); }
#undef PU_ALOAD
#pragma unroll
        for (int i = 0; i < 8; ++i) { const int lrow = (8 * hh + i) * 16 + q;
            const f32x4 x0 = up4((v2u){xv[i].x, xv[i].y}) + acc[i][0] * sc0, x1 = up4((v2u){xv[i].z, xv[i].w}) + acc[i][1] * sc1;
            float sq = ((x0[0] * x0[0] + x0[1] * x0[1]) + (x0[2] * x0[2] + x0[3] * x0[3])) + ((x1[0] * x1[0] + x1[1] * x1[1]) + (x1[2] * x1[2] + x1[3] * x1[3]));
            bf16* xp = xb + (size_t)(row0 + lrow) * 1024 + gc;
            v4u o; o.x = pk2(x0[0], x0[1]); o.y = pk2(x0[2], x0[3]); o.z = pk2(x1[0], x1[1]); o.w = pk2(x1[2], x1[3]);
            *(GAS v4u*)xp = o;
            sq = xsum_16_32(sq);
            if (G == 0) part[w * 256 + lrow] = sq; }
    }
    __syncthreads();
    for (int idx = tid; idx < 1024; idx += NWAVES * 64) { const int row = idx >> 2, j = idx & 3;
        ss2[pg8::ssi(row0 + row, 4 * g + j)] = part[(2 * j) * 256 + row] + part[(2 * j + 1) * 256 + row]; }
    __syncthreads();
}

#ifndef MK_TEST
constexpr int N_PHASES = 41;
__global__ void __launch_bounds__(NWAVES * 64, 2) mk_fwd(Args args) {
    extern __shared__ __attribute__((aligned(16))) unsigned char lds_raw[];
    LAS unsigned char* lds = (LAS unsigned char*)lds_raw;
    volatile LAS unsigned* MISC = (volatile LAS unsigned*)(lds + MISC_OFF);
#define ws ld_ws(args)
    const int tid = threadIdx.x, wave = __builtin_amdgcn_readfirstlane(tid >> 6);
    const int G = gridDim.x, bid = blockIdx.x;
    const int vcu = (G % 8 == 0) ? (bid % 8) * (G / 8) + bid / 8 : bid;
    const int gw = vcu * NWAVES + wave, NGW = G * NWAVES;
    const int p = (bid >> 3) & 3, c = (bid & 7) | ((bid >> 5) << 3);
    const int PG = 64, gwp = c * NWAVES + wave, NGWP = PG * NWAVES;
    for (int u = tid; u < (LDS_BYTES - LDSCTL_OFF) / 4; u += NWAVES * 64) ((LAS unsigned*)(lds + LDSCTL_OFF))[u] = 0u;
    __syncthreads();
    unsigned* ctl = (unsigned*)(ws + WS_CTL);
    XcdBarrier bar0; bar0.bar = ctl + 1024; bar0.x = 0; bar0.st = nullptr; bar0.G = 0;
    XcdBarrier bar = bar0;
    if (MK_N_LAUNCHES == 1) { bar0 = xcd_barrier_post(ctl + 1024, MISC + 8, (unsigned)G); bar = xcd_barrier_post(ctl + 1024 + 4096 * (1 + p), MISC + 10, (unsigned)PG); }
#if MK_N_LAUNCHES != 1
    const int lo = args.ph_lo, hi = args.ph_hi;
#endif
#if MK_N_LAUNCHES == 1
#define IN(k) true
#else
#define IN(k) (lo <= (k) && (k) < hi)
#endif
#ifdef GLOBAL_BAR
#define SEAM(k) do { if (MK_N_LAUNCHES == 1 && (k) + 1 < N_PHASES) { for (int b_ = 0; b_ < REP_BAR; ++b_) xcd_barrier(bar0); } } while (0)
#else
#define SEAM(k) do { if (MK_N_LAUNCHES == 1 && (k) + 1 < N_PHASES) { for (int b_ = 0; b_ < REP_BAR; ++b_) xcd_barrier(bar); } } while (0)
#endif
#define ZEROS ((const float*)(ws + WS_CTL + 98304))
#define LOCAL_SEAM() do { if (MK_N_LAUNCHES == 1) { asm volatile("s_waitcnt vmcnt(0)" ::: "memory"); __syncthreads(); if (tid == 0) { __builtin_amdgcn_fence(__ATOMIC_ACQUIRE, "agent"); asm volatile("s_waitcnt vmcnt(0)" ::: "memory"); } __syncthreads(); } } while (0)
#define RB ((size_t)p * SEQ)
#define SS ((float*)(ws + WS_SS) + RB * 16)
#define QSS ((float*)(ws + WS_QSS) + RB * 16)
#define LSUM ((float*)(ws + WS_LSUM) + RB * 16)
#define SS2 ((float*)(ws + WS_LSUM) + RB * 16)
#define DEN ((float*)(ws + WS_DEN) + RB)
#define AEND ((float*)(ws + WS_AEND) + (size_t)p * 32 * 512)
#define HEND ((float*)(ws + WS_HEND) + (size_t)p * 32 * 512)
#define XB ((bf16*)(ws + WS_XB) + RB * 1024)
#define HB (ws + WS_HID + (size_t)p * 32 * MiB)
#define PROJ ((bf16*)HB)
#define NUM ((bf16*)(HB + 20 * MiB))
#define AOUT ((bf16*)HB)
#define QB ((bf16*)(HB + 8 * MiB))
#define PB ((bf16*)(HB + 16 * MiB))
#define OB ((bf16*)(HB + 24 * MiB))
#define HID ((bf16*)HB)
#define DOP ((unsigned char*)OUTP() + (size_t)p * DO_PIPE)
#define Y0 ((bf16*)(DOP + DO_Y0))
#define Y1 ((bf16*)(DOP + DO_Y1))
#define KVRAW ((bf16*)(DOP + DO_KVRAW))
#define HALO ((bf16*)(DOP + DO_KVRAW))
#define MEMN ((bf16*)(DOP + DO_MEMN))
#define KNP ((bf16*)(DOP + DO_KN))
#define VTP ((bf16*)(DOP + DO_VT))
#ifdef USE_STATIC_ORDER
#define PIPE_ORDER pg8::StaticOrder
#else
#define PIPE_ORDER pg8::XcdOrder
#endif
#ifndef P0B_C0
#define P0B_C0 0
#define P0B_C1 4
#define P0B_C2 12
#endif
#ifndef P0_INFLIGHT
#define P0_INFLIGHT 2
#endif
#ifndef HID_SLAB
#define HID_SLAB 0
#endif
#ifndef CLK_PH
#define CLK_PH -1
#endif
#ifndef STAG
#define STAG 2000
#endif
    if (IN(0)) { if (MK_N_LAUNCHES == 1 && REP_P0 > 1) xcd_barrier_discover(bar0);
        REPEAT(REP_P0) { p0_prologue(args, lds, gw, NGW, wave); if (MK_N_LAUNCHES == 1 && rep_ + 1 < REP_P0) xcd_barrier(bar0); }
        if (MK_N_LAUNCHES == 1) { if (REP_P0 <= 1) xcd_barrier_discover(bar0);
            xcd_barrier(bar0); xcd_barrier_discover(bar);
#ifdef P0_SLEEP_SKEW
            const unsigned long long t0_ = wall_clock64(); const unsigned long long dl_ = (unsigned long long)p * STAG; while (wall_clock64() - t0_ < dl_) __builtin_amdgcn_s_sleep(8);
            if (p > 0) p0_items<1>(args, lds, (p == 1 ? 0 : p == 2 ? P0_NB / 6 : P0_NB / 2), (p == 1 ? P0_NB / 6 : p == 2 ? P0_NB / 2 : P0_NB), gwp, NGWP, wave);
#else
            { constexpr int U = P0_NB / 24; const int c0 = P0B_C0 * U, c1 = P0B_C1 * U, c2 = P0B_C2 * U;
              const int f_ = p == 0 ? 0 : p == 1 ? c0 : p == 2 ? c1 : c2, l_ = p == 0 ? c0 : p == 1 ? c1 : p == 2 ? c2 : P0_NB;
              if (l_ > f_) p0_items<1>(args, lds, f_, l_, gwp, NGWP, wave); }
#endif
            {
                asm volatile("s_waitcnt vmcnt(0)" ::: "memory"); __syncthreads();
                if (tid == 0) { __builtin_amdgcn_fence(__ATOMIC_RELEASE, "agent"); asm volatile("s_waitcnt vmcnt(0)" ::: "memory"); (void)xb_add(ctl + 512, 1u); } } } }

    for (int l = 0; l < 4; ++l) {
        const int pb = 1 + 10 * l;
        if (l == 1 && MK_N_LAUNCHES == 1) {
            if (tid == 0) { XB_SPIN(xb_ld(ctl + 512) < 256u, bar0.bar); __builtin_amdgcn_fence(__ATOMIC_ACQUIRE, "agent"); asm volatile("s_waitcnt vmcnt(0)" ::: "memory"); }
            __syncthreads(); }
        if ((l & 1) == 0) {
            const int e = l >> 1;
            if (IN(pb + 0)) { REPEAT(REP_A1) {
                { pg8::Gemm g{XB, (const bf16*)(ws + WS_WIN) + (size_t)e * INC * D, D, D, D, ~0, 0, (long)256 * D, 30, 0};
                  PIPE_ORDER S; S.init(SEQ / 256, INC / 256, PG, c);
                  pg8::EpiBf16<1> E{PROJ, INC, SS, nullptr};
                  pg8::gemm_phase(lds, g, S, E); }
                if (l == 0) { pg8::Gemm g{MEMN, (const bf16*)(ws + WS_WKV), D, D, D, 0, 0, (long)256 * D, 0, (long)2048 * D};
                  pg8::StaticOrder S; S.init(4, 8, PG - 32, c >= 32 ? c - 32 : (1 << 20));
                  pg8::EpiBf16<0> E{KVRAW, 2048, nullptr, nullptr};
                  pg8::gemm_phase(lds, g, S, E); }
                REP_SEAM(REP_A1); }
                SEAM(pb + 0); }
            if (IN(pb + 1)) { REPEAT(REP_A2) {
                if (l == 0) for (int r2_ = 0; r2_ < REP_KVF; ++r2_) kv_finalize(args, KVRAW, KNP, VTP, gwp, NGWP);
                for (int r2_ = 0; r2_ < REP_ATTN; ++r2_) {
                    for (int sgi = 0; sgi < 2; ++sgi) {
                        int g_, h_, r_, n0_, L_;
                        if (sgi == 1) { g_ = 2; h_ = c >> 4; r_ = c & 15; n0_ = 0; L_ = 2; }
                        else if (c < 32) { g_ = 0; h_ = c >> 3; r_ = 0; n0_ = 4 * (c & 7); L_ = 4; }
                        else { const int id = c - 32, chain = id >> 1; g_ = 1; h_ = chain >> 2; r_ = chain & 3; n0_ = 4 * (id & 1); L_ = 4; }
#ifdef CLK_ACC
                        const unsigned long long ta0_ = wall_clock64();
#endif
                        attn_segment(lds, PROJ, INP(7) + e * 128, INP(8) + e * 128, NUM, DEN, g_, h_, r_, n0_, L_, tid);
#ifdef CLK_ACC
                        if (tid == 0) MISC[16 + 7] += (unsigned)(wall_clock64() - ta0_);
#endif
                    }
                }
                for (int u = c; u < 128; u += PG) for (int r2_ = 0; r2_ < REP_R1; ++r2_) {
#ifdef CLK_ACC
                    const unsigned long long tr0_ = wall_clock64();
#endif
                    r1_unit(lds, PROJ, INP(9) + e * 2048, INP(10) + e * 512, (const bf16*)(ws + WS_GT) + (size_t)((e * 2 + 0) * 4 + (u & 3)) * 16384, (const bf16*)(ws + WS_GT) + (size_t)((e * 2 + 1) * 4 + (u & 3)) * 16384,
                            INP(12) + e * 512, INP(14) + e * 512, INP(15) + e * 512, Y0, 512, Y1, AEND, HEND, u, tid);
#ifdef CLK_ACC
                    if (tid == 0) MISC[16 + 6] += (unsigned)(wall_clock64() - tr0_);
#endif
                }
                REP_SEAM(REP_A2); }
                SEAM(pb + 1); }
            if (IN(pb + 2)) { REPEAT(REP_A3) {
                post_unit(lds, NUM, DEN, Y0, 512, Y1, AEND, HEND, AOUT, c, tid);
                REP_SEAM(REP_A3); }
                SEAM(pb + 2); }
            if (IN(pb + 3)) { REPEAT(REP_A4) {
                pg8::Gemm g{AOUT, (const bf16*)(ws + WS_WOUT) + (size_t)e * D * D, D, D, D, ~0, 0, (long)256 * D, 30, 0};
                PIPE_ORDER S; S.init(SEQ / 256, 4, PG, c);
                pg8::EpiRes E{nullptr, XB, SS, rep_ ? ZEROS : nullptr};
                pg8::gemm_phase(lds, g, S, E);
                REP_SEAM(REP_A4); }
                SEAM(pb + 3); }
        } else {
            const int o = l >> 1;
            if (IN(pb + 0)) { REPEAT(REP_B1) {
                { PIPE_ORDER S; S.init(SEQ / 256, 4, PG, c); pg8::Unit u;
                  if (S.next(0, u)) pool_unit(lds, XB, SS, SS2, HALO, (const bf16*)(ws + WS_POOLT) + ((size_t)o * 4 + u.pn) * 65536, rep_ ? ZEROS : INP(18) + o * D, u.pm, u.pn, tid); }
                REP_SEAM(REP_B1); }
                SEAM(pb + 3); }
        }
#ifdef CLK_ACC
        if (tid == 0) MISC[16 + 14] = (CLK_PH == 4 || CLK_PH < 0) ? 1u : 0u;
#endif
        if (IN(pb + 4)) { REPEAT(REP_X1) {
            pg8::Gemm g{XB, (const bf16*)(ws + WS_WQ) + (size_t)l * D * D, D, D, D, ~0, 0, (long)256 * D, 30, 0};
            PIPE_ORDER S; S.init(SEQ / 256, 4, PG, c);
            pg8::EpiBf16<3> E{QB, D, (l & 1) ? SS2 : SS, QSS};
            pg8::gemm_phase(lds, g, S, E);
            REP_SEAM(REP_X1); }
#ifdef NO_LOCAL_SEAM
#define XA_KPRE_COND && false
            SEAM(pb + 4);
#else
#define XA_KPRE_COND
#ifndef XA_UNFUSED
            if (MK_N_LAUNCHES == 1) { PIPE_ORDER S; S.init(SEQ / 256, 4, PG, c); pg8::Unit u;
                if (S.next(0, u)) xa_fill_image(lds, KNP + (size_t)l * 4 * 65536 + (size_t)u.pn * 65536, __builtin_amdgcn_readfirstlane(tid >> 6), tid & 63); }
#endif
            LOCAL_SEAM();
#endif
            }
#ifndef XA_UNFUSED
        if (IN(pb + 5)) { REPEAT(REP_X2) {
            { PIPE_ORDER S; S.init(SEQ / 256, 4, PG, c); pg8::Unit u; if (S.next(0, u)) xa_unit(lds, QB, QSS, KNP + (size_t)l * 4 * 65536 + (size_t)u.pn * 65536, VTP + (size_t)l * 4 * 65536 + (size_t)u.pn * 65536, OB, u.pm, u.pn, tid, MK_N_LAUNCHES == 1 && rep_ == 0 XA_KPRE_COND); }
            REP_SEAM(REP_X2); }
            SEAM(pb + 6); }
#else
        if (IN(pb + 5)) { REPEAT(REP_X2) {
            pg8::Gemm g{QB, KNP + (size_t)l * 4 * 65536, D, 256, 256, ~0, 256, (long)65536, 30, 0};
            PIPE_ORDER S; S.init(SEQ / 256, 4, PG, c);
            pg8::EpiBf16<4> E{PB, D, QSS, LSUM};
            pg8::gemm_phase(lds, g, S, E);
            REP_SEAM(REP_X2); }
#ifdef NO_LOCAL_SEAM
            SEAM(pb + 5);
#else
            LOCAL_SEAM();
#endif
            }
        if (IN(pb + 6)) { REPEAT(REP_X3) {
            pg8::Gemm g{PB, VTP + (size_t)l * 4 * 65536, D, 256, 256, ~0, 256, (long)65536, 30, 0};
            PIPE_ORDER S; S.init(SEQ / 256, 4, PG, c);
            pg8::EpiBf16<5> E{OB, D, LSUM, nullptr};
            pg8::gemm_phase(lds, g, S, E);
            REP_SEAM(REP_X3); }
            SEAM(pb + 6); }
#endif
        if (IN(pb + 7)) { REPEAT(REP_X4) {
            pg8::Gemm g{OB, (const bf16*)(ws + WS_WO) + (size_t)l * D * D, D, D, D, ~0, 0, (long)256 * D, 30, 0};
            PIPE_ORDER S; S.init(SEQ / 256, 4, PG, c);
            pg8::EpiRes E{nullptr, XB, SS, rep_ ? ZEROS : nullptr};
            pg8::gemm_phase(lds, g, S, E);
            REP_SEAM(REP_X4); }
            SEAM(pb + 7); }
#ifdef CLK_ACC
        if (tid == 0) MISC[16 + 14] = (CLK_PH == 8 || CLK_PH < 0) ? 1u : 0u;
#endif
        if (IN(pb + 8)) { REPEAT(REP_M1) {
            pg8::Gemm g{XB, (const bf16*)(ws + WS_W1) + (size_t)l * FF * D, D, D, D, ~0, 0, (long)256 * D, 30, 0};
            PIPE_ORDER S; S.init(SEQ / 256, FF / 256, PG, c);
            pg8::EpiBf16<2, HID_SLAB != 0> E{HID, FF, SS, nullptr};
            pg8::gemm_phase(lds, g, S, E);
            REP_SEAM(REP_M1); }
            SEAM(pb + 8); }
#ifdef CLK_ACC
        if (tid == 0) MISC[16 + 14] = (CLK_PH == 9 || CLK_PH < 0) ? 1u : 0u;
#endif
        if (IN(pb + 9)) { REPEAT(REP_M2) {
            pg8::Gemm g{HID, (const bf16*)(ws + WS_W2) + (size_t)l * D * FF, HID_SLAB ? 64 : FF, FF, FF, ~0, 0, (long)256 * FF, 30, 0, HID_SLAB ? (long)256 * 64 : (long)64, (long)256 * FF};
#ifdef PROBE_KSTEP0
            if (rep_) g.a_kstep = 0;
#endif
            PIPE_ORDER S; S.init(SEQ / 256, 4, PG, c);
            pg8::EpiRes E{(l == 3 && rep_ == 0) ? OUTP() + RB * 1024 : nullptr, XB, SS, rep_ ? ZEROS : nullptr, (l & 1) ? nullptr : HALO};
            pg8::gemm_phase(lds, g, S, E);
            REP_SEAM(REP_M2); }
            SEAM(pb + 9); }
    }
#ifdef CLK_ACC
    xcd_barrier(bar0);
    if (bid == 0 && tid == 0) { const float us = (float)MISC[16 + CLK_ACC] * 0.01f; OUTP()[0] = floorf(us / (float)CLK_STEP + 0.5f) * (float)CLK_STEP * 1000.0f; }
#endif
#ifdef WS_PROBE
    xcd_barrier(bar0);
    if (bid == 0 && tid == 0) OUTP()[0] = (float)args.ph_hi * 1000.0f;
#endif
#undef IN
#undef SEAM
#undef ws
}
#endif

extern "C" void kernel_launch(void* const* d_in, const int* in_sizes, int n_in, void* d_out, int out_size, void* d_ws, size_t ws_size, hipStream_t stream) {
    static int grid = 0;
    if (grid == 0) {
        if (n_in != 26 || in_sizes[0] != T * D || out_size != T * D || ws_size < WS_END) { fprintf(stderr, "kernel_launch: unexpected shapes: n_in %d in0 %d out %d ws %zu (need %zu); nothing launched\n", n_in, n_in > 0 ? in_sizes[0] : -1, out_size, ws_size, (size_t)WS_END); grid = -1; return; }
        int dev = 0, cus = 0, per_cu = 0;
        if (hipGetDevice(&dev) != hipSuccess || hipDeviceGetAttribute(&cus, hipDeviceAttributeMultiprocessorCount, dev) != hipSuccess) { grid = -1; return; }
        if (hipFuncSetAttribute((const void*)mk_fwd, hipFuncAttributeMaxDynamicSharedMemorySize, LDS_BYTES) != hipSuccess) { fprintf(stderr, "kernel_launch: hipFuncSetAttribute failed\n"); grid = -1; return; }
        if (hipOccupancyMaxActiveBlocksPerMultiprocessor(&per_cu, (const void*)mk_fwd, NWAVES * 64, LDS_BYTES) != hipSuccess || per_cu < 1) fprintf(stderr, "kernel_launch: occupancy query reports %d\n", per_cu);
        (void)hipGetLastError();
        grid = cus;
        if (grid != 256) fprintf(stderr, "kernel_launch: %d CUs (built for 256)\n", grid);
    }
    if (grid < 0) return;
    (void)hipMemsetAsync((char*)d_ws + WS_CTL, 0, CTL_ZERO_BYTES, stream);
    Args a{};
    for (int i = 0; i < 26; ++i) a.p.in[i] = (const float*)d_in[i];
    a.p.out = (float*)d_out; a.p.ws = (unsigned char*)d_ws;
    if (MK_N_LAUNCHES == 1) { a.ph_lo = 0; a.ph_hi = N_PHASES;
#ifdef WS_PROBE
        a.ph_hi = (int)(ws_size >> 20);
#endif
 hipLaunchKernelGGL(mk_fwd, dim3(grid), dim3(NWAVES * 64), LDS_BYTES, stream, a); }
    else {
        for (int k = 0; k < N_PHASES; ++k) {
            const int l = (k - 1) / 10, s = (k - 1) % 10;
            if (k > 0 && (l & 1) == 1 && (s == 2 || s == 3)) continue;
            a.ph_lo = k; a.ph_hi = k + 1; hipLaunchKernelGGL(mk_fwd, dim3(grid), dim3(NWAVES * 64), LDS_BYTES, stream, a);
        }
    }
}
```
